# Optimizing an MI355X kernel written in HIP

```python
import jax
import jax.numpy as jnp
from jax import lax

D_MODEL = 1024
BATCH = 2
SEQ = 16384
DEPTH = 2

GRID_W = 64
CTX_LEN = 256
EPS = 1e-6

CONV_DIM = 512
CONV_WIDTH = 3

HGRN_DIM = 512
HGRN_EXPAND = 128
HGRN_HEADS = HGRN_DIM // HGRN_EXPAND
HGRN_CHUNK = 64

ATT_HEADS = 8
ATT_KV_HEADS = 2
ATT_GROUP = ATT_HEADS // ATT_KV_HEADS
HEAD_DIM = 64
ATT_DIM = ATT_HEADS * HEAD_DIM
KV_DIM = ATT_KV_HEADS * HEAD_DIM
Q_BLOCK = 128
ROPE_THETA = 10000.0
ROPE_AXIS_DIM = HEAD_DIM // 2

N_BRANCH = 3
IN_NAMES = ('a_val', 'a_b', 'a_c', 'b_q', 'b_f_fwd', 'b_f_bwd', 'b_i', 'b_g', 'c_q', 'c_k', 'c_v', 'gate_a', 'gate_b', 'gate_c')
IN_SIZES = (CONV_DIM, CONV_DIM, CONV_DIM, HGRN_DIM, HGRN_DIM, HGRN_DIM, HGRN_DIM, HGRN_DIM, ATT_DIM, KV_DIM, KV_DIM, D_MODEL, D_MODEL, D_MODEL)
W_IN_COLS = 3 * CONV_DIM + 5 * HGRN_DIM + ATT_DIM + 2 * KV_DIM + N_BRANCH * D_MODEL

N_EXPERTS = 16
N_GROUPS = 4
EXPERTS_PER_GROUP = N_EXPERTS // N_GROUPS
TOP_K = 2
EXPERT_DFF = 1024
MOE_BLOCK = 128

kernel_name = 'hybrid_conv_hgrn2_gqa_moe_dit'


def rms_norm(x, g):
    xf = x.astype(jnp.float32)
    y = xf * lax.rsqrt(jnp.mean(xf * xf, axis=-1, keepdims=True) + EPS)
    return (y * g.astype(jnp.float32)).astype(x.dtype)


def _project(u, w_in):
    z = u @ w_in
    parts = {}
    off = 0
    for name, size in zip(IN_NAMES, IN_SIZES):
        parts[name] = z[..., off:off + size]
        off += size
    return parts


def _short_conv(u, w):
    L = u.shape[1]
    pad = CONV_WIDTH // 2
    up = jnp.pad(u, ((0, 0), (pad, CONV_WIDTH - 1 - pad), (0, 0)))
    y = up[:, 0:L] * w[0]
    for j in range(1, CONV_WIDTH):
        y = y + up[:, j:j + L] * w[j]
    return y


def _conv_mixer(p, conv_w, w_out):
    return (p['a_b'] * _short_conv(p['a_c'] * p['a_val'], conv_w)) @ w_out


def _hgrn_lower_bounds(lb_param):
    p = jax.nn.softmax(lb_param.astype(jnp.float32), axis=0)
    cum = jnp.cumsum(p, axis=0)
    return cum - cum[0:1]


def _gla_chunk_scan(q, k, v, log_f, s0):
    B, L, H, _ = q.shape
    n = L // HGRN_CHUNK

    def to_chunks(t):
        return jnp.moveaxis(t.reshape(B, n, HGRN_CHUNK, H, t.shape[-1]), 1, 0)

    lower = jnp.tril(jnp.ones((HGRN_CHUNK, HGRN_CHUNK), dtype=bool))[None, :, :, None, None]

    def step(S, inp):
        qc, kc, vc, gc = inp
        b = jnp.cumsum(gc, axis=1)
        o_inter = jnp.einsum('bthk,bhkv->bthv', qc * jnp.exp(b), S)
        diff = b[:, :, None] - b[:, None, :]
        decay = jnp.exp(jnp.where(lower, diff, -jnp.inf))
        scores = jnp.einsum('bthk,bshk,btshk->bhts', qc, kc, decay)
        o_intra = jnp.einsum('bhts,bshv->bthv', scores, vc)
        b_last = b[:, -1]
        S_new = jnp.exp(b_last)[..., None] * S + jnp.einsum(
            'bshk,bshv->bhkv', kc * jnp.exp(b_last[:, None] - b), vc)
        return S_new, o_inter + o_intra

    S_fin, o = lax.scan(step, s0, (to_chunks(q), to_chunks(k), to_chunks(v), to_chunks(log_f)))
    o = jnp.moveaxis(o, 0, 1).reshape(B, L, H, v.shape[-1])
    return S_fin, o


def _hgrn_mixer(p_ctx, p_lat, lb, norm_g):
    B = p_ctx['b_q'].shape[0]

    def heads(t):
        return t.astype(jnp.float32).reshape(t.shape[0], t.shape[1], HGRN_HEADS, HGRN_EXPAND)

    def ident(t):
        return t

    def rev(t):
        return t[:, ::-1]

    q_c, q_l = heads(jax.nn.silu(p_ctx['b_q'])), heads(jax.nn.silu(p_lat['b_q']))
    v_c, v_l = heads(p_ctx['b_i']), heads(p_lat['b_i'])
    s0 = jnp.zeros((B, HGRN_HEADS, HGRN_EXPAND, HGRN_EXPAND), jnp.float32)
    o_ctx = jnp.zeros_like(v_c)
    o_lat = jnp.zeros_like(v_l)
    for direction, (fname, order) in enumerate((('b_f_fwd', ident), ('b_f_bwd', rev))):
        lb_d = lb[direction].reshape(HGRN_HEADS, HGRN_EXPAND)
        f_c = lb_d + (1.0 - lb_d) * jax.nn.sigmoid(heads(p_ctx[fname]))
        f_l = lb_d + (1.0 - lb_d) * jax.nn.sigmoid(heads(p_lat[fname]))
        s_ctx, oc = _gla_chunk_scan(order(q_c), order(1.0 - f_c), order(v_c), order(jnp.log(f_c)), s0)
        _, ol = _gla_chunk_scan(order(q_l), order(1.0 - f_l), order(v_l), order(jnp.log(f_l)), s_ctx)
        o_ctx = o_ctx + order(oc)
        o_lat = o_lat + order(ol)
    g = norm_g.astype(jnp.float32).reshape(HGRN_HEADS, HGRN_EXPAND)

    def readout(o, p):
        o = o * lax.rsqrt(jnp.mean(o * o, axis=-1, keepdims=True) + EPS) * g
        o = o.reshape(o.shape[0], o.shape[1], HGRN_DIM) * jax.nn.silu(p['b_g'].astype(jnp.float32))
        return o.astype(p['b_g'].dtype)

    return readout(o_ctx, p_ctx), readout(o_lat, p_lat)


def _axial_rope(rows):
    row = jnp.repeat(jnp.arange(rows), GRID_W).astype(jnp.float32)
    col = (jnp.arange(rows * GRID_W) % GRID_W).astype(jnp.float32)
    inv = ROPE_THETA ** (-jnp.arange(0, ROPE_AXIS_DIM, 2, dtype=jnp.float32) / ROPE_AXIS_DIM)
    ar = row[:, None] * inv
    ac = col[:, None] * inv
    ang = jnp.concatenate([ar, ar, ac, ac], axis=-1)
    return jnp.cos(ang), jnp.sin(ang)


def _rotate_half(t):
    a, b = jnp.split(t, 2, axis=-1)
    return jnp.concatenate([-b, a], axis=-1)


def _apply_rope(x, cos, sin):
    xf = x.astype(jnp.float32)
    rot = jnp.concatenate([_rotate_half(xf[..., :ROPE_AXIS_DIM]), _rotate_half(xf[..., ROPE_AXIS_DIM:])], axis=-1)
    return (xf * cos[:, None] + rot * sin[:, None]).astype(x.dtype)


def _attn_heads(p, q_g, k_g):
    B, L, _ = p['c_q'].shape
    q = rms_norm(p['c_q'].reshape(B, L, ATT_HEADS, HEAD_DIM), q_g)
    k = rms_norm(p['c_k'].reshape(B, L, ATT_KV_HEADS, HEAD_DIM), k_g)
    v = p['c_v'].reshape(B, L, ATT_KV_HEADS, HEAD_DIM)
    return q, k, v


def _gqa(q, k, v):
    B, Q = q.shape[:2]
    qg = q.reshape(B, Q, ATT_KV_HEADS, ATT_GROUP, HEAD_DIM).astype(jnp.float32)
    s = jnp.einsum('bqkgd,bskd->bkgqs', qg, k.astype(jnp.float32)) * (HEAD_DIM ** -0.5)
    p = jax.nn.softmax(s, axis=-1)
    o = jnp.einsum('bkgqs,bskd->bqkgd', p, v.astype(jnp.float32))
    return o.reshape(B, Q, ATT_DIM).astype(q.dtype)


def _latent_attention(q_l, k_all, v_all):
    B, L = q_l.shape[:2]
    nb = L // Q_BLOCK
    qb = jnp.moveaxis(q_l.reshape(B, nb, Q_BLOCK, ATT_HEADS, HEAD_DIM), 1, 0)
    o = lax.map(lambda blk: _gqa(blk, k_all, v_all), qb)
    return jnp.moveaxis(o, 0, 1).reshape(B, L, ATT_DIM)


def _merge(p, ya, yb, yc, w_o):
    m = (jax.nn.sigmoid(p['gate_a']) * ya + jax.nn.sigmoid(p['gate_b']) * yb
         + jax.nn.sigmoid(p['gate_c']) * yc)
    return m @ w_o


def _route(h, router_w, router_b):
    T = h.shape[0]
    scores = jax.nn.sigmoid((h @ router_w).astype(jnp.float32))
    sel = scores + router_b.astype(jnp.float32)
    grp_score = lax.top_k(sel.reshape(T, N_GROUPS, EXPERTS_PER_GROUP), TOP_K)[0].sum(-1)
    best = jnp.argmax(grp_score, axis=-1)
    in_group = (jnp.arange(N_EXPERTS) // EXPERTS_PER_GROUP)[None, :] == best[:, None]
    _, idx = lax.top_k(jnp.where(in_group, sel, -jnp.inf), TOP_K)
    w = jnp.take_along_axis(scores, idx, axis=-1)
    return idx, w / jnp.sum(w, axis=-1, keepdims=True)


def _moe(h, router_w, router_b, w_gate, w_up, w_down):
    shp = h.shape
    hf = h.reshape(-1, shp[-1])
    T = hf.shape[0]
    idx, gw = _route(hf, router_w, router_b)
    A = T * TOP_K
    flat_e = idx.reshape(-1)
    flat_tok = jnp.repeat(jnp.arange(T, dtype=jnp.int32), TOP_K)
    flat_w = gw.reshape(-1)
    order = jnp.argsort(flat_e)
    se = flat_e[order]
    counts = jnp.bincount(flat_e, length=N_EXPERTS)
    padded = (counts + MOE_BLOCK - 1) // MOE_BLOCK * MOE_BLOCK
    start = jnp.cumsum(counts) - counts
    pend = jnp.cumsum(padded)
    pstart = pend - padded
    dest = pstart[se] + jnp.arange(A) - start[se]
    n_blocks = -(-A // MOE_BLOCK) + N_EXPERTS
    P = n_blocks * MOE_BLOCK
    row_tok = jnp.zeros((P,), jnp.int32).at[dest].set(flat_tok[order])
    row_w = jnp.zeros((P,), hf.dtype).at[dest].set(flat_w[order].astype(hf.dtype))
    blk_e = jnp.minimum(jnp.searchsorted(pend, jnp.arange(n_blocks) * MOE_BLOCK, side='right'), N_EXPERTS - 1)
    xs = hf[row_tok].reshape(n_blocks, MOE_BLOCK, shp[-1])

    def expert_rows(args):
        xb, e = args
        hid = jax.nn.silu(xb @ w_gate[e]) * (xb @ w_up[e])
        return hid @ w_down[e]

    ys = lax.map(expert_rows, (xs, blk_e)).reshape(P, shp[-1])
    out = jnp.zeros_like(hf).at[row_tok].add(ys * row_w[:, None])
    return out.reshape(shp)


def setup_inputs(seed: int = 0) -> dict:
    key = jax.random.key(seed)
    ks = jax.random.split(key, 24)
    f32 = jnp.float32

    def dense(k, shape, fan_in, gain=1.0):
        return jax.random.normal(k, shape, f32) * (gain * fan_in ** -0.5)

    def gain_vec(k, shape):
        return 1.0 + 0.1 * jax.random.normal(k, shape, f32)

    return {
        'x': jax.random.normal(ks[0], (BATCH, SEQ, D_MODEL), f32),
        'c': jax.random.normal(ks[1], (BATCH, D_MODEL), f32),
        'ctx': jax.random.normal(ks[2], (BATCH, CTX_LEN, D_MODEL), f32),
        'c_ctx': jax.random.normal(ks[3], (D_MODEL,), f32),
        'w_mod': dense(ks[4], (DEPTH, D_MODEL, 6 * D_MODEL), D_MODEL, 0.5),
        'b_mod': 0.02 * jax.random.normal(ks[5], (DEPTH, 6 * D_MODEL), f32),
        'norm1_g': gain_vec(ks[6], (DEPTH, D_MODEL)),
        'norm2_g': gain_vec(ks[7], (DEPTH, D_MODEL)),
        'w_in': dense(ks[8], (DEPTH, D_MODEL, W_IN_COLS), D_MODEL),
        'conv_w': dense(ks[9], (DEPTH, CONV_WIDTH, CONV_DIM), CONV_WIDTH),
        'lb_param': jax.random.normal(ks[10], (DEPTH, 2, HGRN_DIM), f32),
        'hgrn_norm_g': gain_vec(ks[11], (DEPTH, HGRN_DIM)),
        'q_norm_g': gain_vec(ks[12], (DEPTH, HEAD_DIM)),
        'k_norm_g': gain_vec(ks[13], (DEPTH, HEAD_DIM)),
        'w_a_out': dense(ks[14], (DEPTH, CONV_DIM, D_MODEL), CONV_DIM),
        'w_b_out': dense(ks[15], (DEPTH, HGRN_DIM, D_MODEL), HGRN_DIM),
        'w_c_out': dense(ks[16], (DEPTH, ATT_DIM, D_MODEL), ATT_DIM),
        'w_o': dense(ks[17], (DEPTH, D_MODEL, D_MODEL), D_MODEL),
        'router_w': dense(ks[18], (D_MODEL, N_EXPERTS), D_MODEL),
        'router_b': 0.01 * jax.random.normal(ks[19], (N_EXPERTS,), f32),
        'w_gate': dense(ks[20], (DEPTH, N_EXPERTS, D_MODEL, EXPERT_DFF), D_MODEL),
        'w_up': dense(ks[21], (DEPTH, N_EXPERTS, D_MODEL, EXPERT_DFF), D_MODEL),
        'w_down': dense(ks[22], (DEPTH, N_EXPERTS, EXPERT_DFF, D_MODEL), EXPERT_DFF),
        'final_g': gain_vec(ks[23], (D_MODEL,)),
    }


def reference(x, c, ctx, c_ctx, w_mod, b_mod, norm1_g, norm2_g, w_in, conv_w, lb_param,
              hgrn_norm_g, q_norm_g, k_norm_g, w_a_out, w_b_out, w_c_out, w_o,
              router_w, router_b, w_gate, w_up, w_down, final_g):
    L = x.shape[1]
    ROWS = L // GRID_W
    cos, sin = _axial_rope(ROWS)
    lower_bounds = _hgrn_lower_bounds(lb_param)
    h_lat, h_ctx = x, ctx
    for layer in range(DEPTH):
        last = layer == DEPTH - 1
        mod_lat = jnp.split((jax.nn.silu(c) @ w_mod[layer] + b_mod[layer])[:, None, :], 6, axis=-1)
        mod_ctx = jnp.split((jax.nn.silu(c_ctx) @ w_mod[layer] + b_mod[layer])[None, None, :], 6, axis=-1)
        sh1_l, sc1_l, g1_l, sh2_l, sc2_l, g2_l = mod_lat
        sh1_c, sc1_c, g1_c, sh2_c, sc2_c, g2_c = mod_ctx

        u_lat = rms_norm(h_lat, norm1_g[layer]) * (1.0 + sc1_l) + sh1_l
        u_ctx = rms_norm(h_ctx, norm1_g[layer]) * (1.0 + sc1_c) + sh1_c
        p_lat = _project(u_lat, w_in[layer])
        p_ctx = _project(u_ctx, w_in[layer])

        yb_ctx, yb_lat = _hgrn_mixer(p_ctx, p_lat, lower_bounds[layer], hgrn_norm_g[layer])

        q_c, k_c, v_c = _attn_heads(p_ctx, q_norm_g[layer], k_norm_g[layer])
        q_l, k_l, v_l = _attn_heads(p_lat, q_norm_g[layer], k_norm_g[layer])
        q_l = _apply_rope(q_l, cos, sin)
        k_l = _apply_rope(k_l, cos, sin)
        k_all = jnp.concatenate([k_c, k_l], axis=1)
        v_all = jnp.concatenate([v_c, v_l], axis=1)
        yc_lat = _latent_attention(q_l, k_all, v_all)

        ya_lat = _conv_mixer(p_lat, conv_w[layer], w_a_out[layer])
        out_lat = _merge(p_lat, ya_lat, yb_lat @ w_b_out[layer], yc_lat @ w_c_out[layer], w_o[layer])
        h_lat = h_lat + g1_l * out_lat
        if not last:
            ya_ctx = _conv_mixer(p_ctx, conv_w[layer], w_a_out[layer])
            yc_ctx = _gqa(q_c, k_c, v_c)
            out_ctx = _merge(p_ctx, ya_ctx, yb_ctx @ w_b_out[layer], yc_ctx @ w_c_out[layer], w_o[layer])
            h_ctx = h_ctx + g1_c * out_ctx

        m_lat = rms_norm(h_lat, norm2_g[layer]) * (1.0 + sc2_l) + sh2_l
        h_lat = h_lat + g2_l * _moe(m_lat, router_w, router_b, w_gate[layer], w_up[layer], w_down[layer])
        if not last:
            m_ctx = rms_norm(h_ctx, norm2_g[layer]) * (1.0 + sc2_c) + sh2_c
            h_ctx = h_ctx + g2_c * _moe(m_ctx, router_w, router_b, w_gate[layer], w_up[layer], w_down[layer])
    return rms_norm(h_lat, final_g)
```

```cpp
#include <hip/hip_runtime.h>
#include <cstdio>
#include <cstdint>
#include <cmath>
namespace pg8 {
#define PG8_LAS __attribute__((address_space(3)))
typedef unsigned short bf16_t;
typedef short bf16x8 __attribute__((ext_vector_type(8)));
typedef float f32x4 __attribute__((ext_vector_type(4)));
typedef unsigned u32x4 __attribute__((ext_vector_type(4)));
constexpr int BM = 256, BK = 64, HALF = 128, HTB = HALF * BK * 2  , STAGE_BYTES = 8 * HTB, NXCD = 8, WGM = 8;

__host__ __device__ __forceinline__ int lds_byte(int r, int c) { const int st = (r >> 4) * 2 + (c >> 5), rr = r & 15, cc = c & 31, ob = rr * 64 + cc * 2; return st * 1024 + (ob ^ (((ob >> 9) & 1) << 5)); }
__host__ __device__ __forceinline__ void stage_rc(int b, int& R, int& C) { const int st = b / 1024, sb = b % 1024, swz = sb ^ (((sb >> 9) & 1) << 5); R = (st >> 1) * 16 + swz / 64; C = (st & 1) * 32 + (swz % 64) / 2; }
__host__ __device__ __forceinline__ int perm32(int rho) { const int n = rho >> 4, i = rho & 15; return 8 * (i >> 2) + 4 * n + (i & 3); }

struct Unit { int pm, pn; };
struct Gemm { const bf16_t* A; const bf16_t* Bt; int M, N, K, lda; };

struct StaticOrder {
    int nM, nN, nwg, G, c;
    __host__ __device__ void init(int M, int N, int G_, int c_) { nM = M / BM; nN = N / BM; nwg = nM * nN; G = G_; c = c_; }
    __host__ __device__ bool next(int i, Unit& u) const {
        const long L = (long)i * G + c; if (L >= nwg) return false;
        int wgid = (int)L; { const int q = nwg / NXCD, r = nwg % NXCD, xcd = wgid % NXCD, off = wgid / NXCD; wgid = (xcd < r ? xcd * (q + 1) : r * (q + 1) + (xcd - r) * q) + off; }
        const int nig = WGM * nN, gid = wgid / nig, fm = gid * WGM, gsz = (nM - fm) < WGM ? (nM - fm) : WGM;
        u.pm = fm + ((wgid % nig) % gsz); u.pn = (wgid % nig) / gsz; return true;
    }
    __device__ __forceinline__ void a_ready(const Unit&) const {}
    __device__ __forceinline__ void done(const Unit&) const {}
};

typedef float f32x2c __attribute__((ext_vector_type(2))); typedef __bf16 bf16x2c __attribute__((ext_vector_type(2)));
__device__ __forceinline__ unsigned cvt_pk_bf16(float lo, float hi) { const f32x2c v = {lo, hi}; const bf16x2c b = __builtin_convertvector(v, bf16x2c); return __builtin_bit_cast(unsigned, b); }
typedef float f32x2 __attribute__((ext_vector_type(2)));
typedef unsigned u32x2 __attribute__((ext_vector_type(2)));
__device__ __forceinline__ float fsigmoid(float x) { return __builtin_amdgcn_rcpf(1.0f + __builtin_amdgcn_exp2f(-1.4426950408889634f * x)); }
__device__ __forceinline__ float fsilu(float x) { return x * fsigmoid(x); }
__device__ __forceinline__ f32x4 silu4(f32x4 v) { return (f32x4){fsilu(v[0]), fsilu(v[1]), fsilu(v[2]), fsilu(v[3])}; }
__device__ __forceinline__ f32x4 sigm4(f32x4 v) { return (f32x4){fsigmoid(v[0]), fsigmoid(v[1]), fsigmoid(v[2]), fsigmoid(v[3])}; }
__device__ __forceinline__ void st8(bf16_t* p, const f32x4 a, const f32x4 b) {
    u32x4 w; w.x = cvt_pk_bf16(a[0], a[1]); w.y = cvt_pk_bf16(a[2], a[3]); w.z = cvt_pk_bf16(b[0], b[1]); w.w = cvt_pk_bf16(b[2], b[3]); *(u32x4*)p = w; }
__device__ __forceinline__ float bflo(unsigned w) { return __uint_as_float(w << 16); }
__device__ __forceinline__ float bfhi(unsigned w) { return __uint_as_float(w & 0xffff0000u); }
__device__ __forceinline__ void ld8(const bf16_t* p, f32x4& a, f32x4& b) { const u32x4 w = *(const u32x4*)p; a = (f32x4){bflo(w.x), bfhi(w.x), bflo(w.y), bfhi(w.y)}; b = (f32x4){bflo(w.z), bfhi(w.z), bflo(w.w), bfhi(w.w)}; }

struct EpiW1 {
    static constexpr bool PERM = true, AFTER_DRAIN = false;
    bf16_t *PA, *PB, *PC;
    __device__ __forceinline__ void operator()(const f32x4 (&acc)[2][2][4][2], const Unit& u, int wr, int wc, int fr, int fq) const {
        const int row0 = u.pm * BM + wr * 64 + fr, c8 = wc * 32 + 8 * fq;
        if (u.pn < 4) {
#pragma unroll
            for (int ai = 0; ai < 2; ++ai)
#pragma unroll
                for (int m = 0; m < 4; ++m)
                    st8(PA + (size_t)(row0 + ai * HALF + m * 16) * 1024 + u.pn * 128 + c8, acc[ai][0][m][0] * acc[ai][1][m][0], acc[ai][0][m][1] * acc[ai][1][m][1]);
        } else {
            bf16_t* base; int ldc, cb; bool act;
            if (u.pn < 6) { base = PA; ldc = 1024; cb = 512 + 256 * (u.pn - 4); act = false; }
            else if (u.pn < 16) { base = PB; ldc = 2560; cb = 256 * (u.pn - 6); act = (u.pn < 8) || (u.pn >= 14); }
            else { base = PC; ldc = 768; cb = 256 * (u.pn - 16); act = false; }
#pragma unroll
            for (int ai = 0; ai < 2; ++ai)
#pragma unroll
                for (int m = 0; m < 4; ++m)
#pragma unroll
                    for (int bj = 0; bj < 2; ++bj) { f32x4 v0 = acc[ai][bj][m][0], v1 = acc[ai][bj][m][1]; if (act) { v0 = silu4(v0); v1 = silu4(v1); }
                        st8(base + (size_t)(row0 + ai * HALF + m * 16) * ldc + cb + bj * HALF + c8, v0, v1); }
        }
    }
};
struct EpiGate {
    static constexpr bool PERM = true, AFTER_DRAIN = false;
    bf16_t* G;
    __device__ __forceinline__ void operator()(const f32x4 (&acc)[2][2][4][2], const Unit& u, int wr, int wc, int fr, int fq) const {
        const int row0 = u.pm * BM + wr * 64 + fr, c8 = u.pn * BM + wc * 32 + 8 * fq;
#pragma unroll
        for (int ai = 0; ai < 2; ++ai)
#pragma unroll
            for (int m = 0; m < 4; ++m)
#pragma unroll
                for (int bj = 0; bj < 2; ++bj) st8(G + (size_t)(row0 + ai * HALF + m * 16) * 3072 + bj * HALF + c8, sigm4(acc[ai][bj][m][0]), sigm4(acc[ai][bj][m][1]));
    }
};
template <int BR> struct EpiMerge {
    static constexpr bool PERM = true, AFTER_DRAIN = false;
    const bf16_t* G; bf16_t* Mb;
    __device__ __forceinline__ void operator()(const f32x4 (&acc)[2][2][4][2], const Unit& u, int wr, int wc, int fr, int fq) const {
        const int row0 = u.pm * BM + wr * 64 + fr, c8 = u.pn * BM + wc * 32 + 8 * fq;
#pragma unroll
        for (int ai = 0; ai < 2; ++ai)
#pragma unroll
            for (int m = 0; m < 4; ++m) {
#pragma unroll
                for (int bj = 0; bj < 2; ++bj) { const size_t row = (size_t)(row0 + ai * HALF + m * 16); const int col = bj * HALF + c8;
                    f32x4 g0, g1; ld8(G + row * 3072 + BR * 1024 + col, g0, g1);
                    f32x4 v0 = g0 * acc[ai][bj][m][0], v1 = g1 * acc[ai][bj][m][1];
                    if (BR > 0) { f32x4 p0, p1; ld8(Mb + row * 1024 + col, p0, p1); v0 += p0; v1 += p1; }
                    st8(Mb + row * 1024 + col, v0, v1); }
                asm volatile("" ::: "memory"); }
    }
};
struct EpiWo {
    static constexpr bool PERM = false, AFTER_DRAIN = false;
    const float *hs_lat, *hs_ctx; float *hd_lat, *hd_ctx; const float* mod;
    __device__ __forceinline__ void operator()(const f32x4 (&acc)[2][2][4][2], const Unit& u, int wr, int wc, int fr, int fq) const {
        const int b = u.pm / 65, j = u.pm % 65; const float* hs; float* hd; const float* g1;
        if (j == 0) { const size_t off = (size_t)b * 256 * 1024; hs = hs_ctx + off; hd = hd_ctx + off; g1 = mod + (2 * 6 + 2) * 1024; }
        else { const size_t off = ((size_t)b * 16384 + (size_t)(j - 1) * 256) * 1024; hs = hs_lat + off; hd = hd_lat + off; g1 = mod + (b * 6 + 2) * 1024; }
        const int col0 = u.pn * BM + wc * 32 + 4 * fq;
        f32x4 gv[2][2];
#pragma unroll
        for (int bj = 0; bj < 2; ++bj)
#pragma unroll
            for (int n = 0; n < 2; ++n) gv[bj][n] = *(const f32x4*)(g1 + col0 + bj * HALF + n * 16);
#pragma unroll
        for (int ai = 0; ai < 2; ++ai)
#pragma unroll
            for (int m = 0; m < 4; ++m) { const size_t off = (size_t)(ai * HALF + wr * 64 + m * 16 + fr) * 1024 + col0;
#pragma unroll
                for (int bj = 0; bj < 2; ++bj)
#pragma unroll
                    for (int n = 0; n < 2; ++n) { const f32x4 o = *(const f32x4*)(hs + off + bj * HALF + n * 16) + gv[bj][n] * acc[ai][bj][m][n]; *(f32x4*)(hd + off + bj * HALF + n * 16) = o; }
                asm volatile("" ::: "memory"); }
    }
};
struct EpiMoe1 {
    static constexpr bool PERM = true, AFTER_DRAIN = false;
    bf16_t* HID;
    __device__ __forceinline__ void operator()(const f32x4 (&acc)[2][2][4][2], const Unit& u, int wr, int wc, int fr, int fq) const {
        const int row0 = u.pm * BM + wr * 64 + fr, c8 = (u.pn & 7) * 128 + wc * 32 + 8 * fq;
#pragma unroll
        for (int ai = 0; ai < 2; ++ai)
#pragma unroll
            for (int m = 0; m < 4; ++m)
                st8(HID + (size_t)(row0 + ai * HALF + m * 16) * 1024 + c8, silu4(acc[ai][0][m][0]) * acc[ai][1][m][0], silu4(acc[ai][0][m][1]) * acc[ai][1][m][1]);
    }
};
struct EpiMoe2 {
    static constexpr bool PERM = true, AFTER_DRAIN = false;
    bf16_t* YS;
    __device__ __forceinline__ void operator()(const f32x4 (&acc)[2][2][4][2], const Unit& u, int wr, int wc, int fr, int fq) const {
        const int row0 = u.pm * BM + wr * 64 + fr, c8 = (u.pn & 3) * BM + wc * 32 + 8 * fq;
#pragma unroll
        for (int ai = 0; ai < 2; ++ai)
#pragma unroll
            for (int m = 0; m < 4; ++m)
#pragma unroll
                for (int bj = 0; bj < 2; ++bj) st8(YS + (size_t)(row0 + ai * HALF + m * 16) * 1024 + bj * HALF + c8, acc[ai][bj][m][0], acc[ai][bj][m][1]);
    }
};
struct MoeOrder {
    const int* tab; int nN, G, c, n_units;
    __device__ __forceinline__ void init(const int* tab_, int nN_, int G_, int c_) { tab = tab_; nN = nN_; G = G_; c = c_; n_units = __builtin_amdgcn_readfirstlane(tab_[0]) * nN_; }
    __device__ __forceinline__ bool next(int i, Unit& u) const {
        const int L = i * G + c; if (L >= n_units) return false;
        const int t = L / nN, j = L - t * nN; const int e = __builtin_amdgcn_readfirstlane(tab[1 + t]);
        u.pm = t; u.pn = e * nN + j; return true;
    }
    __device__ __forceinline__ void a_ready(const Unit&) const {}
    __device__ __forceinline__ void done(const Unit&) const {}
};

template <class Epi, class Sched, bool ALIGN_EPI = false, bool SP2 = false>
__device__ __forceinline__ void gemm_phase(PG8_LAS unsigned char* lds, const Gemm g, const Sched& S, const Epi& E) {
    int tid_ = threadIdx.x; asm volatile("" : "+v"(tid_));
    const int tid = tid_, wid = __builtin_amdgcn_readfirstlane(tid >> 6), lane = tid & 63, wr = wid >> 2, wc = wid & 3, fr = lane & 15, fq = lane >> 4;
    const int K = g.K, nt = K / BK;
    unsigned voffA[2], voffB[2];
#pragma unroll
    for (int i = 0; i < 2; ++i) { int R, C; stage_rc(tid * 16 + i * 8192, R, C); const int Rb = Epi::PERM ? ((R & ~31) + perm32(R & 31)) : R;
        voffA[i] = (unsigned)(R * g.lda + C) * 2u; voffB[i] = (unsigned)(Rb * K + C) * 2u; }
    const size_t kstep = (size_t)(BK * 2);
    const size_t hstepA = (size_t)HALF * g.lda * 2, hstepB = (size_t)HALF * K * 2;
    const size_t tstepA = 2 * hstepA, tstepB = 2 * hstepB;
    const unsigned ldsw = (unsigned)wid * 1024u;
    const int aoff = lds_byte(wr * 64 + fr, fq * 8), boff = lds_byte(wc * 32 + fr, fq * 8);
#define PG8_SA(b, h) (((b) * 2 + (h)) * HTB)
#define PG8_SB(b, h) ((4 + (b) * 2 + (h)) * HTB)
#define PG8_STAGE(bufoff, gbase, voff) do { _Pragma("unroll") for (int _i = 0; _i < 2; ++_i) \
        __builtin_amdgcn_global_load_lds((const unsigned*)((const char*)(gbase) + (voff)[_i]), (PG8_LAS unsigned*)(lds + (bufoff) + ldsw + _i * 8192), 16, 0, 0); } while (0)
#define PG8_LDA(dst, b, h) do { _Pragma("unroll") for (int m = 0; m < 4; ++m) _Pragma("unroll") for (int k = 0; k < 2; ++k) dst[m][k] = *(const PG8_LAS bf16x8*)(lds + PG8_SA(b, h) + aoff + m * 2048 + k * 1024); } while (0)
#define PG8_LDB(dst, b, h) do { _Pragma("unroll") for (int n = 0; n < 2; ++n) _Pragma("unroll") for (int k = 0; k < 2; ++k) dst[n][k] = *(const PG8_LAS bf16x8*)(lds + PG8_SB(b, h) + boff + n * 2048 + k * 1024); } while (0)
#define PG8_MMA(ai, bj, At, Bt) do { __builtin_amdgcn_s_setprio(1); _Pragma("unroll") for (int m = 0; m < 4; ++m) _Pragma("unroll") for (int n = 0; n < 2; ++n) _Pragma("unroll") for (int k = 0; k < 2; ++k) \
        acc[ai][bj][m][n] = __builtin_amdgcn_mfma_f32_16x16x32_bf16(Bt[n][k], At[m][k], acc[ai][bj][m][n], 0, 0, 0); __builtin_amdgcn_s_setprio(0); } while (0)
#define PG8_WAIT_V(n) asm volatile("s_waitcnt vmcnt(" #n ")" ::: "memory")
#define PG8_WAIT_L(n) asm volatile("s_waitcnt lgkmcnt(" #n ")" ::: "memory")
#define PG8_BAR __builtin_amdgcn_s_barrier()
#define PG8_SCHED __builtin_amdgcn_sched_barrier(0)
    Unit cur, nxt; int ui = 0;
    if (!S.next(0, cur)) return;
    f32x4 acc[2][2][4][2];
#pragma unroll
    for (int a = 0; a < 2; ++a)
#pragma unroll
        for (int b = 0; b < 2; ++b)
#pragma unroll
            for (int m = 0; m < 4; ++m)
#pragma unroll
                for (int n = 0; n < 2; ++n) acc[a][b][m][n] = (f32x4){0.f, 0.f, 0.f, 0.f};
    bf16x8 At[4][2], B0[2][2], B1[2][2];
    const char* cA = (const char*)g.A + (size_t)cur.pm * tstepA; const char* cB = (const char*)g.Bt + (size_t)cur.pn * tstepB;
    S.a_ready(cur);
    if constexpr (SP2) {
        PG8_STAGE(PG8_SB(0, 0), cB, voffB); PG8_STAGE(PG8_SB(0, 1), cB + hstepB, voffB); PG8_STAGE(PG8_SA(0, 0), cA, voffA); PG8_STAGE(PG8_SA(0, 1), cA + hstepA, voffA);
        if (wr == 1) PG8_BAR;
        PG8_WAIT_V(2); PG8_BAR;
        PG8_STAGE(PG8_SB(1, 0), cB + kstep, voffB); PG8_STAGE(PG8_SA(1, 0), cA + kstep, voffA); PG8_STAGE(PG8_SB(1, 1), cB + hstepB + kstep, voffB);
        PG8_WAIT_V(6); PG8_BAR;
    } else {
        PG8_STAGE(PG8_SB(0, 0), cB, voffB); PG8_STAGE(PG8_SA(0, 0), cA, voffA); PG8_STAGE(PG8_SB(0, 1), cB + hstepB, voffB); PG8_STAGE(PG8_SA(0, 1), cA + hstepA, voffA);
        if (wr == 1) PG8_BAR;
        PG8_WAIT_V(4); PG8_BAR;
        PG8_STAGE(PG8_SB(1, 0), cB + kstep, voffB); PG8_STAGE(PG8_SA(1, 0), cA + kstep, voffA); PG8_STAGE(PG8_SB(1, 1), cB + hstepB + kstep, voffB);
        PG8_WAIT_V(6); PG8_BAR;
    }
    for (;;) {
        const bool has_next = S.next(ui + 1, nxt);
        const char* nA = has_next ? (const char*)g.A + (size_t)nxt.pm * tstepA : cA; const char* nB = has_next ? (const char*)g.Bt + (size_t)nxt.pn * tstepB : cB;
        for (int t = 0; t < nt; t += 2) {
            const bool last = (t == nt - 2);
            const char* a1 = cA + (size_t)(t + 1) * kstep;
            const char* a2 = last ? nA : cA + (size_t)(t + 2) * kstep; const char* b2 = last ? nB : cB + (size_t)(t + 2) * kstep;
            const char* a3 = a2 + kstep; const char* b3 = b2 + kstep;
            if (last && has_next) S.a_ready(nxt);
            if constexpr (SP2) {
            PG8_LDB(B0, 0, 0); PG8_LDB(B1, 0, 1); PG8_SCHED; PG8_LDA(At, 0, 0); PG8_STAGE(PG8_SA(1, 1), a1 + hstepA, voffA);
            PG8_WAIT_V(8); PG8_WAIT_L(0); PG8_BAR; PG8_MMA(0, 0, At, B0); PG8_MMA(0, 1, At, B1); PG8_BAR; PG8_SCHED;
            PG8_LDA(At, 0, 1); PG8_STAGE(PG8_SB(0, 0), b2, voffB); PG8_STAGE(PG8_SB(0, 1), b2 + hstepB, voffB); PG8_STAGE(PG8_SA(0, 0), a2, voffA);
            PG8_WAIT_V(8); PG8_WAIT_L(0); PG8_BAR; PG8_MMA(1, 0, At, B0); PG8_MMA(1, 1, At, B1); PG8_BAR; PG8_SCHED;
            PG8_LDB(B0, 1, 0); PG8_LDB(B1, 1, 1); PG8_SCHED; PG8_LDA(At, 1, 0); PG8_STAGE(PG8_SA(0, 1), a2 + hstepA, voffA);
            PG8_WAIT_V(8); PG8_WAIT_L(0); PG8_BAR; PG8_MMA(0, 0, At, B0); PG8_MMA(0, 1, At, B1); PG8_BAR; PG8_SCHED;
            PG8_LDA(At, 1, 1); PG8_STAGE(PG8_SB(1, 0), b3, voffB); PG8_STAGE(PG8_SB(1, 1), b3 + hstepB, voffB); PG8_STAGE(PG8_SA(1, 0), a3, voffA);
            PG8_WAIT_V(8); PG8_WAIT_L(0); PG8_BAR; PG8_MMA(1, 0, At, B0); PG8_MMA(1, 1, At, B1); PG8_BAR; PG8_SCHED;
            } else {
            PG8_LDB(B0, 0, 0); PG8_SCHED; PG8_LDA(At, 0, 0); PG8_STAGE(PG8_SA(1, 1), a1 + hstepA, voffA);
            PG8_WAIT_L(8); PG8_BAR; PG8_WAIT_L(0); PG8_MMA(0, 0, At, B0); PG8_BAR; PG8_SCHED;
            PG8_LDB(B1, 0, 1); PG8_STAGE(PG8_SB(0, 0), b2, voffB);
            PG8_BAR; PG8_WAIT_L(0); PG8_MMA(0, 1, At, B1); PG8_BAR;
            PG8_LDA(At, 0, 1); PG8_STAGE(PG8_SA(0, 0), a2, voffA);
            PG8_BAR; PG8_WAIT_L(0); PG8_MMA(1, 0, At, B0); PG8_BAR; PG8_SCHED;
            PG8_STAGE(PG8_SB(0, 1), b2 + hstepB, voffB);
            PG8_WAIT_V(6); PG8_BAR; PG8_MMA(1, 1, At, B1); PG8_BAR;
            PG8_LDB(B0, 1, 0); PG8_SCHED; PG8_LDA(At, 1, 0); PG8_STAGE(PG8_SA(0, 1), a2 + hstepA, voffA);
            PG8_WAIT_L(8); PG8_BAR; PG8_WAIT_L(0); PG8_MMA(0, 0, At, B0); PG8_BAR; PG8_SCHED;
            PG8_LDB(B1, 1, 1); PG8_STAGE(PG8_SB(1, 0), b3, voffB);
            PG8_BAR; PG8_WAIT_L(0); PG8_MMA(0, 1, At, B1); PG8_BAR;
            PG8_LDA(At, 1, 1); PG8_STAGE(PG8_SA(1, 0), a3, voffA);
            PG8_BAR; PG8_WAIT_L(0); PG8_MMA(1, 0, At, B0); PG8_BAR; PG8_SCHED;
            PG8_STAGE(PG8_SB(1, 1), b3 + hstepB, voffB);
            PG8_WAIT_V(6); PG8_BAR; PG8_MMA(1, 1, At, B1); PG8_BAR;
            }
        }
        if constexpr (ALIGN_EPI) { if (wr == 0) PG8_BAR; }
        if constexpr (!Epi::AFTER_DRAIN) { E(acc, cur, wr, wc, fr, fq); S.done(cur); }
        if (!has_next) break;
#pragma unroll
        for (int a = 0; a < 2; ++a)
#pragma unroll
            for (int b = 0; b < 2; ++b)
#pragma unroll
                for (int m = 0; m < 4; ++m)
#pragma unroll
                    for (int n = 0; n < 2; ++n) acc[a][b][m][n] = (f32x4){0.f, 0.f, 0.f, 0.f};
        cur = nxt; cA = nA; cB = nB; ++ui;
        if constexpr (ALIGN_EPI) { if (wr == 1) PG8_BAR; }
    }
    PG8_WAIT_V(0);
    if constexpr (!ALIGN_EPI) { if (wr == 0) PG8_BAR; }
    PG8_BAR;
    if constexpr (Epi::AFTER_DRAIN) { E.fused(acc, cur, wr, wc, fr, fq, lds, wid, lane); S.done(cur); }
#undef PG8_SA
#undef PG8_SB
#undef PG8_STAGE
#undef PG8_LDA
#undef PG8_LDB
#undef PG8_MMA
#undef PG8_WAIT_V
#undef PG8_WAIT_L
#undef PG8_BAR
#undef PG8_SCHED
}
}
#define GAS __attribute__((address_space(1)))
#define LAS __attribute__((address_space(3)))
typedef unsigned short bf16;
typedef unsigned v4u __attribute__((ext_vector_type(4)));
typedef float f32x4 __attribute__((ext_vector_type(4)));
typedef short bf16x8 __attribute__((ext_vector_type(8)));
typedef GAS unsigned gu32;
typedef GAS unsigned long long gu64;
#define RLX_AGENT __ATOMIC_RELAXED, __HIP_MEMORY_SCOPE_AGENT
#define LDS_WAIT() asm volatile("s_waitcnt lgkmcnt(0)" ::: "memory")
#define VM_WAIT() asm volatile("s_waitcnt vmcnt(0)" ::: "memory")
__device__ __forceinline__ unsigned long long rt() { return __builtin_amdgcn_s_memrealtime(); }
__device__ __forceinline__ unsigned f2bf(float f) { unsigned u = __builtin_bit_cast(unsigned, f); return (u + 0x7fffu + ((u >> 16) & 1u)) >> 16; }
__device__ __forceinline__ unsigned pk2(float lo, float hi) { return f2bf(lo) | (f2bf(hi) << 16); }
#define XB_TMO      128
#define XB_XCNT(j)  (256  + 64 * (j))
#define XB_XSUB(j)  (1280 + 64 * (j))
#define XB_XGEN(j)  (2304 + 64 * (j))
#define XB_TOP      3328
#define XB_TOPGEN   3392
#define XCD_BAR_WORDS 3456
#define XB_SPIN_CAP (1u << 18)

__device__ __forceinline__ unsigned xb_ld(unsigned* p)              { return __hip_atomic_load(p, __ATOMIC_RELAXED, __HIP_MEMORY_SCOPE_AGENT); }
__device__ __forceinline__ unsigned xb_add(unsigned* p, unsigned v) { return __hip_atomic_fetch_add(p, v, __ATOMIC_RELAXED, __HIP_MEMORY_SCOPE_AGENT); }
__device__ __forceinline__ unsigned xb_xcc_id() { return (unsigned)__builtin_amdgcn_s_getreg((3 << 11) | 20) & 0xFu; }
#define XB_SPIN(cond, bar) do { unsigned _sp = 0; while (cond) { __builtin_amdgcn_s_sleep(1); \
    if ((++_sp & 255u) == 0u) { if (xb_ld(&(bar)[XB_TMO])) break; if (_sp > XB_SPIN_CAP) { atomicAdd(&(bar)[XB_TMO], 1u); break; } } } } while (0)

struct XcdBarrier {
    unsigned* bar; unsigned x;
    volatile LAS unsigned* st;
};

__device__ __forceinline__ XcdBarrier xcd_barrier_post(unsigned* bar, volatile LAS unsigned* st) {
    XcdBarrier b; b.bar = bar; b.x = xb_xcc_id(); b.st = st;
    if (threadIdx.x == 0) (void)xb_add(&bar[XB_XCNT(b.x)], 1u);
    return b;
}
__device__ __forceinline__ void xcd_barrier_complete(unsigned* bar, unsigned x, unsigned& nloc, unsigned& nx) {
    const unsigned G = gridDim.x * gridDim.y * gridDim.z;
    unsigned sum, cnt, mine, sp = 0u;
    for (;;) {
        sum = 0u; cnt = 0u; mine = 0u;
#pragma unroll
        for (unsigned j = 0; j < 16; ++j) { const unsigned c = xb_ld(&bar[XB_XCNT(j)]); sum += c; cnt += (c > 0u) ? 1u : 0u; mine = (j == x) ? c : mine; }
        if (sum == G) break;
        __builtin_amdgcn_s_sleep(1);
        if ((++sp & 255u) == 0u) { if (xb_ld(&bar[XB_TMO])) break; if (sp > XB_SPIN_CAP) { atomicAdd(&bar[XB_TMO], 1u); break; } }
    }
    nloc = mine > 0u ? mine : 1u; nx = cnt > 0u ? cnt : 1u;
}

__device__ __forceinline__ void xcd_barrier(const XcdBarrier& b) {
    asm volatile("s_waitcnt vmcnt(0)" ::: "memory");
    __syncthreads();
    if (threadIdx.x == 0) {
        unsigned* bar = b.bar;
        __builtin_amdgcn_s_waitcnt(0);
        unsigned nloc = b.st[0], nx = b.st[1];
        if (nloc == 0u) { xcd_barrier_complete(bar, b.x, nloc, nx); b.st[0] = nloc; b.st[1] = nx; }
        const unsigned old = xb_add(&bar[XB_XSUB(b.x)], 1u);
        const unsigned gen = old / nloc;
        if (old + 1u == (gen + 1u) * nloc) {
            __builtin_amdgcn_fence(__ATOMIC_RELEASE, "agent");
            asm volatile("s_waitcnt vmcnt(0)" ::: "memory");
            const unsigned og = xb_add(&bar[XB_TOP], 1u);
            const unsigned tg = og / nx;
            if (og + 1u == (tg + 1u) * nx) xb_add(&bar[XB_TOPGEN], 1u);
            else XB_SPIN(xb_ld(&bar[XB_TOPGEN]) == tg, bar);
            __builtin_amdgcn_fence(__ATOMIC_ACQUIRE, "agent");
            xb_add(&bar[XB_XGEN(b.x)], 1u);
            asm volatile("s_waitcnt vmcnt(0)" ::: "memory");
        } else {
            XB_SPIN(xb_ld(&bar[XB_XGEN(b.x)]) == gen, bar);
            __builtin_amdgcn_fence(__ATOMIC_ACQUIRE, "agent");
            asm volatile("s_waitcnt vmcnt(0)" ::: "memory");
        }
    }
    __syncthreads();
}
constexpr int NWAVES = 8;
constexpr int D = 1024, NB = 2, SEQ = 16384, CTX = 256, SPB = SEQ + CTX  , MT = NB * SPB  , DEPTH = 2;
constexpr int NWIN = 7936, N1 = 4864, NGATE = 3072, NE = 16, DFF = 1024;
constexpr int PMAX_TILES = 276, PMAX = PMAX_TILES * 256;
constexpr float EPS = 1e-6f;
constexpr float C2 = 0.125f * 1.4426950408889634f;
constexpr size_t MiB = 1u << 20;
constexpr size_t WS_CTL = 0, CTL_ZERO_BYTES = 1 * MiB;
constexpr size_t WS_MOD = 1 * MiB;
constexpr size_t WS_SMALL = 2 * MiB;
constexpr size_t WS_HCTX = 8 * MiB;
constexpr size_t WS_HGU = 10 * MiB, WS_HGS = 26 * MiB;
constexpr size_t WS_WIN = 42 * MiB;
constexpr size_t WS_WABC = 73 * MiB;
constexpr size_t WS_WO = 79 * MiB;
constexpr size_t WS_WEXP = 83 * MiB;
constexpr size_t WS_U = 179 * MiB;
constexpr size_t WS_PA = 244 * MiB;
constexpr size_t WS_PB = 309 * MiB;
constexpr size_t WS_PC = WS_PB + (size_t)MT * 2560 * 2;
constexpr size_t WS_YCAT = WS_PC + (size_t)MT * 768 * 2;
constexpr size_t WS_END = WS_YCAT + (size_t)MT * 1536 * 2;
constexpr size_t WS_GATES = WS_PA;
constexpr size_t WS_XS = WS_PA;
constexpr size_t WS_HID = WS_XS + (size_t)PMAX * 1024 * 2;
constexpr size_t WS_OBUF = WS_PA;
static_assert(WS_GATES + (size_t)MT * 3072 * 2 <= WS_PC, "gates overlay");
static_assert(WS_HID + (size_t)PMAX * 1024 * 2 <= WS_END, "hid overlay");
constexpr size_t SM_RE = 0, SM_RW = 512 * 1024, SM_RP = 1024 * 1024, SM_BCNT = 1536 * 1024, SM_TAB = 1600 * 1024, SM_ROPE = 1664 * 1024;
constexpr int CW_BAR = 4096;
constexpr int RING_BYTES = 131072, LDSCTL_OFF = RING_BYTES, MISC_OFF = LDSCTL_OFF + 320, LDS_BYTES = 147456;

typedef unsigned u32x2v __attribute__((ext_vector_type(2)));
__device__ __forceinline__ float wave_sum(float v) {
#pragma unroll
    for (int o = 1; o < 64; o <<= 1) v += __shfl_xor(v, o);
    return v;
}
__device__ __forceinline__ float bf2f(bf16 h) { return __uint_as_float((unsigned)h << 16); }
__device__ __forceinline__ float sigm_acc(float x) { return 1.0f / (1.0f + __expf(-x)); }
__device__ __forceinline__ const float* hrow(const float* lat, const float* ctx, int r) { const int b = r >= SPB ? 1 : 0, s = r - b * SPB; return s < CTX ? ctx + (size_t)(b * CTX + s) * D : lat + (size_t)(b * SEQ + s - CTX) * D; }
__device__ __forceinline__ int mod_idx(int r) { const int b = r >= SPB ? 1 : 0, s = r - b * SPB; return s < CTX ? 2 : b; }
__device__ __forceinline__ void load_row(const float* p, int lane, f32x4 (&v)[4]) {
#pragma unroll
    for (int j = 0; j < 4; ++j) v[j] = *(const f32x4*)(p + 4 * lane + 256 * j);
}
__device__ __forceinline__ float row_rstd(const f32x4 (&v)[4]) {
    float s = 0.f;
#pragma unroll
    for (int j = 0; j < 4; ++j) s += (v[j][0] * v[j][0] + v[j][1] * v[j][1]) + (v[j][2] * v[j][2] + v[j][3] * v[j][3]);
    return 1.0f / sqrtf(wave_sum(s) * (1.0f / D) + EPS);
}
__device__ __forceinline__ void norm_mod(const f32x4 (&v)[4], const float* gain, const float* sc, const float* sh, int lane, f32x4 (&y)[4]) {
    const float rstd = row_rstd(v);
#pragma unroll
    for (int j = 0; j < 4; ++j) { const int i = 4 * lane + 256 * j; const f32x4 g = *(const f32x4*)(gain + i), c = *(const f32x4*)(sc + i), h = *(const f32x4*)(sh + i);
        y[j] = v[j] * rstd * g * (1.0f + c) + h; }
}
__device__ __forceinline__ void store_row_bf16(bf16* p, int lane, const f32x4 (&y)[4]) {
#pragma unroll
    for (int j = 0; j < 4; ++j) { u32x2v w; w.x = pk2(y[j][0], y[j][1]); w.y = pk2(y[j][2], y[j][3]); *(u32x2v*)(p + 4 * lane + 256 * j) = w; }
}

__device__ __forceinline__ void transpose_item(const float* W, int pitch, bf16* WT, int K, int drow0, int k0, int n0, LAS float* scr, int lane) {
#pragma unroll 8
    for (int i = 0; i < 32; ++i) { const int kk = 2 * i + (lane >> 5); scr[kk * 33 + (lane & 31)] = W[(size_t)(k0 + kk) * pitch + n0 + (lane & 31)]; }
    LDS_WAIT(); asm volatile("" ::: "memory");
    const int c = lane & 7;
#pragma unroll
    for (int j = 0; j < 4; ++j) { const int n = (lane >> 3) + 8 * j; const LAS float* s = scr + (8 * c) * 33 + n;
        v4u o; o.x = pk2(s[0 * 33], s[1 * 33]); o.y = pk2(s[2 * 33], s[3 * 33]); o.z = pk2(s[4 * 33], s[5 * 33]); o.w = pk2(s[6 * 33], s[7 * 33]);
        *(v4u*)(WT + (size_t)(drow0 + n) * K + k0 + 8 * c) = o; }
    LDS_WAIT(); asm volatile("" ::: "memory");
}
__device__ __forceinline__ int win_drow(int n0) {
    if (n0 < 512) return (n0 >> 7) * 256 + (n0 & 127);
    if (n0 < 1024) return 1024 + (n0 - 512);
    if (n0 < 1536) return ((n0 - 1024) >> 7) * 256 + 128 + (n0 & 127);
    return n0;
}
__device__ __forceinline__ void convert_experts(const float* wg, const float* wu, const float* wd, int layer, bf16* WE, LAS float* scr, int gw, int NGW, int lane) {
    const size_t lo = (size_t)layer * NE * D * DFF;
    bf16* GU = WE; bf16* DN = WE + (size_t)NE * 2048 * 1024;
    constexpr int IPM = 16 * 32;
    for (int it = gw; it < 3 * NE * IPM; it += NGW) {
        const int mat = it / IPM, r = it % IPM, kb = r / 32, nb = r % 32, e = mat % NE, kind = mat / NE, n0 = 32 * nb;
        if (kind == 0) transpose_item(wg + lo + (size_t)e * D * DFF, DFF, GU + (size_t)e * 2048 * 1024, 1024, (n0 >> 7) * 256 + (n0 & 127), 64 * kb, n0, scr, lane);
        else if (kind == 1) transpose_item(wu + lo + (size_t)e * D * DFF, DFF, GU + (size_t)e * 2048 * 1024, 1024, (n0 >> 7) * 256 + 128 + (n0 & 127), 64 * kb, n0, scr, lane);
        else transpose_item(wd + lo + (size_t)e * DFF * D, D, DN + (size_t)e * 1024 * 1024, 1024, n0, 64 * kb, n0, scr, lane);
    }
}

__device__ __forceinline__ void attn_naive(unsigned char* lds, const bf16* PC, bf16* YC, int vcu, int G, int tid) {
    float* Ks = (float*)lds; float* Vs = Ks + 64 * 64;
    for (int unit = vcu; unit < 528; unit += G) {
        int b, h, q0, nq, nkeys;
        if (unit < 512) { b = unit >> 8; h = (unit >> 5) & 7; q0 = CTX + (unit & 31) * 512; nq = 512; nkeys = SPB; }
        else { const int x = unit - 512; b = x >> 3; h = x & 7; q0 = 0; nq = 256; nkeys = CTX; }
        const int kvh = h >> 2;
        const int qi = tid < nq ? tid : nq - 1;
        const size_t row = (size_t)b * SPB + q0 + qi;
        float q[64], o[64];
#pragma unroll
        for (int d = 0; d < 64; d += 8) { f32x4 a, c; pg8::ld8(PC + row * 768 + h * 64 + d, a, c); q[d] = a[0]; q[d + 1] = a[1]; q[d + 2] = a[2]; q[d + 3] = a[3]; q[d + 4] = c[0]; q[d + 5] = c[1]; q[d + 6] = c[2]; q[d + 7] = c[3]; }
#pragma unroll
        for (int d = 0; d < 64; ++d) o[d] = 0.f;
        float mrun = -INFINITY, lrun = 0.f;
        for (int kt = 0; kt < nkeys; kt += 64) {
            __syncthreads();
            { const int key = tid >> 3, d0 = (tid & 7) * 8; const size_t kr = ((size_t)b * SPB + kt + key) * 768;
              f32x4 a, c; pg8::ld8(PC + kr + 512 + kvh * 64 + d0, a, c); *(f32x4*)(Ks + key * 64 + d0) = a; *(f32x4*)(Ks + key * 64 + d0 + 4) = c;
              pg8::ld8(PC + kr + 640 + kvh * 64 + d0, a, c); *(f32x4*)(Vs + key * 64 + d0) = a; *(f32x4*)(Vs + key * 64 + d0 + 4) = c; }
            __syncthreads();
#pragma unroll 1
            for (int j = 0; j < 64; ++j) { const float* kp = Ks + j * 64; const float* vp = Vs + j * 64; float a = 0.f;
#pragma unroll
                for (int d = 0; d < 64; d += 4) { const f32x4 kv = *(const f32x4*)(kp + d); a += q[d] * kv[0]; a += q[d + 1] * kv[1]; a += q[d + 2] * kv[2]; a += q[d + 3] * kv[3]; }
                if (a > mrun) { const float alpha = __builtin_amdgcn_exp2f(mrun - a); lrun *= alpha; mrun = a;
#pragma unroll
                    for (int d = 0; d < 64; ++d) o[d] *= alpha; }
                const float pj = __builtin_amdgcn_exp2f(a - mrun); lrun += pj;
#pragma unroll
                for (int d = 0; d < 64; d += 4) { const f32x4 vv = *(const f32x4*)(vp + d); o[d] += pj * vv[0]; o[d + 1] += pj * vv[1]; o[d + 2] += pj * vv[2]; o[d + 3] += pj * vv[3]; }
            }
        }
        if (tid < nq) { const float il = 1.0f / lrun; bf16* op = YC + row * 1536 + 1024 + h * 64;
#pragma unroll
            for (int d = 0; d < 64; d += 8) pg8::st8(op + d, (f32x4){o[d] * il, o[d + 1] * il, o[d + 2] * il, o[d + 3] * il}, (f32x4){o[d + 4] * il, o[d + 5] * il, o[d + 6] * il, o[d + 7] * il}); }
    }
    __syncthreads();
}

__device__ __forceinline__ void hgrn_naive(const bf16* PB, bf16* OB, const float* lbp, int layer, int gw, int NGW, int lane) {
    for (int wu = gw; wu < 2048; wu += NGW) {
        const int chain = wu >> 7, v = wu & 127, b = chain >> 3, hd = (chain >> 1) & 3, dir = chain & 1;
        float lb0 = 0.f, lb1 = 0.f;
        if (layer > 0) { const int c0 = dir * 512 + hd * 128 + lane; lb0 = sigm_acc(lbp[1024 + c0] - lbp[c0]); lb1 = sigm_acc(lbp[1024 + c0 + 64] - lbp[c0 + 64]); }
        float S0 = 0.f, S1 = 0.f;
        for (int tb = 0; tb < SPB; tb += 8) {
            float q0[8], q1[8], z0[8], z1[8], vv[8]; int rr[8];
#pragma unroll
            for (int i = 0; i < 8; ++i) { const int tau = tb + i; const int s = dir == 0 ? tau : (tau < CTX ? CTX - 1 - tau : SPB + CTX - 1 - tau); const int r = b * SPB + s; rr[i] = r;
                const bf16* p = PB + (size_t)r * 2560 + hd * 128;
                q0[i] = bf2f(p[lane]); q1[i] = bf2f(p[lane + 64]); z0[i] = bf2f(p[512 + dir * 512 + lane]); z1[i] = bf2f(p[512 + dir * 512 + lane + 64]); vv[i] = bf2f(p[1536 + v]); }
            float part[8];
#pragma unroll
            for (int i = 0; i < 8; ++i) {
                const float e0 = __expf(z0[i]), e1 = __expf(z1[i]);
                const float n0 = 1.0f / (1.0f + e0), n1 = 1.0f / (1.0f + e1);
                const float k0 = (1.0f - lb0) * n0, k1 = (1.0f - lb1) * n1, f0 = 1.0f - k0, f1 = 1.0f - k1;
                S0 = f0 * S0 + k0 * vv[i]; S1 = f1 * S1 + k1 * vv[i];
                part[i] = S0 * q0[i] + S1 * q1[i]; }
#pragma unroll
            for (int i = 0; i < 8; ++i) part[i] = wave_sum(part[i]);
            float mine = part[0]; int myr = rr[0];
#pragma unroll
            for (int i = 1; i < 8; ++i) if (lane == i) { mine = part[i]; myr = rr[i]; }
            if (lane < 8) OB[((size_t)dir * MT + myr) * 512 + hd * 128 + v] = (bf16)f2bf(mine);
        }
    }
}
constexpr int NPL = 17;
constexpr int NPHASE = 2 + DEPTH * NPL;
struct Args { const float* in[24]; float* out; unsigned char* ws; int ph_lo, ph_hi, li, pad; };
enum { I_X = 0, I_C, I_CTX, I_CCTX, I_WMOD, I_BMOD, I_N1G, I_N2G, I_WIN, I_CONVW, I_LBP, I_HNG, I_QNG, I_KNG, I_WA, I_WB, I_WC, I_WOUT, I_RW, I_RB, I_WG, I_WU, I_WD, I_FG };

typedef __attribute__((address_space(4))) const Args CArgs;
__device__ __forceinline__ const CArgs* kap() { const CArgs* p = (const CArgs*)__builtin_amdgcn_kernarg_segment_ptr(); asm volatile("" : "+s"(p)); return p; }
#define IN(k) (lo <= (k) && (k) < hi)
#define PHASE_VARS int tid_ = threadIdx.x; asm volatile("" : "+v"(tid_)); const int tid = tid_, lane = tid_ & 63; (void)tid; (void)lane; PHASE_PTRS
#define PHASE_PTRS const CArgs* A = kap(); unsigned char* ws = A->ws; (void)ws;
#define WSP(T, off) ((T*)(ws + (off)))
#define SEAM(k) do { if (IN(k) && IN((k) + 1)) xcd_barrier(bar); } while (0)
template <int LAYER> __device__ __forceinline__ void layer_phases(const int lo, const int hi, const XcdBarrier& bar, unsigned char* lds) {
    constexpr int layer = LAYER;
    LAS unsigned char* ldsl = (LAS unsigned char*)lds;
    const int wave = __builtin_amdgcn_readfirstlane((int)threadIdx.x >> 6);
    const int G = gridDim.x; const int bx = blockIdx.x; const int vcu = (G % 8 == 0) ? (bx % 8) * (G / 8) + bx / 8 : bx;
    const int gw = vcu * NWAVES + wave, NGW = G * NWAVES;
    LAS float* scr = (LAS float*)(ldsl + wave * 16384); (void)scr;
        const int pb = 2 + layer * NPL;
        if (IN(pb + 0)) { PHASE_PTRS
            pg8::Gemm g{WSP(bf16, WS_U), WSP(bf16, WS_WIN) + (size_t)layer * NWIN * D, MT, N1, D, D}; pg8::StaticOrder S; S.init(MT, N1, G, bx);
            pg8::EpiW1 E{WSP(bf16, WS_PA), WSP(bf16, WS_PB), WSP(bf16, WS_PC)};
            pg8::gemm_phase<pg8::EpiW1, pg8::StaticOrder, true, true>(ldsl, g, S, E);
        }
        SEAM(pb + 0);
        if (IN(pb + 1)) { PHASE_VARS
            const float* cw = A->in[I_CONVW] + layer * 3 * 512; const float* qg = A->in[I_QNG] + layer * 64; const float* kg = A->in[I_KNG] + layer * 64;
            for (int r = gw; r < MT; r += NGW) {
                const int b = r >= SPB ? 1 : 0, s = r - b * SPB; const bool first = (s == 0 || s == CTX), last = (s == CTX - 1 || s == SPB - 1);
                { const bf16* pa = WSP(bf16, WS_PA) + (size_t)r * 1024 + 8 * lane; f32x4 x0a, x0b, xma = {0.f, 0.f, 0.f, 0.f}, xmb = xma, xpa = xma, xpb = xma, aba, abb;
                  pg8::ld8(pa, x0a, x0b); if (!first) pg8::ld8(pa - 1024, xma, xmb); if (!last) pg8::ld8(pa + 1024, xpa, xpb); pg8::ld8(pa + 512, aba, abb);
                  const f32x4 w0a = *(const f32x4*)(cw + 8 * lane), w0b = *(const f32x4*)(cw + 8 * lane + 4), w1a = *(const f32x4*)(cw + 512 + 8 * lane), w1b = *(const f32x4*)(cw + 512 + 8 * lane + 4),
                              w2a = *(const f32x4*)(cw + 1024 + 8 * lane), w2b = *(const f32x4*)(cw + 1024 + 8 * lane + 4);
                  pg8::st8(WSP(bf16, WS_YCAT) + (size_t)r * 1536 + 8 * lane, aba * (w0a * xma + w1a * x0a + w2a * xpa), abb * (w0b * xmb + w1b * x0b + w2b * xpb)); }
                bf16* pc = WSP(bf16, WS_PC) + (size_t)r * 768;
                const int t = s - CTX; const int ti = lane < 32 ? (t >> 6) : 256 + (t & 63);
                float cs = 1.f, sn = 0.f; if (s >= CTX) { cs = WSP(float, WS_SMALL + SM_ROPE)[2 * (ti * 16 + (lane & 15))]; sn = WSP(float, WS_SMALL + SM_ROPE)[2 * (ti * 16 + (lane & 15)) + 1]; }
#pragma unroll
                for (int hh = 0; hh < 10; ++hh) { const float xv = bf2f(pc[hh * 64 + lane]); const float ss = wave_sum(xv * xv);
                    float y = xv * (1.0f / sqrtf(ss * (1.0f / 64.0f) + EPS)) * (hh < 8 ? qg[lane] : kg[lane]);
                    const float pr = __shfl_xor(y, 16); y = y * cs + ((lane & 16) ? pr : -pr) * sn;
                    if (hh < 8) y *= C2;
                    pc[hh * 64 + lane] = (bf16)f2bf(y); }
            }
            if (layer > 0) convert_experts(A->in[I_WG], A->in[I_WU], A->in[I_WD], layer, WSP(bf16, WS_WEXP), scr, gw, NGW, lane);
        }
        SEAM(pb + 1);
        if (IN(pb + 2)) { PHASE_VARS attn_naive(lds, WSP(bf16, WS_PC), WSP(bf16, WS_YCAT), vcu, G, tid); }
        SEAM(pb + 2);
        if (IN(pb + 3)) { PHASE_VARS hgrn_naive(WSP(bf16, WS_PB), WSP(bf16, WS_OBUF), A->in[I_LBP], layer, gw, NGW, lane); }
        SEAM(pb + 3);
        SEAM(pb + 4);
        SEAM(pb + 5);
        if (IN(pb + 6)) { PHASE_VARS
            const float* hg = A->in[I_HNG] + layer * 512;
            for (int r = gw; r < MT; r += NGW) { f32x4 a0, a1, b0, b1, g0, g1;
                pg8::ld8(WSP(bf16, WS_OBUF) + (size_t)r * 512 + 8 * lane, a0, a1); pg8::ld8(WSP(bf16, WS_OBUF) + ((size_t)MT + r) * 512 + 8 * lane, b0, b1); pg8::ld8(WSP(bf16, WS_PB) + (size_t)r * 2560 + 2048 + 8 * lane, g0, g1);
                a0 += b0; a1 += b1; float ss = (a0[0] * a0[0] + a0[1] * a0[1]) + (a0[2] * a0[2] + a0[3] * a0[3]) + (a1[0] * a1[0] + a1[1] * a1[1]) + (a1[2] * a1[2] + a1[3] * a1[3]);
                ss += __shfl_xor(ss, 1); ss += __shfl_xor(ss, 2); ss += __shfl_xor(ss, 4); ss += __shfl_xor(ss, 8);
                const float rs = 1.0f / sqrtf(ss * (1.0f / 128.0f) + EPS);
                const f32x4 n0 = *(const f32x4*)(hg + 8 * lane), n1 = *(const f32x4*)(hg + 8 * lane + 4);
                pg8::st8(WSP(bf16, WS_YCAT) + (size_t)r * 1536 + 512 + 8 * lane, a0 * rs * n0 * g0, a1 * rs * n1 * g1); }
        }
        SEAM(pb + 6);
        if (IN(pb + 7)) { PHASE_PTRS
            pg8::Gemm g{WSP(bf16, WS_U), WSP(bf16, WS_WIN) + (size_t)layer * NWIN * D + (size_t)N1 * D, MT, NGATE, D, D}; pg8::StaticOrder S; S.init(MT, NGATE, G, bx);
            pg8::EpiGate E{WSP(bf16, WS_GATES)};
            pg8::gemm_phase<pg8::EpiGate, pg8::StaticOrder, true, true>(ldsl, g, S, E);
        }
        SEAM(pb + 7);
        if (IN(pb + 8)) { PHASE_PTRS pg8::Gemm g{WSP(bf16, WS_YCAT), WSP(bf16, WS_WABC) + (size_t)(layer * 3 + 0) * D * 512, MT, D, 512, 1536}; pg8::StaticOrder S; S.init(MT, D, G, bx); pg8::EpiMerge<0> E{WSP(bf16, WS_GATES), WSP(bf16, WS_U)};
            pg8::gemm_phase<pg8::EpiMerge<0>, pg8::StaticOrder, true, true>(ldsl, g, S, E); }
        SEAM(pb + 8);
        if (IN(pb + 9)) { PHASE_PTRS pg8::Gemm g{WSP(bf16, WS_YCAT) + 512, WSP(bf16, WS_WABC) + (size_t)(layer * 3 + 1) * D * 512, MT, D, 512, 1536}; pg8::StaticOrder S; S.init(MT, D, G, bx); pg8::EpiMerge<1> E{WSP(bf16, WS_GATES), WSP(bf16, WS_U)};
            pg8::gemm_phase<pg8::EpiMerge<1>, pg8::StaticOrder, true, true>(ldsl, g, S, E); }
        SEAM(pb + 9);
        if (IN(pb + 10)) { PHASE_PTRS pg8::Gemm g{WSP(bf16, WS_YCAT) + 1024, WSP(bf16, WS_WABC) + (size_t)(layer * 3 + 2) * D * 512, MT, D, 512, 1536}; pg8::StaticOrder S; S.init(MT, D, G, bx); pg8::EpiMerge<2> E{WSP(bf16, WS_GATES), WSP(bf16, WS_U)};
            pg8::gemm_phase<pg8::EpiMerge<2>, pg8::StaticOrder, true, true>(ldsl, g, S, E); }
        SEAM(pb + 10);
        if (IN(pb + 11)) { PHASE_PTRS pg8::Gemm g{WSP(bf16, WS_U), WSP(bf16, WS_WO) + (size_t)layer * D * D, MT, D, D, D}; pg8::StaticOrder S; S.init(MT, D, G, bx); pg8::EpiWo E{(layer == 0 ? A->in[I_X] : (const float*)A->out), (layer == 0 ? A->in[I_CTX] : (const float*)WSP(float, WS_HCTX)), A->out, WSP(float, WS_HCTX), (WSP(float, WS_MOD) + (size_t)layer * 3 * 6144)};
            pg8::gemm_phase<pg8::EpiWo, pg8::StaticOrder, true, true>(ldsl, g, S, E); }
        SEAM(pb + 11);
        if (IN(pb + 12)) { PHASE_VARS
            int* lcnt = (int*)lds;
            if (tid < 16) lcnt[tid] = 0;
            __syncthreads();
            const float* rw = A->in[I_RW]; const float* rb = A->in[I_RB];
            for (int r = gw; r < MT; r += NGW) { f32x4 v[4], y[4]; load_row(hrow(A->out, WSP(float, WS_HCTX), r), lane, v);
                const float* m = (WSP(float, WS_MOD) + (size_t)layer * 3 * 6144) + (size_t)mod_idx(r) * 6144; norm_mod(v, A->in[I_N2G] + layer * D, m + 4 * 1024, m + 3 * 1024, lane, y); store_row_bf16(WSP(bf16, WS_U) + (size_t)r * D, lane, y);
                float lg[16];
#pragma unroll
                for (int e = 0; e < 16; ++e) lg[e] = 0.f;
#pragma unroll
                for (int j = 0; j < 4; ++j)
#pragma unroll
                    for (int i = 0; i < 4; ++i) { const float* wr_ = rw + (size_t)(4 * lane + 256 * j + i) * 16; const float yv = y[j][i];
#pragma unroll
                        for (int e4 = 0; e4 < 4; ++e4) { const f32x4 w = *(const f32x4*)(wr_ + 4 * e4); lg[4 * e4] += yv * w[0]; lg[4 * e4 + 1] += yv * w[1]; lg[4 * e4 + 2] += yv * w[2]; lg[4 * e4 + 3] += yv * w[3]; } }
#pragma unroll
                for (int e = 0; e < 16; ++e) lg[e] = wave_sum(lg[e]);
                float bestg = 0.f, w0 = 0.f, w1 = 0.f; int i0 = 0, i1 = 1;
#pragma unroll
                for (int gq = 0; gq < 4; ++gq) { float m1v = 0.f, m2v = 0.f, s1 = 0.f, s2 = 0.f; int m1i = 0, m2i = 0;
#pragma unroll
                    for (int k = 0; k < 4; ++k) { const int e = 4 * gq + k; const float scv = sigm_acc(lg[e]); const float sel = scv + rb[e];
                        if (k == 0) { m1v = sel; m1i = e; s1 = scv; m2v = -INFINITY; m2i = e; s2 = 0.f; }
                        else if (sel > m1v) { m2v = m1v; m2i = m1i; s2 = s1; m1v = sel; m1i = e; s1 = scv; }
                        else if (sel > m2v) { m2v = sel; m2i = e; s2 = scv; } }
                    const float gs = m1v + m2v;
                    if (gq == 0 || gs > bestg) { bestg = gs; i0 = m1i; i1 = m2i; w0 = s1; w1 = s2; } }
                if (lane == 0) { const float inv = 1.0f / (w0 + w1); const int k0 = atomicAdd(&lcnt[i0], 1), k1 = atomicAdd(&lcnt[i1], 1);
                    WSP(int, WS_SMALL + SM_RE)[2 * r] = i0; WSP(int, WS_SMALL + SM_RE)[2 * r + 1] = i1; WSP(float, WS_SMALL + SM_RW)[2 * r] = w0 * inv; WSP(float, WS_SMALL + SM_RW)[2 * r + 1] = w1 * inv; WSP(int, WS_SMALL + SM_RP)[2 * r] = k0; WSP(int, WS_SMALL + SM_RP)[2 * r + 1] = k1; }
            }
            __syncthreads();
            if (tid < 16) WSP(int, WS_SMALL + SM_BCNT)[vcu * 16 + tid] = lcnt[tid];
            __syncthreads();
        }
        SEAM(pb + 12);
        if (IN(pb + 13)) { PHASE_VARS
            int* ltot = (int*)lds; int* lbef = ltot + 16; int* lbase = ltot + 32;
            if (tid < 16) { int tot = 0, bef = 0; for (int b2 = 0; b2 < G; ++b2) { const int c = WSP(int, WS_SMALL + SM_BCNT)[b2 * 16 + tid]; tot += c; if (b2 < vcu) bef += c; } ltot[tid] = tot; lbef[tid] = bef; }
            __syncthreads();
            if (tid == 0) { int run = 0;
                for (int e = 0; e < 16; ++e) { const int pad = (ltot[e] + 255) / 256 * 256; lbase[e] = run + lbef[e];
                    if (vcu == 0) for (int t2 = run / 256; t2 < (run + pad) / 256; ++t2) WSP(int, WS_SMALL + SM_TAB)[1 + t2] = e;
                    run += pad; }
                if (vcu == 0) WSP(int, WS_SMALL + SM_TAB)[0] = run / 256; }
            __syncthreads();
            for (int r = gw; r < MT; r += NGW) {
                const int p0 = lbase[WSP(int, WS_SMALL + SM_RE)[2 * r]] + WSP(int, WS_SMALL + SM_RP)[2 * r], p1 = lbase[WSP(int, WS_SMALL + SM_RE)[2 * r + 1]] + WSP(int, WS_SMALL + SM_RP)[2 * r + 1];
                asm volatile("" ::: "memory");
                if (lane == 0) { WSP(int, WS_SMALL + SM_RP)[2 * r] = p0; WSP(int, WS_SMALL + SM_RP)[2 * r + 1] = p1; }
                const v4u a = *(const v4u*)(WSP(bf16, WS_U) + (size_t)r * D + 16 * lane), c = *(const v4u*)(WSP(bf16, WS_U) + (size_t)r * D + 16 * lane + 8);
                *(v4u*)(WSP(bf16, WS_XS) + (size_t)p0 * D + 16 * lane) = a; *(v4u*)(WSP(bf16, WS_XS) + (size_t)p0 * D + 16 * lane + 8) = c;
                *(v4u*)(WSP(bf16, WS_XS) + (size_t)p1 * D + 16 * lane) = a; *(v4u*)(WSP(bf16, WS_XS) + (size_t)p1 * D + 16 * lane + 8) = c; }
            __syncthreads();
        }
        SEAM(pb + 13);
        if (IN(pb + 14)) { PHASE_PTRS pg8::Gemm g{WSP(bf16, WS_XS), WSP(bf16, WS_WEXP), PMAX, 2048, D, D}; pg8::MoeOrder S; S.init(WSP(int, WS_SMALL + SM_TAB), 8, G, vcu); pg8::EpiMoe1 E{WSP(bf16, WS_HID)};
            pg8::gemm_phase<pg8::EpiMoe1, pg8::MoeOrder, true, true>(ldsl, g, S, E); }
        SEAM(pb + 14);
        if (IN(pb + 15)) { PHASE_PTRS pg8::Gemm g{WSP(bf16, WS_HID), WSP(bf16, WS_WEXP) + (size_t)NE * 2048 * 1024, PMAX, 1024, DFF, DFF}; pg8::MoeOrder S; S.init(WSP(int, WS_SMALL + SM_TAB), 4, G, vcu); pg8::EpiMoe2 E{WSP(bf16, WS_XS)};
            pg8::gemm_phase<pg8::EpiMoe2, pg8::MoeOrder, true, true>(ldsl, g, S, E); }
        SEAM(pb + 15);
        if (IN(pb + 16)) { PHASE_VARS
            for (int r = gw; r < MT; r += NGW) {
                const int mi = mod_idx(r); if (layer == DEPTH - 1 && mi == 2) continue;
                f32x4 v[4]; float* hp = (float*)hrow(A->out, WSP(float, WS_HCTX), r); load_row(hp, lane, v);
                const int p0 = WSP(int, WS_SMALL + SM_RP)[2 * r], p1 = WSP(int, WS_SMALL + SM_RP)[2 * r + 1]; const float w0 = WSP(float, WS_SMALL + SM_RW)[2 * r], w1 = WSP(float, WS_SMALL + SM_RW)[2 * r + 1];
                const float* g2 = (WSP(float, WS_MOD) + (size_t)layer * 3 * 6144) + (size_t)mi * 6144 + 5 * 1024;
#pragma unroll
                for (int j = 0; j < 4; ++j) { const int c = 4 * lane + 256 * j; const u32x2v a = *(const u32x2v*)(WSP(bf16, WS_XS) + (size_t)p0 * D + c), b2 = *(const u32x2v*)(WSP(bf16, WS_XS) + (size_t)p1 * D + c); const f32x4 gg = *(const f32x4*)(g2 + c);
                    const f32x4 ya = {pg8::bflo(a.x), pg8::bfhi(a.x), pg8::bflo(a.y), pg8::bfhi(a.y)}, yb = {pg8::bflo(b2.x), pg8::bfhi(b2.x), pg8::bflo(b2.y), pg8::bfhi(b2.y)};
                    v[j] += gg * (ya * w0 + yb * w1); }
                if (layer < DEPTH - 1) {
#pragma unroll
                    for (int j = 0; j < 4; ++j) *(f32x4*)(hp + 4 * lane + 256 * j) = v[j];
                    f32x4 y[4]; const float* m = WSP(float, WS_MOD) + (size_t)((layer + 1) * 3 + mi) * 6144; norm_mod(v, A->in[I_N1G] + (layer + 1) * D, m + 1024, m, lane, y); store_row_bf16(WSP(bf16, WS_U) + (size_t)r * D, lane, y);
                } else {
                    const float rstd = row_rstd(v); const float* fg = A->in[I_FG];
#pragma unroll
                    for (int j = 0; j < 4; ++j) *(f32x4*)(hp + 4 * lane + 256 * j) = v[j] * rstd * *(const f32x4*)(fg + 4 * lane + 256 * j);
                }
            }
        }
        SEAM(pb + 16);
    }
__global__ void __launch_bounds__(NWAVES * 64, 2) fwd(Args args) {
    extern __shared__ __attribute__((aligned(16))) unsigned char lds[];
    LAS unsigned char* ldsl = (LAS unsigned char*)lds;
    volatile LAS unsigned* MISC = (volatile LAS unsigned*)(ldsl + MISC_OFF);
    const int tid = threadIdx.x, lane = tid & 63, wave = __builtin_amdgcn_readfirstlane(tid >> 6);
    const int G = gridDim.x; const int bx = blockIdx.x; const int vcu = (G % 8 == 0) ? (bx % 8) * (G / 8) + bx / 8 : bx;
    const int gw = vcu * NWAVES + wave, NGW = G * NWAVES;
    gu32* ctl = (gu32*)(args.ws + WS_CTL);
    for (int u = tid; u < (LDS_BYTES - LDSCTL_OFF) / 4; u += NWAVES * 64) ((LAS unsigned*)(ldsl + LDSCTL_OFF))[u] = 0u;
    __syncthreads();
    const int lo = args.ph_lo, hi = args.ph_hi;
    const bool multi = (hi - lo) > 1;
    XcdBarrier bar; bar.bar = (unsigned*)(ctl + CW_BAR) + args.li * XCD_BAR_WORDS; bar.x = 0; bar.st = nullptr;
    if (multi) bar = xcd_barrier_post((unsigned*)(ctl + CW_BAR) + args.li * XCD_BAR_WORDS, MISC + 8);

    LAS float* scr = (LAS float*)(ldsl + wave * 16384);

    if (IN(0)) { PHASE_VARS
        for (int it = gw; it < DEPTH * 16 * 248; it += NGW) { const int l = it / (16 * 248), r = it % (16 * 248), kb = r / 248, nb = r % 248;
            transpose_item(A->in[I_WIN] + (size_t)l * D * NWIN, NWIN, WSP(bf16, WS_WIN) + (size_t)l * NWIN * D, D, win_drow(32 * nb), 64 * kb, 32 * nb, scr, lane); }
        for (int it = gw; it < DEPTH * 3 * 256; it += NGW) { const int mat = it / 256, r = it % 256, kb = r / 32, nb = r % 32, l = mat / 3, br = mat % 3;
            const float* W = (br == 0 ? A->in[I_WA] : br == 1 ? A->in[I_WB] : A->in[I_WC]) + (size_t)l * 512 * D;
            transpose_item(W, D, WSP(bf16, WS_WABC) + (size_t)(l * 3 + br) * D * 512, 512, 32 * nb, 64 * kb, 32 * nb, scr, lane); }
        for (int it = gw; it < DEPTH * 512; it += NGW) { const int l = it / 512, r = it % 512, kb = r / 32, nb = r % 32;
            transpose_item(A->in[I_WOUT] + (size_t)l * D * D, D, WSP(bf16, WS_WO) + (size_t)l * D * D, D, 32 * nb, 64 * kb, 32 * nb, scr, lane); }
        convert_experts(A->in[I_WG], A->in[I_WU], A->in[I_WD], 0, WSP(bf16, WS_WEXP), scr, gw, NGW, lane);
        __syncthreads();
        { float* sc = (float*)lds;
          float* red = sc + 3 * 1024;
          for (int i = tid; i < 3 * 1024; i += NWAVES * 64) { const int j = i >> 10, k = i & 1023; const float c = j < 2 ? A->in[I_C][j * 1024 + k] : A->in[I_CCTX][k]; sc[i] = c * sigm_acc(c); }
          __syncthreads();
          for (int unit = vcu; unit < DEPTH * 96; unit += G) { const int l = unit / 96, cg = unit % 96, col = cg * 64 + lane;
              const float* W = A->in[I_WMOD] + (size_t)l * D * 6144 + col; float a0 = 0.f, a1 = 0.f, a2 = 0.f;
#pragma unroll 8
              for (int k = wave * 128; k < wave * 128 + 128; ++k) { const float w = W[(size_t)k * 6144]; a0 += sc[k] * w; a1 += sc[1024 + k] * w; a2 += sc[2048 + k] * w; }
              red[(wave * 3 + 0) * 64 + lane] = a0; red[(wave * 3 + 1) * 64 + lane] = a1; red[(wave * 3 + 2) * 64 + lane] = a2;
              __syncthreads();
              if (tid < 192) { const int j = tid >> 6, ln = tid & 63; float s = 0.f;
#pragma unroll
                  for (int w = 0; w < 8; ++w) s += red[(w * 3 + j) * 64 + ln];
                  const int c = cg * 64 + ln; WSP(float, WS_MOD)[(size_t)(l * 3 + j) * 6144 + c] = s + A->in[I_BMOD][l * 6144 + c]; }
              __syncthreads(); }
        }
        for (int i = gw * 64 + lane; i < 320 * 16; i += NGW * 64) { const int pos = (i >> 4) < 256 ? (i >> 4) : (i >> 4) - 256, fi = i & 15;
            const float inv = __builtin_amdgcn_exp2f(-(float)(2 * fi) * (13.287712379549449f / 32.0f)); const float a = (float)pos * inv;
            const double ad = (double)a; const double rev = ad * 0.15915494309189535; const double fr = rev - __builtin_rint(rev); const float red = (float)(fr * 6.283185307179586);
            WSP(float, WS_SMALL + SM_ROPE)[2 * i] = __cosf(red); WSP(float, WS_SMALL + SM_ROPE)[2 * i + 1] = __sinf(red); }
    }
    SEAM(0);
    if (IN(1)) { PHASE_VARS
        for (int r = gw; r < MT; r += NGW) { f32x4 v[4], y[4]; load_row(hrow(A->in[I_X], A->in[I_CTX], r), lane, v);
            const float* m = WSP(float, WS_MOD) + (size_t)(0 * 3 + mod_idx(r)) * 6144; norm_mod(v, A->in[I_N1G], m + 1024, m, lane, y); store_row_bf16(WSP(bf16, WS_U) + (size_t)r * D, lane, y); }
    }
    SEAM(1);

    layer_phases<0>(lo, hi, bar, lds);
    layer_phases<1>(lo, hi, bar, lds);
#undef PHASE_VARS
#undef PHASE_PTRS
#undef WSP
#undef IN
#undef SEAM
}

extern "C" void kernel_launch(void* const* d_in, const int* in_sizes, int n_in, void* d_out, int out_size, void* d_ws, size_t ws_size, hipStream_t stream) {
    static int grid = 0;
    if (grid == 0) {
        if (n_in != 24 || out_size != NB * SEQ * D || ws_size < WS_END) { fprintf(stderr, "kernel_launch: unexpected shapes (n_in %d, out %d, ws %zu < %zu); nothing launched\n", n_in, out_size, ws_size, (size_t)WS_END); grid = -1; return; }
        int dev = 0, cus = 0, per_cu = 0;
        if (hipGetDevice(&dev) != hipSuccess || hipDeviceGetAttribute(&cus, hipDeviceAttributeMultiprocessorCount, dev) != hipSuccess) { grid = -1; return; }
        if (hipFuncSetAttribute((const void*)fwd, hipFuncAttributeMaxDynamicSharedMemorySize, LDS_BYTES) != hipSuccess) { fprintf(stderr, "kernel_launch: hipFuncSetAttribute failed\n"); grid = -1; return; }
        if (hipOccupancyMaxActiveBlocksPerMultiprocessor(&per_cu, (const void*)fwd, NWAVES * 64, LDS_BYTES) != hipSuccess || per_cu < 1) { fprintf(stderr, "kernel_launch: occupancy query says %d\n", per_cu); }
        (void)hipGetLastError();
        grid = cus;
    }
    if (grid < 0) return;
    if (hipMemsetAsync((char*)d_ws + WS_CTL, 0, CTL_ZERO_BYTES, stream) != hipSuccess) return;
    Args a{};
    for (int i = 0; i < 24; ++i) a.in[i] = (const float*)d_in[i];
    a.out = (float*)d_out; a.ws = (unsigned char*)d_ws;
#ifndef MK_ONE_LAUNCH
#define MK_ONE_LAUNCH 1
#endif
    if (MK_ONE_LAUNCH) { a.ph_lo = 0; a.ph_hi = NPHASE; a.li = 0; hipLaunchKernelGGL(fwd, dim3(grid), dim3(NWAVES * 64), LDS_BYTES, stream, a); }
    else for (int ph = 0; ph < NPHASE; ++ph) { a.ph_lo = ph; a.ph_hi = ph + 1; a.li = 0; hipLaunchKernelGGL(fwd, dim3(grid), dim3(NWAVES * 64), LDS_BYTES, stream, a); }
}
```

```cpp
#include <hip/hip_runtime.h>
#include <cstdio>
#include <cstdint>
#include <cmath>
#include <hip/hip_bf16.h>
#ifndef ATTN_NSUM
#define ATTN_NSUM 4
#endif
namespace pg8 {
#define PG8_LAS __attribute__((address_space(3)))
typedef unsigned short bf16_t;
typedef short bf16x8 __attribute__((ext_vector_type(8)));
typedef float f32x4 __attribute__((ext_vector_type(4)));
typedef unsigned u32x4 __attribute__((ext_vector_type(4)));
typedef int v4i_t __attribute__((ext_vector_type(4)));
typedef int v8i_t __attribute__((ext_vector_type(8)));
constexpr int BM = 256, BK = 64, HALF = 128, HTB = HALF * BK * 2  , STAGE_BYTES = 8 * HTB, NXCD = 8, WGM = 8;

__host__ __device__ __forceinline__ int lds_byte(int r, int c) { const int st = (r >> 4) * 2 + (c >> 5), rr = r & 15, cc = c & 31, ob = rr * 64 + cc * 2; return st * 1024 + (ob ^ (((ob >> 9) & 1) << 5)); }
__host__ __device__ __forceinline__ void stage_rc(int b, int& R, int& C) { const int st = b / 1024, sb = b % 1024, swz = sb ^ (((sb >> 9) & 1) << 5); R = (st >> 1) * 16 + swz / 64; C = (st & 1) * 32 + (swz % 64) / 2; }
__host__ __device__ __forceinline__ int perm32(int rho) { const int n = rho >> 4, i = rho & 15; return 8 * (i >> 2) + 4 * n + (i & 3); }

struct Unit { int pm, pn, seg; };
struct Gemm { const bf16_t* A; const bf16_t* Bt; int M, N, K, lda; size_t segA, segB; };

struct StaticOrder {
    int nM, nN, nwg, G, c;
    __host__ __device__ void init(int M, int N, int G_, int c_) { nM = M / BM; nN = N / BM; nwg = nM * nN; G = G_; c = c_; }
    __host__ __device__ bool next(int i, Unit& u) const {
        const long L = (long)i * G + c; if (L >= nwg) return false;
        int wgid = (int)L; { const int q = nwg / NXCD, r = nwg % NXCD, xcd = wgid % NXCD, off = wgid / NXCD; wgid = (xcd < r ? xcd * (q + 1) : r * (q + 1) + (xcd - r) * q) + off; }
        const int nig = WGM * nN, gid = wgid / nig, fm = gid * WGM, gsz = (nM - fm) < WGM ? (nM - fm) : WGM;
        u.pm = fm + ((wgid % nig) % gsz); u.pn = (wgid % nig) / gsz; u.seg = 0; return true;
    }
    __device__ __forceinline__ void a_ready(const Unit&) const {}
    __device__ __forceinline__ void done(const Unit&) const {}
};

typedef float f32x2c __attribute__((ext_vector_type(2))); typedef __bf16 bf16x2c __attribute__((ext_vector_type(2)));
__device__ __forceinline__ unsigned cvt_pk_bf16(float lo, float hi) { const f32x2c v = {lo, hi}; const bf16x2c b = __builtin_convertvector(v, bf16x2c); return __builtin_bit_cast(unsigned, b); }
typedef float f32x2 __attribute__((ext_vector_type(2)));
typedef unsigned u32x2 __attribute__((ext_vector_type(2)));
__device__ __forceinline__ float fsigmoid(float x) { return __builtin_amdgcn_rcpf(1.0f + __builtin_amdgcn_exp2f(-1.4426950408889634f * x)); }
__device__ __forceinline__ float fsilu(float x) { return x * fsigmoid(x); }
__device__ __forceinline__ f32x4 silu4(f32x4 v) { return (f32x4){fsilu(v[0]), fsilu(v[1]), fsilu(v[2]), fsilu(v[3])}; }
__device__ __forceinline__ f32x4 sigm4(f32x4 v) { return (f32x4){fsigmoid(v[0]), fsigmoid(v[1]), fsigmoid(v[2]), fsigmoid(v[3])}; }
__device__ __forceinline__ void st8(bf16_t* p, const f32x4 a, const f32x4 b) {
    u32x4 w; w.x = cvt_pk_bf16(a[0], a[1]); w.y = cvt_pk_bf16(a[2], a[3]); w.z = cvt_pk_bf16(b[0], b[1]); w.w = cvt_pk_bf16(b[2], b[3]); *(u32x4*)p = w; }
__device__ __forceinline__ float bflo(unsigned w) { return __uint_as_float(w << 16); }
__device__ __forceinline__ float bfhi(unsigned w) { return __uint_as_float(w & 0xffff0000u); }
__device__ __forceinline__ void ld8(const bf16_t* p, f32x4& a, f32x4& b) { const u32x4 w = *(const u32x4*)p; a = (f32x4){bflo(w.x), bfhi(w.x), bflo(w.y), bfhi(w.y)}; b = (f32x4){bflo(w.z), bfhi(w.z), bflo(w.w), bfhi(w.w)}; }

__device__ __forceinline__ unsigned pk_fp8x4(float a, float b, float c, float d) { int p = __builtin_amdgcn_cvt_pk_fp8_f32(a, b, 0, false); p = __builtin_amdgcn_cvt_pk_fp8_f32(c, d, p, true); return (unsigned)p; }
constexpr float WSCALE8 = 64.0f, WINV8 = 1.0f / 64.0f;
struct EpiW1 {
    static constexpr bool PERM = true, AFTER_DRAIN = false; __device__ __forceinline__ bool keep(const Unit&) const { return false; }
    bf16_t *PA, *PB, *PC;
    __device__ __forceinline__ void operator()(const f32x4 (&acc)[2][2][4][2], const Unit& u, int wr, int wc, int fr, int fq) const {
        const int row0 = u.pm * BM + wr * 64 + fr, c8 = wc * 32 + 8 * fq;
        if (u.pn < 4) {
#pragma unroll
            for (int ai = 0; ai < 2; ++ai)
#pragma unroll
                for (int m = 0; m < 4; ++m)
                    st8(PA + (size_t)(row0 + ai * HALF + m * 16) * 1024 + u.pn * 128 + c8, acc[ai][0][m][0] * acc[ai][1][m][0], acc[ai][0][m][1] * acc[ai][1][m][1]);
        } else {
            bf16_t* base; int ldc, cb; bool act;
            if (u.pn < 6) { base = PA; ldc = 1024; cb = 512 + 256 * (u.pn - 4); act = false; }
            else if (u.pn < 16) { base = PB; ldc = 2560; cb = 256 * (u.pn - 6); act = (u.pn < 8) || (u.pn >= 14); }
            else { base = PC; ldc = 768; cb = 256 * (u.pn - 16); act = false; }
#pragma unroll
            for (int ai = 0; ai < 2; ++ai)
#pragma unroll
                for (int m = 0; m < 4; ++m)
#pragma unroll
                    for (int bj = 0; bj < 2; ++bj) { f32x4 v0 = acc[ai][bj][m][0], v1 = acc[ai][bj][m][1]; if (act) { v0 = silu4(v0); v1 = silu4(v1); }
                        if (u.pn == 18 && bj == 1) { u32x2 w; w.x = pk_fp8x4(v0[0], v0[1], v0[2], v0[3]); w.y = pk_fp8x4(v1[0], v1[1], v1[2], v1[3]);
                            *(u32x2*)((unsigned char*)(base + (size_t)(row0 + ai * HALF + m * 16) * ldc) + 1280 + c8) = w; }
                        else st8(base + (size_t)(row0 + ai * HALF + m * 16) * ldc + cb + bj * HALF + c8, v0, v1); }
        }
    }
};
struct EpiGate {
    static constexpr bool PERM = true, AFTER_DRAIN = false; __device__ __forceinline__ bool keep(const Unit&) const { return false; }
    bf16_t* G;
    __device__ __forceinline__ void operator()(const f32x4 (&acc)[2][2][4][2], const Unit& u, int wr, int wc, int fr, int fq) const {
        bf16_t* tp = G + ((size_t)(u.pm * 12 + u.pn) * 65536) + (((wr * 4 + wc) * 64 + fq * 16 + fr) * 8);
#pragma unroll
        for (int ai = 0; ai < 2; ++ai)
#pragma unroll
            for (int m = 0; m < 4; ++m)
#pragma unroll
                for (int bj = 0; bj < 2; ++bj) st8(tp + ((ai * 4 + m) * 2 + bj) * 4096, sigm4(acc[ai][bj][m][0] * WINV8), sigm4(acc[ai][bj][m][1] * WINV8));
    }
};
template <int BR> struct EpiMerge {
    static constexpr bool PERM = true, AFTER_DRAIN = false; __device__ __forceinline__ bool keep(const Unit&) const { return false; }
    const bf16_t* G; bf16_t* Mb;
    __device__ __forceinline__ void operator()(const f32x4 (&acc)[2][2][4][2], const Unit& u, int wr, int wc, int fr, int fq) const {
        const int row0 = u.pm * BM + wr * 64 + fr, c8 = u.pn * BM + wc * 32 + 8 * fq;
#pragma unroll
        for (int ai = 0; ai < 2; ++ai)
#pragma unroll
            for (int m = 0; m < 4; ++m) {
#pragma unroll
                for (int bj = 0; bj < 2; ++bj) { const size_t row = (size_t)(row0 + ai * HALF + m * 16); const int col = bj * HALF + c8;
                    f32x4 g0, g1; ld8(G + row * 3072 + BR * 1024 + col, g0, g1);
                    f32x4 v0 = g0 * acc[ai][bj][m][0], v1 = g1 * acc[ai][bj][m][1];
                    if (BR > 0) { f32x4 p0, p1; ld8(Mb + row * 1024 + col, p0, p1); v0 += p0; v1 += p1; }
                    st8(Mb + row * 1024 + col, v0, v1); }
                asm volatile("" ::: "memory"); }
    }
};
struct EpiWo {
    static constexpr bool PERM = true, AFTER_DRAIN = false; __device__ __forceinline__ bool keep(const Unit&) const { return false; }
    bf16_t* DL; const float* mod;
    __device__ __forceinline__ void operator()(const f32x4 (&acc)[2][2][4][2], const Unit& u, int wr, int wc, int fr, int fq) const {
        const int b = u.pm / 65, j = u.pm % 65; const float* g1 = mod + ((j == 0 ? 2 : b) * 6 + 2) * 1024;
        const int row0 = u.pm * BM + wr * 64 + fr, c8 = u.pn * BM + wc * 32 + 8 * fq;
        f32x4 gv[2][2];
#pragma unroll
        for (int bj = 0; bj < 2; ++bj)
#pragma unroll
            for (int n = 0; n < 2; ++n) gv[bj][n] = *(const f32x4*)(g1 + c8 + bj * HALF + 4 * n);
#pragma unroll
        for (int ai = 0; ai < 2; ++ai)
#pragma unroll
            for (int m = 0; m < 4; ++m)
#pragma unroll
                for (int bj = 0; bj < 2; ++bj) st8(DL + (size_t)(row0 + ai * HALF + m * 16) * 1024 + bj * HALF + c8, gv[bj][0] * acc[ai][bj][m][0], gv[bj][1] * acc[ai][bj][m][1]);
    }
};
struct EpiMoe1 {
    static constexpr bool PERM = true, AFTER_DRAIN = false; __device__ __forceinline__ bool keep(const Unit&) const { return false; }
    unsigned char* HID;
    __device__ __forceinline__ void operator()(const f32x4 (&acc)[2][2][4][2], const Unit& u, int wr, int wc, int fr, int fq) const {
        const int row0 = u.pm * BM + wr * 64 + fr, c8 = (u.pn & 7) * 128 + wc * 32 + 8 * fq;
#pragma unroll
        for (int ai = 0; ai < 2; ++ai)
#pragma unroll
            for (int m = 0; m < 4; ++m) { const f32x4 h0 = silu4(acc[ai][0][m][0] * WINV8) * (acc[ai][1][m][0] * WINV8), h1 = silu4(acc[ai][0][m][1] * WINV8) * (acc[ai][1][m][1] * WINV8);
                u32x2 w; w.x = pk_fp8x4(h0[0], h0[1], h0[2], h0[3]); w.y = pk_fp8x4(h1[0], h1[1], h1[2], h1[3]);
                *(u32x2*)(HID + (size_t)(row0 + ai * HALF + m * 16) * 1024 + c8) = w; }
    }
};
struct EpiMoe2 {
    static constexpr bool PERM = true, AFTER_DRAIN = false; __device__ __forceinline__ bool keep(const Unit&) const { return false; }
    bf16_t* YS;
    __device__ __forceinline__ void operator()(const f32x4 (&acc)[2][2][4][2], const Unit& u, int wr, int wc, int fr, int fq) const {
        const int row0 = u.pm * BM + wr * 64 + fr, c8 = (u.pn & 3) * BM + wc * 32 + 8 * fq;
#pragma unroll
        for (int ai = 0; ai < 2; ++ai)
#pragma unroll
            for (int m = 0; m < 4; ++m)
#pragma unroll
                for (int bj = 0; bj < 2; ++bj) st8(YS + (size_t)(row0 + ai * HALF + m * 16) * 1024 + bj * HALF + c8, acc[ai][bj][m][0] * WINV8, acc[ai][bj][m][1] * WINV8);
    }
};
struct MoeOrder {
    const int* tab; int nN, G, c, n_units;
    __device__ __forceinline__ void init(const int* tab_, int nN_, int G_, int c_) { tab = tab_; nN = nN_; G = G_; c = c_; n_units = __builtin_amdgcn_readfirstlane(tab_[0]) * nN_; }
    __device__ __forceinline__ bool next(int i, Unit& u) const {
        const int L = i * G + c; if (L >= n_units) return false;
        const int t = L / nN, j = L - t * nN; const int e = __builtin_amdgcn_readfirstlane(tab[1 + t]);
        u.pm = t; u.pn = e * nN + j; u.seg = 0; return true;
    }
    __device__ __forceinline__ void a_ready(const Unit&) const {}
    __device__ __forceinline__ void done(const Unit&) const {}
};


struct EpiMerge3 {
    static constexpr bool PERM = true, AFTER_DRAIN = false;
    const bf16_t* G; bf16_t* Mb;
    __device__ __forceinline__ bool keep(const Unit& u) const { return u.seg < 2; }
    __device__ __forceinline__ void operator()(f32x4 (&acc)[2][2][4][2], const Unit& u, int wr, int wc, int fr, int fq) const {
        const int row0 = u.pm * BM + wr * 64 + fr, c8 = u.pn * BM + wc * 32 + 8 * fq;
#pragma unroll
        for (int ai = 0; ai < 2; ++ai) {
            u32x4 gw[4][2], hw[4][2];
#pragma unroll
            for (int m = 0; m < 4; ++m)
#pragma unroll
                for (int bj = 0; bj < 2; ++bj) { const bf16_t* gp = G + ((size_t)(u.pm * 12 + u.seg * 4 + u.pn) * 65536) + (((wr * 4 + wc) * 64 + fq * 16 + fr) * 8) + ((ai * 4 + m) * 2 + bj) * 4096;
                    gw[m][bj] = *(const u32x4*)gp; if (u.seg < 2) hw[m][bj] = *(const u32x4*)(gp + 4 * 65536); }
#pragma unroll
            for (int m = 0; m < 4; ++m)
#pragma unroll
                for (int bj = 0; bj < 2; ++bj) { const u32x4 w = gw[m][bj];
                    f32x4 g0 = {bflo(w.x), bfhi(w.x), bflo(w.y), bfhi(w.y)}, g1 = {bflo(w.z), bfhi(w.z), bflo(w.w), bfhi(w.w)};
                    if (u.seg < 2) { const u32x4 x = hw[m][bj]; const f32x4 h0 = {bflo(x.x), bfhi(x.x), bflo(x.y), bfhi(x.y)}, h1 = {bflo(x.z), bfhi(x.z), bflo(x.w), bfhi(x.w)};
#pragma unroll
                        for (int q = 0; q < 4; ++q) { g0[q] *= __builtin_amdgcn_rcpf(fmaxf(h0[q], 1e-6f)); g1[q] *= __builtin_amdgcn_rcpf(fmaxf(h1[q], 1e-6f)); }
                        acc[ai][bj][m][0] *= g0; acc[ai][bj][m][1] *= g1; }
                    else st8(Mb + (size_t)(row0 + ai * HALF + m * 16) * 1024 + bj * HALF + c8, acc[ai][bj][m][0] * g0, acc[ai][bj][m][1] * g1); }
            asm volatile("" ::: "memory"); }
    }
};
struct RowOrder {
    StaticOrder so; bool lat; int nseg;
    __device__ __forceinline__ void init(bool lat_, int N, int nseg_, int G_, int c_) { lat = lat_; nseg = nseg_; so.init(lat_ ? 128 * BM : 130 * BM, N, G_, c_); }
    __device__ __forceinline__ bool next(int i, Unit& u) const { const int ti = i / nseg; if (!so.next(ti, u)) return false; u.seg = i - ti * nseg; if (lat) u.pm += 1 + (u.pm >= 64 ? 1 : 0); return true; }
    __device__ __forceinline__ void a_ready(const Unit&) const {}
    __device__ __forceinline__ void done(const Unit&) const {}
};
template <class Epi, class Sched, bool ALIGN_EPI = false, bool SP2 = false, bool FP8 = false>
__device__ __forceinline__ void gemm_phase(PG8_LAS unsigned char* lds, const Gemm g, const Sched& S, const Epi& E) {
    int tid_ = threadIdx.x; asm volatile("" : "+v"(tid_));
    const int tid = tid_, wid = __builtin_amdgcn_readfirstlane(tid >> 6), lane = tid & 63, wr = wid >> 2, wc = wid & 3, fr = lane & 15, fq = lane >> 4;
    const int K = g.K, nt = K / BK;
    unsigned voffA[2], voffB[2];
#pragma unroll
    for (int i = 0; i < 2; ++i) { int R, C; stage_rc(tid * 16 + i * 8192, R, C); const int Rb = Epi::PERM ? ((R & ~31) + perm32(R & 31)) : R;
        voffA[i] = (unsigned)(R * g.lda + C) * 2u; voffB[i] = (unsigned)(Rb * K + C) * 2u; }
    const size_t kstep = (size_t)(BK * 2);
    const size_t hstepA = (size_t)HALF * g.lda * 2, hstepB = (size_t)HALF * K * 2;
    const size_t tstepA = 2 * hstepA, tstepB = 2 * hstepB;
    const unsigned ldsw = (unsigned)wid * 1024u;
    const int aoff = lds_byte(wr * 64 + fr, fq * 8), boff = lds_byte(wc * 32 + fr, fq * 8);
#define PG8_SA(b, h) (((b) * 2 + (h)) * HTB)
#define PG8_SB(b, h) ((4 + (b) * 2 + (h)) * HTB)
#define PG8_UPTR(p) ((const char*)(((unsigned long long)(unsigned)__builtin_amdgcn_readfirstlane((int)(unsigned)((unsigned long long)(p) >> 32)) << 32) | (unsigned long long)(unsigned)__builtin_amdgcn_readfirstlane((int)(unsigned)(unsigned long long)(p))))
#define PG8_STAGE(bufoff, gbase, voff) do { const char* gb_ = PG8_UPTR(gbase); _Pragma("unroll") for (int _i = 0; _i < 2; ++_i) \
        __builtin_amdgcn_global_load_lds((const unsigned*)(gb_ + (voff)[_i]), (PG8_LAS unsigned*)(lds + (bufoff) + ldsw + _i * 8192), 16, 0, 0); } while (0)
#define PG8_LD32(p) __builtin_shufflevector(*(const PG8_LAS v4i_t*)(p), *(const PG8_LAS v4i_t*)((p) + 1024), 0, 1, 2, 3, 4, 5, 6, 7)
#define PG8_LDA(dst, b, h) do { _Pragma("unroll") for (int m = 0; m < 4; ++m) { if constexpr (FP8) dst##8[m] = PG8_LD32(lds + PG8_SA(b, h) + aoff + m * 2048); else { _Pragma("unroll") for (int k = 0; k < 2; ++k) dst[m][k] = *(const PG8_LAS bf16x8*)(lds + PG8_SA(b, h) + aoff + m * 2048 + k * 1024); } } } while (0)
#define PG8_LDB(dst, b, h) do { _Pragma("unroll") for (int n = 0; n < 2; ++n) { if constexpr (FP8) dst##8[n] = PG8_LD32(lds + PG8_SB(b, h) + boff + n * 2048); else { _Pragma("unroll") for (int k = 0; k < 2; ++k) dst[n][k] = *(const PG8_LAS bf16x8*)(lds + PG8_SB(b, h) + boff + n * 2048 + k * 1024); } } } while (0)
#define PG8_MMA(ai, bj, At, Bt) do { __builtin_amdgcn_s_setprio(1); _Pragma("unroll") for (int m = 0; m < 4; ++m) _Pragma("unroll") for (int n = 0; n < 2; ++n) { \
        if constexpr (FP8) acc[ai][bj][m][n] = __builtin_amdgcn_mfma_scale_f32_16x16x128_f8f6f4(Bt##8[n], At##8[m], acc[ai][bj][m][n], 0, 0, 0, 0, 0, 0); \
        else { _Pragma("unroll") for (int k = 0; k < 2; ++k) acc[ai][bj][m][n] = __builtin_amdgcn_mfma_f32_16x16x32_bf16(Bt[n][k], At[m][k], acc[ai][bj][m][n], 0, 0, 0); } } __builtin_amdgcn_s_setprio(0); } while (0)
#define PG8_WAIT_V(n) asm volatile("s_waitcnt vmcnt(" #n ")" ::: "memory")
#define PG8_WAIT_L(n) asm volatile("s_waitcnt lgkmcnt(" #n ")" ::: "memory")
#define PG8_BAR __builtin_amdgcn_s_barrier()
#define PG8_SCHED __builtin_amdgcn_sched_barrier(0)
    Unit cur, nxt; int ui = 0;
    if (!S.next(0, cur)) return;
    f32x4 acc[2][2][4][2];
#pragma unroll
    for (int a = 0; a < 2; ++a)
#pragma unroll
        for (int b = 0; b < 2; ++b)
#pragma unroll
            for (int m = 0; m < 4; ++m)
#pragma unroll
                for (int n = 0; n < 2; ++n) acc[a][b][m][n] = (f32x4){0.f, 0.f, 0.f, 0.f};
    bf16x8 At[4][2], B0[2][2], B1[2][2]; v8i_t At8[4], B08[2], B18[2];
    const char* cA = (const char*)g.A + (size_t)cur.pm * tstepA + (size_t)cur.seg * g.segA; const char* cB = (const char*)g.Bt + (size_t)cur.pn * tstepB + (size_t)cur.seg * g.segB;
    S.a_ready(cur);
    if constexpr (SP2) {
        PG8_STAGE(PG8_SB(0, 0), cB, voffB); PG8_STAGE(PG8_SB(0, 1), cB + hstepB, voffB); PG8_STAGE(PG8_SA(0, 0), cA, voffA); PG8_STAGE(PG8_SA(0, 1), cA + hstepA, voffA);
        if (wr == 1) PG8_BAR;
        PG8_WAIT_V(2); PG8_BAR;
        PG8_STAGE(PG8_SB(1, 0), cB + kstep, voffB); PG8_STAGE(PG8_SA(1, 0), cA + kstep, voffA); PG8_STAGE(PG8_SB(1, 1), cB + hstepB + kstep, voffB);
        PG8_WAIT_V(6); PG8_BAR;
    } else {
        PG8_STAGE(PG8_SB(0, 0), cB, voffB); PG8_STAGE(PG8_SA(0, 0), cA, voffA); PG8_STAGE(PG8_SB(0, 1), cB + hstepB, voffB); PG8_STAGE(PG8_SA(0, 1), cA + hstepA, voffA);
        if (wr == 1) PG8_BAR;
        PG8_WAIT_V(4); PG8_BAR;
        PG8_STAGE(PG8_SB(1, 0), cB + kstep, voffB); PG8_STAGE(PG8_SA(1, 0), cA + kstep, voffA); PG8_STAGE(PG8_SB(1, 1), cB + hstepB + kstep, voffB);
        PG8_WAIT_V(6); PG8_BAR;
    }
    for (;;) {
        const bool has_next = S.next(ui + 1, nxt);
        const char* nA = has_next ? (const char*)g.A + (size_t)nxt.pm * tstepA + (size_t)nxt.seg * g.segA : cA; const char* nB = has_next ? (const char*)g.Bt + (size_t)nxt.pn * tstepB + (size_t)nxt.seg * g.segB : cB;
#pragma unroll 1
        for (int t = 0; t < nt; t += 2) {
            const bool last = (t == nt - 2);
            const char* a1 = cA + (size_t)(t + 1) * kstep;
            const char* a2 = last ? nA : cA + (size_t)(t + 2) * kstep; const char* b2 = last ? nB : cB + (size_t)(t + 2) * kstep;
            const char* a3 = a2 + kstep; const char* b3 = b2 + kstep;
            if (last && has_next) S.a_ready(nxt);
            if constexpr (SP2) {
            PG8_LDB(B0, 0, 0); PG8_LDB(B1, 0, 1); PG8_SCHED; PG8_LDA(At, 0, 0); PG8_STAGE(PG8_SA(1, 1), a1 + hstepA, voffA);
            PG8_WAIT_V(8); PG8_WAIT_L(0); PG8_BAR; PG8_MMA(0, 0, At, B0); PG8_MMA(0, 1, At, B1); PG8_BAR; PG8_SCHED;
            PG8_LDA(At, 0, 1); PG8_STAGE(PG8_SB(0, 0), b2, voffB); PG8_STAGE(PG8_SB(0, 1), b2 + hstepB, voffB); PG8_STAGE(PG8_SA(0, 0), a2, voffA);
            PG8_WAIT_V(8); PG8_WAIT_L(0); PG8_BAR; PG8_MMA(1, 0, At, B0); PG8_MMA(1, 1, At, B1); PG8_BAR; PG8_SCHED;
            PG8_LDB(B0, 1, 0); PG8_LDB(B1, 1, 1); PG8_SCHED; PG8_LDA(At, 1, 0); PG8_STAGE(PG8_SA(0, 1), a2 + hstepA, voffA);
            PG8_WAIT_V(8); PG8_WAIT_L(0); PG8_BAR; PG8_MMA(0, 0, At, B0); PG8_MMA(0, 1, At, B1); PG8_BAR; PG8_SCHED;
            PG8_LDA(At, 1, 1); PG8_STAGE(PG8_SB(1, 0), b3, voffB); PG8_STAGE(PG8_SB(1, 1), b3 + hstepB, voffB); PG8_STAGE(PG8_SA(1, 0), a3, voffA);
            PG8_WAIT_V(8); PG8_WAIT_L(0); PG8_BAR; PG8_MMA(1, 0, At, B0); PG8_MMA(1, 1, At, B1); PG8_BAR; PG8_SCHED;
            } else {
            PG8_LDB(B0, 0, 0); PG8_SCHED; PG8_LDA(At, 0, 0); PG8_STAGE(PG8_SA(1, 1), a1 + hstepA, voffA);
            PG8_WAIT_L(8); PG8_BAR; PG8_WAIT_L(0); PG8_MMA(0, 0, At, B0); PG8_BAR; PG8_SCHED;
            PG8_LDB(B1, 0, 1); PG8_STAGE(PG8_SB(0, 0), b2, voffB);
            PG8_BAR; PG8_WAIT_L(0); PG8_MMA(0, 1, At, B1); PG8_BAR;
            PG8_LDA(At, 0, 1); PG8_STAGE(PG8_SA(0, 0), a2, voffA);
            PG8_BAR; PG8_WAIT_L(0); PG8_MMA(1, 0, At, B0); PG8_BAR; PG8_SCHED;
            PG8_STAGE(PG8_SB(0, 1), b2 + hstepB, voffB);
            PG8_WAIT_V(6); PG8_BAR; PG8_MMA(1, 1, At, B1); PG8_BAR;
            PG8_LDB(B0, 1, 0); PG8_SCHED; PG8_LDA(At, 1, 0); PG8_STAGE(PG8_SA(0, 1), a2 + hstepA, voffA);
            PG8_WAIT_L(8); PG8_BAR; PG8_WAIT_L(0); PG8_MMA(0, 0, At, B0); PG8_BAR; PG8_SCHED;
            PG8_LDB(B1, 1, 1); PG8_STAGE(PG8_SB(1, 0), b3, voffB);
            PG8_BAR; PG8_WAIT_L(0); PG8_MMA(0, 1, At, B1); PG8_BAR;
            PG8_LDA(At, 1, 1); PG8_STAGE(PG8_SA(1, 0), a3, voffA);
            PG8_BAR; PG8_WAIT_L(0); PG8_MMA(1, 0, At, B0); PG8_BAR; PG8_SCHED;
            PG8_STAGE(PG8_SB(1, 1), b3 + hstepB, voffB);
            PG8_WAIT_V(6); PG8_BAR; PG8_MMA(1, 1, At, B1); PG8_BAR;
            }
        }
        if constexpr (ALIGN_EPI) { if (wr == 0) PG8_BAR; }
        if constexpr (!Epi::AFTER_DRAIN) { int le_; asm volatile("v_mbcnt_lo_u32_b32 %0, -1, 0\n\tv_mbcnt_hi_u32_b32 %0, -1, %0" : "=v"(le_));
            E(acc, cur, wr, wc, le_ & 15, le_ >> 4); S.done(cur); }
        if (!has_next) break;
        if (!E.keep(cur)) {
#pragma unroll
        for (int a = 0; a < 2; ++a)
#pragma unroll
            for (int b = 0; b < 2; ++b)
#pragma unroll
                for (int m = 0; m < 4; ++m)
#pragma unroll
                    for (int n = 0; n < 2; ++n) acc[a][b][m][n] = (f32x4){0.f, 0.f, 0.f, 0.f};
        }
        cur = nxt; cA = nA; cB = nB; ++ui;
        if constexpr (ALIGN_EPI) { if (wr == 1) PG8_BAR; }
    }
    PG8_WAIT_V(0);
    if constexpr (!ALIGN_EPI) { if (wr == 0) PG8_BAR; }
    PG8_BAR;
    if constexpr (Epi::AFTER_DRAIN) { E.fused(acc, cur, wr, wc, fr, fq, lds, wid, lane); S.done(cur); }
#undef PG8_SA
#undef PG8_SB
#undef PG8_STAGE
#undef PG8_UPTR
#undef PG8_LDA
#undef PG8_LDB
#undef PG8_MMA
#undef PG8_LD32
#undef PG8_WAIT_V
#undef PG8_WAIT_L
#undef PG8_BAR
#undef PG8_SCHED
}
}
namespace attn_body {
using bf16=__hip_bfloat16;
using f32x16=__attribute__((ext_vector_type(16)))float;
using f32x4_t=__attribute__((ext_vector_type(4)))float;
using u32x4=__attribute__((ext_vector_type(4)))unsigned;
using v2i=__attribute__((ext_vector_type(2)))int; using v4i=__attribute__((ext_vector_type(4)))int; using v8i=__attribute__((ext_vector_type(8)))int;
constexpr int D=64,PKV=768,PO=1536;
constexpr int PKVB=PKV*2;
#define MF8(a,b,c) __builtin_amdgcn_mfma_scale_f32_32x32x64_f8f6f4((a),(b),(c),0,0,0,0,0,0)
#define MF8A(D,A,B,C) asm volatile("v_mfma_f32_32x32x64_f8f6f4 %0, %1, %2, %3":"=&v"(D):"v"(A),"v"(B),"v"(C))
constexpr int NW=8,QBLK=32,QB=QBLK*NW,KVBLK=64;
constexpr int ATTN_UNIT_ROWS=QB;
__device__ __forceinline__ int crow(int r,int hi){return (r&3)+8*(r>>2)+4*hi;}
#define SBAR() __builtin_amdgcn_sched_barrier(0)
constexpr int NSLOT=3, SLOTB=4096;
constexpr int LDS_K=0, LDS_V=NSLOT*SLOTB, LDS_WS=2*NSLOT*SLOTB, LDS_OST=LDS_WS+NW*64*4, LDS_BYTES=LDS_OST+NW*4096;
constexpr float C2=0.125f*1.4426950408889634f;
__device__ __forceinline__ void glds16s(const void*sbase,unsigned voff,unsigned lds_dst){unsigned keep;
  asm volatile("s_mov_b32 %0, m0\n\ts_mov_b32 m0, %3\n\ts_nop 0\n\tglobal_load_lds_dwordx4 %1, %2\n\ts_mov_b32 m0, %0":"=&s"(keep):"v"(voff),"s"(sbase),"s"(lds_dst):"memory");}
__device__ __forceinline__ const char* uptr(const void*p){ const unsigned long long u=(unsigned long long)p; return (const char*)(((unsigned long long)(unsigned)__builtin_amdgcn_readfirstlane((int)(unsigned)(u>>32))<<32)|(unsigned long long)(unsigned)__builtin_amdgcn_readfirstlane((int)(unsigned)u)); }
#define WAIT_BAR(N) asm volatile("s_waitcnt vmcnt(" #N ") lgkmcnt(0)\n\ts_barrier":::"memory")
typedef __attribute__((address_space(3))) const char* lds_cptr;
typedef __attribute__((address_space(3))) const v4i* lds_v4p;
__device__ __forceinline__ void kload2(v8i*kf,lds_cptr kp,int j){ const v4i x=*(lds_v4p)(kp+j*512), y=*(lds_v4p)(kp+j*512+1024); kf[j]=__builtin_shufflevector(x,y,0,1,2,3,4,5,6,7); }
typedef __attribute__((address_space(3))) v2i* lds_v2p;
__device__ __forceinline__ v8i vload(lds_cptr vp){
  const v2i a=__builtin_amdgcn_ds_read_tr8_b64_v2i32((lds_v2p)(vp)),b=__builtin_amdgcn_ds_read_tr8_b64_v2i32((lds_v2p)(vp+1024)),c=__builtin_amdgcn_ds_read_tr8_b64_v2i32((lds_v2p)(vp+2048)),d=__builtin_amdgcn_ds_read_tr8_b64_v2i32((lds_v2p)(vp+3072));
  return (v8i){a[0],a[1],b[0],b[1],c[0],c[1],d[0],d[1]}; }
__device__ __forceinline__ int pk8(int old,float a,float b,float c,float d){ const int p=__builtin_amdgcn_cvt_pk_fp8_f32(a,b,old,false); return __builtin_amdgcn_cvt_pk_fp8_f32(c,d,p,true); }

#ifndef ATTN_STORE16
#define ATTN_STORE16(p,v) (*(u32x4*)(p)=(v))
#endif
__device__ __forceinline__ void attn_unit(const unsigned char*Qw0,const unsigned char*__restrict__ Kh,const unsigned char*__restrict__ Vh,bf16*Ow0,const int NT,char*shm){
  int tid_=threadIdx.x; asm volatile("":"+v"(tid_)); const int tid=tid_,lane=tid&63,r32=lane&31,hi=lane>>5; const int wid=__builtin_amdgcn_readfirstlane(tid>>6);
  const unsigned char*Qw=Qw0+(long)(wid*QBLK)*PKVB; const bool kw=wid<4;
  const unsigned lds0=(unsigned)(uintptr_t)shm;
  float*wsf=(float*)(shm+LDS_WS)+wid*64;
  const char*kvbase=kw?uptr(Kh+wid*16):uptr(Vh+(long)(16*(wid&3))*PKVB);
  const unsigned kvoff=kw?(unsigned)(lane*PKVB):(unsigned)((lane>>2)*PKVB+(((lane&3)^(2*((lane>>5)&1)))*16));
  const unsigned kvdst=lds0+(kw?LDS_K:LDS_V)+(wid&3)*1024;
  #define DMA_KV(t,slot) glds16s(kvbase+(long)(t)*(KVBLK*PKVB),kvoff,(unsigned)__builtin_amdgcn_readfirstlane(kvdst+(slot)))
  v8i kf[2];
  const lds_cptr shm3=(lds_cptr)shm; const lds_cptr kp0=shm3+LDS_K+hi*2048+r32*16;
  const int vr_=(lane&15)>>1; const lds_cptr vp0=shm3+LDS_V+((vr_&3)+8*(vr_>>2)+4*hi)*64+((2*((vr_>>2)&1)+((lane>>4)&1))*16)+8*(lane&1);
  const lds_cptr vp1=shm3+LDS_V+((vr_&3)+8*(vr_>>2)+4*hi)*64+(((2*((vr_>>2)&1)+((lane>>4)&1))*16)^32)+8*(lane&1);
  if(kw){DMA_KV(0,0);DMA_KV(1,SLOTB);}else{DMA_KV(0,0);}
  v8i qr; { const v4i q0=*reinterpret_cast<const v4i*>(Qw+(long)r32*PKVB+hi*32), q1=*reinterpret_cast<const v4i*>(Qw+(long)r32*PKVB+hi*32+16); qr=__builtin_shufflevector(q0,q1,0,1,2,3,4,5,6,7); }
  constexpr float REF=3.0f; f32x16 o[2];o[0]=f32x16{};o[1]=f32x16{};
  f32x4_t osum4={0.f,0.f,0.f,0.f}; v8i msk8; { const int mv=((((lane>>4)&1)==0)==((lane&15)<8))?0x38383838:0; msk8=(v8i){mv,mv,mv,mv,mv,mv,mv,mv}; } asm volatile("":"+v"(msk8));
  f32x16 negm; _Pragma("unroll") for(int r=0;r<16;++r)negm[r]=-REF; asm volatile("":"+v"(negm));
  f32x16 pA0,pA1,pB0,pB1;
  int sl_prev=0,sl_cur=0,sl_next=SLOTB;
  #define ROT() do{sl_prev=sl_cur;sl_cur=sl_next;sl_next=(sl_next==(NSLOT-1)*SLOTB)?0:sl_next+SLOTB;}while(0)
  if(kw){DMA_KV(2,2*SLOTB);}
  WAIT_BAR(3);
  { kload2(kf,kp0,0); kload2(kf,kp0,1); pA0=MF8(kf[0],qr,negm); pA1=MF8(kf[1],qr,negm); }
  _Pragma("unroll") for(int r=0;r<16;++r){pA0[r]=__builtin_amdgcn_exp2f(pA0[r]);pA1[r]=__builtin_amdgcn_exp2f(pA1[r]);}
  WAIT_BAR(0);
  if(kw){DMA_KV(3,0);}else{DMA_KV(1,SLOTB);}
  ROT();
  kload2(kf,kp0+sl_cur,0); kload2(kf,kp0+sl_cur,1);
  WAIT_BAR(1);
  v8i vb8[2], p8={0,0,0,0,0,0,0,0};
  #define PIN(x) asm volatile("":"+v"(x))
  #define EX(v) __builtin_amdgcn_exp2f(v)
  #define EX8(X,B) do{ X[B]=EX(X[B]); X[B+1]=EX(X[B+1]); X[B+2]=EX(X[B+2]); X[B+3]=EX(X[B+3]); X[B+4]=EX(X[B+4]); X[B+5]=EX(X[B+5]); X[B+6]=EX(X[B+6]); X[B+7]=EX(X[B+7]); }while(0)
  #define KRD(G,j) do{ if(G){ kload2(kf,kp0+sl_next,j); SBAR(); } }while(0)
  #define STEP(C0,C1,P0,P1,t,GK,GV,GL) do{ SBAR(); \
    vb8[0]=vload(vp0+sl_prev); vb8[1]=vload(vp1+sl_prev); SBAR(); \
    MF8A(C0,kf[0],qr,negm); PIN(P0); \
    p8[0]=pk8(p8[0],P0[0],P0[1],P0[2],P0[3]); p8[1]=pk8(p8[1],P0[4],P0[5],P0[6],P0[7]); p8[2]=pk8(p8[2],P0[8],P0[9],P0[10],P0[11]); p8[3]=pk8(p8[3],P0[12],P0[13],P0[14],P0[15]); SBAR(); \
    MF8A(C1,kf[1],qr,negm); PIN(P1); \
    p8[4]=pk8(p8[4],P1[0],P1[1],P1[2],P1[3]); p8[5]=pk8(p8[5],P1[4],P1[5],P1[6],P1[7]); p8[6]=pk8(p8[6],P1[8],P1[9],P1[10],P1[11]); p8[7]=pk8(p8[7],P1[12],P1[13],P1[14],P1[15]); PIN(p8); SBAR(); \
    if(kw){ if(GK){DMA_KV((t)+3,sl_cur);} } else { if(GV){DMA_KV((t)+1,sl_next);} } \
    SBAR(); \
    o[0]=MF8(p8,vb8[0],o[0]); EX8(C0,0); PIN(C0); SBAR(); \
    KRD(GL,0); o[1]=MF8(p8,vb8[1],o[1]); EX8(C0,8); PIN(C0); SBAR(); \
    KRD(GL,1); osum4=__builtin_amdgcn_mfma_scale_f32_16x16x128_f8f6f4(p8,msk8,osum4,0,0,0,0,0,0); EX8(C1,0); EX8(C1,8); PIN(C1); SBAR(); \
    }while(0)
  int t=1;
  for(;t+5<NT;t+=2){
    STEP(pB0,pB1,pA0,pA1,t,true,true,true);     WAIT_BAR(1); ROT();
    STEP(pA0,pA1,pB0,pB1,t+1,true,true,true);   WAIT_BAR(1); ROT();
  }
  #define ENDW(tt) do{ if((tt)+3<NT){WAIT_BAR(1);} else {WAIT_BAR(0);} }while(0)
  for(;t+1<NT;t+=2){
    STEP(pB0,pB1,pA0,pA1,t,(t+3<NT),(t+1<NT),(t+1<NT));       ENDW(t);   ROT();
    STEP(pA0,pA1,pB0,pB1,t+1,(t+4<NT),(t+2<NT),(t+2<NT));     ENDW(t+1); ROT();
  }
  STEP(pB0,pB1,pA0,pA1,NT-1,false,false,false);
  { p8[0]=pk8(p8[0],pB0[0],pB0[1],pB0[2],pB0[3]); p8[1]=pk8(p8[1],pB0[4],pB0[5],pB0[6],pB0[7]); p8[2]=pk8(p8[2],pB0[8],pB0[9],pB0[10],pB0[11]); p8[3]=pk8(p8[3],pB0[12],pB0[13],pB0[14],pB0[15]);
    p8[4]=pk8(p8[4],pB1[0],pB1[1],pB1[2],pB1[3]); p8[5]=pk8(p8[5],pB1[4],pB1[5],pB1[6],pB1[7]); p8[6]=pk8(p8[6],pB1[8],pB1[9],pB1[10],pB1[11]); p8[7]=pk8(p8[7],pB1[12],pB1[13],pB1[14],pB1[15]);
    vb8[0]=vload(vp0+sl_cur); vb8[1]=vload(vp1+sl_cur);
    o[0]=MF8(p8,vb8[0],o[0]); o[1]=MF8(p8,vb8[1],o[1]); osum4=__builtin_amdgcn_mfma_scale_f32_16x16x128_f8f6f4(p8,msk8,osum4,0,0,0,0,0,0); }
  #undef PIN
  #undef EX
  #undef EX8
  #undef KRD
  #undef STEP
  #undef ENDW
  if((lane&7)==0){ float*wq=wsf+32+16*((lane>>3)&1)+4*(lane>>4); wq[0]=osum4[0];wq[1]=osum4[1];wq[2]=osum4[2];wq[3]=osum4[3]; } asm volatile("s_waitcnt lgkmcnt(0)":::"memory");
  float rli[16];
  #pragma unroll
  for(int r=0;r<16;++r)rli[r]=__builtin_amdgcn_rcpf(wsf[32+crow(r,hi)]);
  bf16*Ow=Ow0+(long)(wid*QBLK)*PO;
  { bf16*stg=(bf16*)(shm+LDS_OST)+wid*2048;
    #pragma unroll
    for(int r=0;r<16;++r){const int orow=crow(r,hi);
      #pragma unroll
      for(int d0=0;d0<2;++d0)stg[orow*64+d0*32+r32]=__float2bfloat16(o[d0][r]*rli[r]);}
    asm volatile("s_waitcnt lgkmcnt(0)":::"memory");
    #pragma unroll
    for(int i=0;i<4;++i){const int row=i*8+(lane>>3),ch=lane&7; const u32x4 v=*(const u32x4*)(stg+row*64+ch*8); ATTN_STORE16(Ow+(long)row*PO+ch*8,v);} }
  asm volatile("s_waitcnt lgkmcnt(0)\n\ts_barrier":::"memory");
  #undef DMA_KV
  #undef ROT
}
constexpr int ATTN_LDS_BYTES=LDS_BYTES;
#undef SBAR
#undef WAIT_BAR
}
#define GAS __attribute__((address_space(1)))
#define LAS __attribute__((address_space(3)))
typedef unsigned short bf16;
typedef unsigned v4u __attribute__((ext_vector_type(4)));
typedef float f32x4 __attribute__((ext_vector_type(4)));
typedef short bf16x8 __attribute__((ext_vector_type(8)));
typedef GAS unsigned gu32;
typedef GAS unsigned long long gu64;
#define RLX_AGENT __ATOMIC_RELAXED, __HIP_MEMORY_SCOPE_AGENT
#define LDS_WAIT() asm volatile("s_waitcnt lgkmcnt(0)" ::: "memory")
#define VM_WAIT() asm volatile("s_waitcnt vmcnt(0)" ::: "memory")
__device__ __forceinline__ unsigned long long rt() { return __builtin_amdgcn_s_memrealtime(); }
__device__ __forceinline__ unsigned f2bf(float f) { unsigned u = __builtin_bit_cast(unsigned, f); return (u + 0x7fffu + ((u >> 16) & 1u)) >> 16; }
__device__ __forceinline__ unsigned pk2(float lo, float hi) { return f2bf(lo) | (f2bf(hi) << 16); }
#define XB_TMO      128
#define XB_XCNT(j)  (256  + 64 * (j))
#define XB_XSUB(j)  (1280 + 64 * (j))
#define XB_XGEN(j)  (2304 + 64 * (j))
#define XB_TOP      3328
#define XB_TOPGEN   3392
#define XCD_BAR_WORDS 3456
#define XB_SPIN_CAP (1u << 18)

__device__ __forceinline__ unsigned xb_ld(unsigned* p)              { return __hip_atomic_load(p, __ATOMIC_RELAXED, __HIP_MEMORY_SCOPE_AGENT); }
__device__ __forceinline__ unsigned xb_add(unsigned* p, unsigned v) { return __hip_atomic_fetch_add(p, v, __ATOMIC_RELAXED, __HIP_MEMORY_SCOPE_AGENT); }
__device__ __forceinline__ unsigned xb_xcc_id() { return (unsigned)__builtin_amdgcn_s_getreg((3 << 11) | 20) & 0xFu; }
#define XB_SPIN(cond, bar) do { unsigned _sp = 0; while (cond) { __builtin_amdgcn_s_sleep(1); \
    if ((++_sp & 255u) == 0u) { if (xb_ld(&(bar)[XB_TMO])) break; if (_sp > XB_SPIN_CAP) { atomicAdd(&(bar)[XB_TMO], 1u); break; } } } } while (0)

struct XcdBarrier {
    unsigned* bar; unsigned x;
    volatile LAS unsigned* st;
};

__device__ __forceinline__ XcdBarrier xcd_barrier_post(unsigned* bar, volatile LAS unsigned* st) {
    XcdBarrier b; b.bar = bar; b.x = xb_xcc_id(); b.st = st;
    if (threadIdx.x == 0) (void)xb_add(&bar[XB_XCNT(b.x)], 1u);
    return b;
}
__device__ __forceinline__ void xcd_barrier_complete(unsigned* bar, unsigned x, unsigned& nloc, unsigned& nx) {
    const unsigned G = gridDim.x * gridDim.y * gridDim.z;
    unsigned sum, cnt, mine, sp = 0u;
    for (;;) {
        sum = 0u; cnt = 0u; mine = 0u;
#pragma unroll
        for (unsigned j = 0; j < 16; ++j) { const unsigned c = xb_ld(&bar[XB_XCNT(j)]); sum += c; cnt += (c > 0u) ? 1u : 0u; mine = (j == x) ? c : mine; }
        if (sum == G) break;
        __builtin_amdgcn_s_sleep(1);
        if ((++sp & 255u) == 0u) { if (xb_ld(&bar[XB_TMO])) break; if (sp > XB_SPIN_CAP) { atomicAdd(&bar[XB_TMO], 1u); break; } }
    }
    nloc = mine > 0u ? mine : 1u; nx = cnt > 0u ? cnt : 1u;
}

__device__ __forceinline__ void xcd_barrier(const XcdBarrier& b) {
    asm volatile("s_waitcnt vmcnt(0)" ::: "memory");
    __syncthreads();
    if (threadIdx.x == 0) {
        unsigned* bar = b.bar;
        __builtin_amdgcn_s_waitcnt(0);
        unsigned nloc = b.st[0], nx = b.st[1];
        if (nloc == 0u) { xcd_barrier_complete(bar, b.x, nloc, nx); b.st[0] = nloc; b.st[1] = nx; }
        const unsigned old = xb_add(&bar[XB_XSUB(b.x)], 1u);
        const unsigned gen = old / nloc;
        if (old + 1u == (gen + 1u) * nloc) {
            __builtin_amdgcn_fence(__ATOMIC_RELEASE, "agent");
            asm volatile("s_waitcnt vmcnt(0)" ::: "memory");
            const unsigned og = xb_add(&bar[XB_TOP], 1u);
            const unsigned tg = og / nx;
            if (og + 1u == (tg + 1u) * nx) xb_add(&bar[XB_TOPGEN], 1u);
            else XB_SPIN(xb_ld(&bar[XB_TOPGEN]) == tg, bar);
            __builtin_amdgcn_fence(__ATOMIC_ACQUIRE, "agent");
            xb_add(&bar[XB_XGEN(b.x)], 1u);
            asm volatile("s_waitcnt vmcnt(0)" ::: "memory");
        } else {
            XB_SPIN(xb_ld(&bar[XB_XGEN(b.x)]) == gen, bar);
            __builtin_amdgcn_fence(__ATOMIC_ACQUIRE, "agent");
            asm volatile("s_waitcnt vmcnt(0)" ::: "memory");
        }
    }
    __syncthreads();
}
constexpr int NWAVES = 8;
constexpr int D = 1024, NB = 2, SEQ = 16384, CTX = 256, SPB = SEQ + CTX  , MT = NB * SPB  , DEPTH = 2;
constexpr int NWIN = 7936, N1 = 4864, NGATE = 3072, NE = 16, DFF = 1024;
constexpr int PMAX_TILES = 276, PMAX = PMAX_TILES * 256;
constexpr float EPS = 1e-6f;
constexpr float C2 = 0.125f * 1.4426950408889634f;
constexpr size_t MiB = 1u << 20;
constexpr size_t WS_CTL = 0, CTL_ZERO_BYTES = 32 * 1024;
constexpr size_t WS_MOD = 1 * MiB;
constexpr size_t WS_SMALL = 2 * MiB;
constexpr size_t WS_HCTX = 8 * MiB;
constexpr size_t WS_HGU = 10 * MiB, WS_HGS = 26 * MiB;
constexpr size_t WS_WIN = 42 * MiB;
constexpr size_t WS_WABC = 73 * MiB;
constexpr size_t WS_WO = 79 * MiB;
constexpr size_t WS_WEXP = 83 * MiB;
constexpr size_t WS_WG8 = WS_WEXP + 48 * MiB;
constexpr size_t WS_U8 = WS_WEXP + 56 * MiB;
constexpr size_t WS_U = 179 * MiB;
constexpr size_t WS_PA = 244 * MiB;
constexpr size_t WS_PB = 309 * MiB;
constexpr size_t WS_PC = WS_PB + (size_t)MT * 2560 * 2;
constexpr size_t WS_YCAT = WS_PC + (size_t)MT * 768 * 2;
constexpr size_t WS_END = WS_YCAT + (size_t)MT * 1536 * 2;
constexpr size_t WS_DELTA = WS_YCAT;
constexpr size_t WS_GATES = WS_PA;
constexpr size_t WS_XS = WS_PA;
constexpr size_t WS_HID = WS_XS + (size_t)PMAX * 1024;
constexpr size_t WS_YS = WS_HID + (size_t)PMAX * 1024;
constexpr size_t WS_OBUF = WS_PA;
static_assert(WS_GATES + (size_t)MT * 3072 * 2 <= WS_PC, "gates overlay");
static_assert(WS_WG8 + (size_t)DEPTH * 3072 * 1024 <= WS_U8 && WS_U8 + (size_t)MT * 1024 <= WS_U, "fp8 gate weights / activations in the freed expert space");
static_assert(WS_YS + (size_t)PMAX * 1024 * 2 <= WS_YCAT, "expert buffers overlay PA..PC");
constexpr size_t SM_RE = 0, SM_RW = 512 * 1024, SM_RP = 1024 * 1024, SM_BCNT = 1536 * 1024, SM_TAB = 1600 * 1024, SM_ROPE = 1664 * 1024, SM_HLD = 1792 * 1024;
constexpr int CW_BAR = 4096;
static_assert((CW_BAR + 3456) * 4 <= (int)CTL_ZERO_BYTES, "barrier words inside the per-call memset");
constexpr int RING_BYTES = 131072, LDS_BYTES = 147456, LDSCTL_OFF = LDS_BYTES - 1024, MISC_OFF = LDSCTL_OFF + 320;

typedef unsigned u32x2v __attribute__((ext_vector_type(2)));
template <int CTRL> __device__ __forceinline__ float dppf(float v) { return __int_as_float(__builtin_amdgcn_mov_dpp(__float_as_int(v), CTRL, 0xf, 0xf, true)); }
__device__ __forceinline__ float quad_sum(float v) { v += dppf<0xB1>(v); v += dppf<0x4E>(v); return v; }
__device__ __forceinline__ float row_sum16(float v) { v = quad_sum(v); v += dppf<0x124>(v); v += dppf<0x128>(v); return v; }
__device__ __forceinline__ float wave_sum(float v) {
    v = row_sum16(v);
    return (__int_as_float(__builtin_amdgcn_readlane(__float_as_int(v), 0)) + __int_as_float(__builtin_amdgcn_readlane(__float_as_int(v), 16)))
         + (__int_as_float(__builtin_amdgcn_readlane(__float_as_int(v), 32)) + __int_as_float(__builtin_amdgcn_readlane(__float_as_int(v), 48)));
}
__device__ __forceinline__ float bf2f(bf16 h) { return __uint_as_float((unsigned)h << 16); }
__device__ __forceinline__ float sigm_acc(float x) { return 1.0f / (1.0f + __expf(-x)); }
__device__ __forceinline__ const float* hrow(const float* lat, const float* ctx, int r) { const int b = r >= SPB ? 1 : 0, s = r - b * SPB; return s < CTX ? ctx + (size_t)(b * CTX + s) * D : lat + (size_t)(b * SEQ + s - CTX) * D; }
__device__ __forceinline__ int mod_idx(int r) { const int b = r >= SPB ? 1 : 0, s = r - b * SPB; return s < CTX ? 2 : b; }
__device__ __forceinline__ void load_row(const float* p, int lane, f32x4 (&v)[4]) {
#pragma unroll
    for (int j = 0; j < 4; ++j) v[j] = *(const f32x4*)(p + 4 * lane + 256 * j);
}
__device__ __forceinline__ void add_row_bf16(const bf16* p, int lane, f32x4 (&v)[4]) {
#pragma unroll
    for (int j = 0; j < 4; ++j) { const u32x2v w = *(const u32x2v*)(p + 4 * lane + 256 * j); v[j] += (f32x4){__uint_as_float(w.x << 16), __uint_as_float(w.x & 0xffff0000u), __uint_as_float(w.y << 16), __uint_as_float(w.y & 0xffff0000u)}; }
}
__device__ __forceinline__ void load_h1(const float* outp, const float* hctx, int r, int lane, f32x4 (&v)[4]) {
    const int b = r >= SPB ? 1 : 0, s = r - b * SPB;
    if (s < CTX) { load_row(hctx + (size_t)(b * CTX + s) * D, lane, v); return; }
    const bf16* p = (const bf16*)(outp + (size_t)(b * SEQ + s - CTX) * D) + D;
#pragma unroll
    for (int j = 0; j < 4; ++j) { const u32x2v w = *(const u32x2v*)(p + 4 * lane + 256 * j); v[j] = (f32x4){__uint_as_float(w.x << 16), __uint_as_float(w.x & 0xffff0000u), __uint_as_float(w.y << 16), __uint_as_float(w.y & 0xffff0000u)}; }
}
__device__ __forceinline__ float row_rstd(const f32x4 (&v)[4]) {
    float s = 0.f;
#pragma unroll
    for (int j = 0; j < 4; ++j) s += (v[j][0] * v[j][0] + v[j][1] * v[j][1]) + (v[j][2] * v[j][2] + v[j][3] * v[j][3]);
    return 1.0f / sqrtf(wave_sum(s) * (1.0f / D) + EPS);
}
__device__ __forceinline__ void norm_mod(const f32x4 (&v)[4], const float* gain, const float* sc, const float* sh, int lane, f32x4 (&y)[4]) {
    const float rstd = row_rstd(v);
#pragma unroll
    for (int j = 0; j < 4; ++j) { const int i = 4 * lane + 256 * j; const f32x4 g = *(const f32x4*)(gain + i), c = *(const f32x4*)(sc + i), h = *(const f32x4*)(sh + i);
        y[j] = v[j] * rstd * g * (1.0f + c) + h; }
}
__device__ __forceinline__ void store_row_bf16(bf16* p, int lane, const f32x4 (&y)[4]) {
#pragma unroll
    for (int j = 0; j < 4; ++j) { u32x2v w; w.x = pk2(y[j][0], y[j][1]); w.y = pk2(y[j][2], y[j][3]); *(u32x2v*)(p + 4 * lane + 256 * j) = w; }
}

__device__ __forceinline__ void store_row_fp8(unsigned char* p, int lane, const f32x4 (&y)[4]) {
#pragma unroll
    for (int j = 0; j < 4; ++j) *(unsigned*)(p + 4 * lane + 256 * j) = pg8::pk_fp8x4(y[j][0], y[j][1], y[j][2], y[j][3]);
}
__device__ __forceinline__ void qk_norm_rope(f32x4& a, f32x4& b2, const f32x4 ga, const f32x4 gb, const float* rp, const bool second, const float scale) {
    float ss = (a[0] * a[0] + a[1] * a[1]) + (a[2] * a[2] + a[3] * a[3]) + (b2[0] * b2[0] + b2[1] * b2[1]) + (b2[2] * b2[2] + b2[3] * b2[3]);
    ss = quad_sum(ss); { const float up = dppf<0x124>(ss), dn = dppf<0x12C>(ss); ss += (threadIdx.x & 4) ? up : dn; }
    const float rs = 1.0f / sqrtf(ss * (1.0f / 64.0f) + EPS);
    a = a * rs * ga; b2 = b2 * rs * gb;
    f32x4 pa, pb;
#pragma unroll
    for (int e = 0; e < 4; ++e) { pa[e] = dppf<0x4E>(a[e]); pb[e] = dppf<0x4E>(b2[e]); }
    if (rp) { const f32x4 t0 = *(const f32x4*)rp, t1 = *(const f32x4*)(rp + 4), t2 = *(const f32x4*)(rp + 8), t3 = *(const f32x4*)(rp + 12); const float sg = second ? 1.0f : -1.0f;
        a = (f32x4){a[0] * t0[0] + sg * pa[0] * t0[1], a[1] * t0[2] + sg * pa[1] * t0[3], a[2] * t1[0] + sg * pa[2] * t1[1], a[3] * t1[2] + sg * pa[3] * t1[3]};
        b2 = (f32x4){b2[0] * t2[0] + sg * pb[0] * t2[1], b2[1] * t2[2] + sg * pb[1] * t2[3], b2[2] * t3[0] + sg * pb[2] * t3[1], b2[3] * t3[2] + sg * pb[3] * t3[3]}; }
    a = a * scale; b2 = b2 * scale;
}

template <bool FP8OUT = false> __device__ __forceinline__ void transpose_item(const float* W, int pitch, bf16* WT, int K, int drow0, int k0, int n0, LAS float* scr, int lane) {
    const int rr = lane >> 3, c4 = (lane & 7) * 4;
    f32x4 t[8];
#pragma unroll
    for (int i = 0; i < 8; ++i) t[i] = *(const f32x4*)(W + (size_t)(k0 + 8 * i + rr) * pitch + n0 + c4);
#pragma unroll
    for (int i = 0; i < 8; ++i) { LAS float* d = scr + (8 * i + rr) * 33 + c4; d[0] = t[i][0]; d[1] = t[i][1]; d[2] = t[i][2]; d[3] = t[i][3]; }
    LDS_WAIT(); asm volatile("" ::: "memory");
    const int c = lane & 7;
#pragma unroll
    for (int j = 0; j < 4; ++j) { const int n = (lane >> 3) + 8 * j; const LAS float* s = scr + (8 * c) * 33 + n;
        if constexpr (FP8OUT) { u32x2v o; o.x = pg8::pk_fp8x4(s[0 * 33] * pg8::WSCALE8, s[1 * 33] * pg8::WSCALE8, s[2 * 33] * pg8::WSCALE8, s[3 * 33] * pg8::WSCALE8); o.y = pg8::pk_fp8x4(s[4 * 33] * pg8::WSCALE8, s[5 * 33] * pg8::WSCALE8, s[6 * 33] * pg8::WSCALE8, s[7 * 33] * pg8::WSCALE8);
            *(u32x2v*)((unsigned char*)WT + (size_t)(drow0 + n) * K + k0 + 8 * c) = o; }
        else { v4u o; o.x = pk2(s[0 * 33], s[1 * 33]); o.y = pk2(s[2 * 33], s[3 * 33]); o.z = pk2(s[4 * 33], s[5 * 33]); o.w = pk2(s[6 * 33], s[7 * 33]);
        *(v4u*)(WT + (size_t)(drow0 + n) * K + k0 + 8 * c) = o; } }
    LDS_WAIT(); asm volatile("" ::: "memory");
}
__device__ __forceinline__ int win_drow(int n0) {
    if (n0 < 512) return (n0 >> 7) * 256 + (n0 & 127);
    if (n0 < 1024) return 1024 + (n0 - 512);
    if (n0 < 1536) return ((n0 - 1024) >> 7) * 256 + 128 + (n0 & 127);
    return n0;
}
__device__ __forceinline__ void convert_experts(const float* wg, const float* wu, const float* wd, int layer, bf16* WE, LAS float* scr, int gw, int NGW, int lane) {
    const size_t lo = (size_t)layer * NE * D * DFF;
    unsigned char* GU = (unsigned char*)WE; unsigned char* DN = GU + (size_t)NE * 2048 * 1024;
    constexpr int IPM = 16 * 32;
    for (int it = gw; it < 3 * NE * IPM; it += NGW) {
        const int mat = it / IPM, r = it % IPM, kb = r / 32, nb = r % 32, e = mat % NE, kind = mat / NE, n0 = 32 * nb;
        if (kind == 0) transpose_item<true>(wg + lo + (size_t)e * D * DFF, DFF, (bf16*)(GU + (size_t)e * 2048 * 1024), 1024, (n0 >> 7) * 256 + (n0 & 127), 64 * kb, n0, scr, lane);
        else if (kind == 1) transpose_item<true>(wu + lo + (size_t)e * D * DFF, DFF, (bf16*)(GU + (size_t)e * 2048 * 1024), 1024, (n0 >> 7) * 256 + 128 + (n0 & 127), 64 * kb, n0, scr, lane);
        else transpose_item<true>(wd + lo + (size_t)e * DFF * D, D, (bf16*)(DN + (size_t)e * 1024 * 1024), 1024, n0, 64 * kb, n0, scr, lane);
    }
}

__device__ __forceinline__ void attn_naive(unsigned char* lds, const bf16* PC, bf16* YC, int vcu, int G, int tid) {
    float* Ks = (float*)lds; float* Vs = Ks + 64 * 64;
    for (int unit = vcu; unit < 528; unit += G) {
        int b, h, q0, nq, nkeys;
        if (unit < 512) { b = unit >> 8; h = (unit >> 5) & 7; q0 = CTX + (unit & 31) * 512; nq = 512; nkeys = SPB; }
        else { const int x = unit - 512; b = x >> 3; h = x & 7; q0 = 0; nq = 256; nkeys = CTX; }
        const int kvh = h >> 2;
        const int qi = tid < nq ? tid : nq - 1;
        const size_t row = (size_t)b * SPB + q0 + qi;
        float q[64], o[64];
#pragma unroll
        for (int d = 0; d < 64; d += 8) { f32x4 a, c; pg8::ld8(PC + row * 768 + h * 64 + d, a, c); q[d] = a[0]; q[d + 1] = a[1]; q[d + 2] = a[2]; q[d + 3] = a[3]; q[d + 4] = c[0]; q[d + 5] = c[1]; q[d + 6] = c[2]; q[d + 7] = c[3]; }
#pragma unroll
        for (int d = 0; d < 64; ++d) o[d] = 0.f;
        float mrun = -INFINITY, lrun = 0.f;
        for (int kt = 0; kt < nkeys; kt += 64) {
            __syncthreads();
            { const int key = tid >> 3, d0 = (tid & 7) * 8; const size_t kr = ((size_t)b * SPB + kt + key) * 768;
              f32x4 a, c; pg8::ld8(PC + kr + 512 + kvh * 64 + d0, a, c); *(f32x4*)(Ks + key * 64 + d0) = a; *(f32x4*)(Ks + key * 64 + d0 + 4) = c;
              pg8::ld8(PC + kr + 640 + kvh * 64 + d0, a, c); *(f32x4*)(Vs + key * 64 + d0) = a; *(f32x4*)(Vs + key * 64 + d0 + 4) = c; }
            __syncthreads();
#pragma unroll 1
            for (int j = 0; j < 64; ++j) { const float* kp = Ks + j * 64; const float* vp = Vs + j * 64; float a = 0.f;
#pragma unroll
                for (int d = 0; d < 64; d += 4) { const f32x4 kv = *(const f32x4*)(kp + d); a += q[d] * kv[0]; a += q[d + 1] * kv[1]; a += q[d + 2] * kv[2]; a += q[d + 3] * kv[3]; }
                if (a > mrun) { const float alpha = __builtin_amdgcn_exp2f(mrun - a); lrun *= alpha; mrun = a;
#pragma unroll
                    for (int d = 0; d < 64; ++d) o[d] *= alpha; }
                const float pj = __builtin_amdgcn_exp2f(a - mrun); lrun += pj;
#pragma unroll
                for (int d = 0; d < 64; d += 4) { const f32x4 vv = *(const f32x4*)(vp + d); o[d] += pj * vv[0]; o[d + 1] += pj * vv[1]; o[d + 2] += pj * vv[2]; o[d + 3] += pj * vv[3]; }
            }
        }
        if (tid < nq) { const float il = 1.0f / lrun; bf16* op = YC + row * 1536 + 1024 + h * 64;
#pragma unroll
            for (int d = 0; d < 64; d += 8) pg8::st8(op + d, (f32x4){o[d] * il, o[d + 1] * il, o[d + 2] * il, o[d + 3] * il}, (f32x4){o[d + 4] * il, o[d + 5] * il, o[d + 6] * il, o[d + 7] * il}); }
    }
    __syncthreads();
}

__device__ __forceinline__ void hgrn_naive(const bf16* PB, bf16* OB, const float* lbp, int layer, int gw, int NGW, int lane) {
    for (int wu = gw; wu < 2048; wu += NGW) {
        const int chain = wu >> 7, v = wu & 127, b = chain >> 3, hd = (chain >> 1) & 3, dir = chain & 1;
        float lb0 = 0.f, lb1 = 0.f;
        if (layer > 0) { const int c0 = dir * 512 + hd * 128 + lane; lb0 = sigm_acc(lbp[1024 + c0] - lbp[c0]); lb1 = sigm_acc(lbp[1024 + c0 + 64] - lbp[c0 + 64]); }
        float S0 = 0.f, S1 = 0.f;
        for (int tb = 0; tb < SPB; tb += 8) {
            float q0[8], q1[8], z0[8], z1[8], vv[8]; int rr[8];
#pragma unroll
            for (int i = 0; i < 8; ++i) { const int tau = tb + i; const int s = dir == 0 ? tau : (tau < CTX ? CTX - 1 - tau : SPB + CTX - 1 - tau); const int r = b * SPB + s; rr[i] = r;
                const bf16* p = PB + (size_t)r * 2560 + hd * 128;
                q0[i] = bf2f(p[lane]); q1[i] = bf2f(p[lane + 64]); z0[i] = bf2f(p[512 + dir * 512 + lane]); z1[i] = bf2f(p[512 + dir * 512 + lane + 64]); vv[i] = bf2f(p[1536 + v]); }
            float part[8];
#pragma unroll
            for (int i = 0; i < 8; ++i) {
                const float e0 = __expf(z0[i]), e1 = __expf(z1[i]);
                const float n0 = 1.0f / (1.0f + e0), n1 = 1.0f / (1.0f + e1);
                const float k0 = (1.0f - lb0) * n0, k1 = (1.0f - lb1) * n1, f0 = 1.0f - k0, f1 = 1.0f - k1;
                S0 = f0 * S0 + k0 * vv[i]; S1 = f1 * S1 + k1 * vv[i];
                part[i] = S0 * q0[i] + S1 * q1[i]; }
#pragma unroll
            for (int i = 0; i < 8; ++i) part[i] = wave_sum(part[i]);
            float mine = part[0]; int myr = rr[0];
#pragma unroll
            for (int i = 1; i < 8; ++i) if (lane == i) { mine = part[i]; myr = rr[i]; }
            if (lane < 8) OB[((size_t)dir * MT + myr) * 512 + hd * 128 + v] = (bf16)f2bf(mine);
        }
    }
}
namespace hg {
typedef short bf16x8 __attribute__((ext_vector_type(8)));
typedef float f32x4 __attribute__((ext_vector_type(4)));
constexpr int QS = 136, TS = 72;
constexpr int NSEG = 16, NCHUNK = SPB / 64;
constexpr int OFF_QT = 0, OFF_KT = OFF_QT + 64 * QS * 2, OFF_KTT = OFF_KT + 64 * QS * 2, OFF_VT = OFF_KTT + 128 * TS * 2, OFF_S0T = OFF_VT + 128 * TS * 2,
              OFF_AS = OFF_S0T + 128 * QS * 2, OFF_ER = OFF_AS + 64 * TS * 2, OFF_D2 = OFF_ER + 128 * 4, HG_LDS = OFF_D2 + 128 * 4;
static_assert(OFF_KT % 16 == 0 && OFF_KTT % 16 == 0 && OFF_VT % 16 == 0 && OFF_S0T % 16 == 0 && OFF_AS % 16 == 0 && OFF_ER % 16 == 0 && HG_LDS <= LDSCTL_OFF, "hgrn LDS map");
#define HG_MFMA(a, b, c) __builtin_amdgcn_mfma_f32_16x16x32_bf16((a), (b), (c), 0, 0, 0)
__device__ __forceinline__ int rowmap(int dir, int ci, int t) { return dir == 0 ? 64 * ci + t : (ci < 4 ? 255 - 64 * ci - t : 16895 - 64 * ci - t); }

__device__ __forceinline__ float scan32_mul(float v) {
    const int one = __float_as_int(1.0f);
    v *= __int_as_float(__builtin_amdgcn_update_dpp(one, __float_as_int(v), 0x111, 0xf, 0xf, false));
    v *= __int_as_float(__builtin_amdgcn_update_dpp(one, __float_as_int(v), 0x112, 0xf, 0xf, false));
    v *= __int_as_float(__builtin_amdgcn_update_dpp(one, __float_as_int(v), 0x114, 0xf, 0xf, false));
    v *= __int_as_float(__builtin_amdgcn_update_dpp(one, __float_as_int(v), 0x118, 0xf, 0xf, false));
    v *= __int_as_float(__builtin_amdgcn_update_dpp(one, __float_as_int(v), 0x142, 0xa, 0xf, false));
    return v;
}
__device__ __forceinline__ void scan32_mul16(float (&P)[16]) {
    asm volatile("s_nop 1\n\t" "v_mul_f32_dpp %0, %0, %0 row_shr:1 row_mask:0xf bank_mask:0xf\n\tv_mul_f32_dpp %1, %1, %1 row_shr:1 row_mask:0xf bank_mask:0xf\n\tv_mul_f32_dpp %2, %2, %2 row_shr:1 row_mask:0xf bank_mask:0xf\n\tv_mul_f32_dpp %3, %3, %3 row_shr:1 row_mask:0xf bank_mask:0xf\n\tv_mul_f32_dpp %4, %4, %4 row_shr:1 row_mask:0xf bank_mask:0xf\n\tv_mul_f32_dpp %5, %5, %5 row_shr:1 row_mask:0xf bank_mask:0xf\n\tv_mul_f32_dpp %6, %6, %6 row_shr:1 row_mask:0xf bank_mask:0xf\n\tv_mul_f32_dpp %7, %7, %7 row_shr:1 row_mask:0xf bank_mask:0xf\n\tv_mul_f32_dpp %8, %8, %8 row_shr:1 row_mask:0xf bank_mask:0xf\n\tv_mul_f32_dpp %9, %9, %9 row_shr:1 row_mask:0xf bank_mask:0xf\n\tv_mul_f32_dpp %10, %10, %10 row_shr:1 row_mask:0xf bank_mask:0xf\n\tv_mul_f32_dpp %11, %11, %11 row_shr:1 row_mask:0xf bank_mask:0xf\n\tv_mul_f32_dpp %12, %12, %12 row_shr:1 row_mask:0xf bank_mask:0xf\n\tv_mul_f32_dpp %13, %13, %13 row_shr:1 row_mask:0xf bank_mask:0xf\n\tv_mul_f32_dpp %14, %14, %14 row_shr:1 row_mask:0xf bank_mask:0xf\n\tv_mul_f32_dpp %15, %15, %15 row_shr:1 row_mask:0xf bank_mask:0xf\n\t" : "+v"(P[0]), "+v"(P[1]), "+v"(P[2]), "+v"(P[3]), "+v"(P[4]), "+v"(P[5]), "+v"(P[6]), "+v"(P[7]), "+v"(P[8]), "+v"(P[9]), "+v"(P[10]), "+v"(P[11]), "+v"(P[12]), "+v"(P[13]), "+v"(P[14]), "+v"(P[15]));
    asm volatile("v_mul_f32_dpp %0, %0, %0 row_shr:2 row_mask:0xf bank_mask:0xf\n\tv_mul_f32_dpp %1, %1, %1 row_shr:2 row_mask:0xf bank_mask:0xf\n\tv_mul_f32_dpp %2, %2, %2 row_shr:2 row_mask:0xf bank_mask:0xf\n\tv_mul_f32_dpp %3, %3, %3 row_shr:2 row_mask:0xf bank_mask:0xf\n\tv_mul_f32_dpp %4, %4, %4 row_shr:2 row_mask:0xf bank_mask:0xf\n\tv_mul_f32_dpp %5, %5, %5 row_shr:2 row_mask:0xf bank_mask:0xf\n\tv_mul_f32_dpp %6, %6, %6 row_shr:2 row_mask:0xf bank_mask:0xf\n\tv_mul_f32_dpp %7, %7, %7 row_shr:2 row_mask:0xf bank_mask:0xf\n\tv_mul_f32_dpp %8, %8, %8 row_shr:2 row_mask:0xf bank_mask:0xf\n\tv_mul_f32_dpp %9, %9, %9 row_shr:2 row_mask:0xf bank_mask:0xf\n\tv_mul_f32_dpp %10, %10, %10 row_shr:2 row_mask:0xf bank_mask:0xf\n\tv_mul_f32_dpp %11, %11, %11 row_shr:2 row_mask:0xf bank_mask:0xf\n\tv_mul_f32_dpp %12, %12, %12 row_shr:2 row_mask:0xf bank_mask:0xf\n\tv_mul_f32_dpp %13, %13, %13 row_shr:2 row_mask:0xf bank_mask:0xf\n\tv_mul_f32_dpp %14, %14, %14 row_shr:2 row_mask:0xf bank_mask:0xf\n\tv_mul_f32_dpp %15, %15, %15 row_shr:2 row_mask:0xf bank_mask:0xf\n\t" : "+v"(P[0]), "+v"(P[1]), "+v"(P[2]), "+v"(P[3]), "+v"(P[4]), "+v"(P[5]), "+v"(P[6]), "+v"(P[7]), "+v"(P[8]), "+v"(P[9]), "+v"(P[10]), "+v"(P[11]), "+v"(P[12]), "+v"(P[13]), "+v"(P[14]), "+v"(P[15]));
    asm volatile("v_mul_f32_dpp %0, %0, %0 row_shr:4 row_mask:0xf bank_mask:0xf\n\tv_mul_f32_dpp %1, %1, %1 row_shr:4 row_mask:0xf bank_mask:0xf\n\tv_mul_f32_dpp %2, %2, %2 row_shr:4 row_mask:0xf bank_mask:0xf\n\tv_mul_f32_dpp %3, %3, %3 row_shr:4 row_mask:0xf bank_mask:0xf\n\tv_mul_f32_dpp %4, %4, %4 row_shr:4 row_mask:0xf bank_mask:0xf\n\tv_mul_f32_dpp %5, %5, %5 row_shr:4 row_mask:0xf bank_mask:0xf\n\tv_mul_f32_dpp %6, %6, %6 row_shr:4 row_mask:0xf bank_mask:0xf\n\tv_mul_f32_dpp %7, %7, %7 row_shr:4 row_mask:0xf bank_mask:0xf\n\tv_mul_f32_dpp %8, %8, %8 row_shr:4 row_mask:0xf bank_mask:0xf\n\tv_mul_f32_dpp %9, %9, %9 row_shr:4 row_mask:0xf bank_mask:0xf\n\tv_mul_f32_dpp %10, %10, %10 row_shr:4 row_mask:0xf bank_mask:0xf\n\tv_mul_f32_dpp %11, %11, %11 row_shr:4 row_mask:0xf bank_mask:0xf\n\tv_mul_f32_dpp %12, %12, %12 row_shr:4 row_mask:0xf bank_mask:0xf\n\tv_mul_f32_dpp %13, %13, %13 row_shr:4 row_mask:0xf bank_mask:0xf\n\tv_mul_f32_dpp %14, %14, %14 row_shr:4 row_mask:0xf bank_mask:0xf\n\tv_mul_f32_dpp %15, %15, %15 row_shr:4 row_mask:0xf bank_mask:0xf\n\t" : "+v"(P[0]), "+v"(P[1]), "+v"(P[2]), "+v"(P[3]), "+v"(P[4]), "+v"(P[5]), "+v"(P[6]), "+v"(P[7]), "+v"(P[8]), "+v"(P[9]), "+v"(P[10]), "+v"(P[11]), "+v"(P[12]), "+v"(P[13]), "+v"(P[14]), "+v"(P[15]));
    asm volatile("v_mul_f32_dpp %0, %0, %0 row_shr:8 row_mask:0xf bank_mask:0xf\n\tv_mul_f32_dpp %1, %1, %1 row_shr:8 row_mask:0xf bank_mask:0xf\n\tv_mul_f32_dpp %2, %2, %2 row_shr:8 row_mask:0xf bank_mask:0xf\n\tv_mul_f32_dpp %3, %3, %3 row_shr:8 row_mask:0xf bank_mask:0xf\n\tv_mul_f32_dpp %4, %4, %4 row_shr:8 row_mask:0xf bank_mask:0xf\n\tv_mul_f32_dpp %5, %5, %5 row_shr:8 row_mask:0xf bank_mask:0xf\n\tv_mul_f32_dpp %6, %6, %6 row_shr:8 row_mask:0xf bank_mask:0xf\n\tv_mul_f32_dpp %7, %7, %7 row_shr:8 row_mask:0xf bank_mask:0xf\n\tv_mul_f32_dpp %8, %8, %8 row_shr:8 row_mask:0xf bank_mask:0xf\n\tv_mul_f32_dpp %9, %9, %9 row_shr:8 row_mask:0xf bank_mask:0xf\n\tv_mul_f32_dpp %10, %10, %10 row_shr:8 row_mask:0xf bank_mask:0xf\n\tv_mul_f32_dpp %11, %11, %11 row_shr:8 row_mask:0xf bank_mask:0xf\n\tv_mul_f32_dpp %12, %12, %12 row_shr:8 row_mask:0xf bank_mask:0xf\n\tv_mul_f32_dpp %13, %13, %13 row_shr:8 row_mask:0xf bank_mask:0xf\n\tv_mul_f32_dpp %14, %14, %14 row_shr:8 row_mask:0xf bank_mask:0xf\n\tv_mul_f32_dpp %15, %15, %15 row_shr:8 row_mask:0xf bank_mask:0xf\n\t" : "+v"(P[0]), "+v"(P[1]), "+v"(P[2]), "+v"(P[3]), "+v"(P[4]), "+v"(P[5]), "+v"(P[6]), "+v"(P[7]), "+v"(P[8]), "+v"(P[9]), "+v"(P[10]), "+v"(P[11]), "+v"(P[12]), "+v"(P[13]), "+v"(P[14]), "+v"(P[15]));
    asm volatile("v_mul_f32_dpp %0, %0, %0 row_bcast:15 row_mask:0xa bank_mask:0xf\n\tv_mul_f32_dpp %1, %1, %1 row_bcast:15 row_mask:0xa bank_mask:0xf\n\tv_mul_f32_dpp %2, %2, %2 row_bcast:15 row_mask:0xa bank_mask:0xf\n\tv_mul_f32_dpp %3, %3, %3 row_bcast:15 row_mask:0xa bank_mask:0xf\n\tv_mul_f32_dpp %4, %4, %4 row_bcast:15 row_mask:0xa bank_mask:0xf\n\tv_mul_f32_dpp %5, %5, %5 row_bcast:15 row_mask:0xa bank_mask:0xf\n\tv_mul_f32_dpp %6, %6, %6 row_bcast:15 row_mask:0xa bank_mask:0xf\n\tv_mul_f32_dpp %7, %7, %7 row_bcast:15 row_mask:0xa bank_mask:0xf\n\tv_mul_f32_dpp %8, %8, %8 row_bcast:15 row_mask:0xa bank_mask:0xf\n\tv_mul_f32_dpp %9, %9, %9 row_bcast:15 row_mask:0xa bank_mask:0xf\n\tv_mul_f32_dpp %10, %10, %10 row_bcast:15 row_mask:0xa bank_mask:0xf\n\tv_mul_f32_dpp %11, %11, %11 row_bcast:15 row_mask:0xa bank_mask:0xf\n\tv_mul_f32_dpp %12, %12, %12 row_bcast:15 row_mask:0xa bank_mask:0xf\n\tv_mul_f32_dpp %13, %13, %13 row_bcast:15 row_mask:0xa bank_mask:0xf\n\tv_mul_f32_dpp %14, %14, %14 row_bcast:15 row_mask:0xa bank_mask:0xf\n\tv_mul_f32_dpp %15, %15, %15 row_bcast:15 row_mask:0xa bank_mask:0xf\n\t" "s_nop 1" : "+v"(P[0]), "+v"(P[1]), "+v"(P[2]), "+v"(P[3]), "+v"(P[4]), "+v"(P[5]), "+v"(P[6]), "+v"(P[7]), "+v"(P[8]), "+v"(P[9]), "+v"(P[10]), "+v"(P[11]), "+v"(P[12]), "+v"(P[13]), "+v"(P[14]), "+v"(P[15]));
}
__device__ __forceinline__ float bfx(const v4u& a, const v4u& b, int c) {
    const unsigned w = c < 8 ? (c < 4 ? (c < 2 ? a.x : a.y) : (c < 6 ? a.z : a.w)) : (c < 12 ? (c < 10 ? b.x : b.y) : (c < 14 ? b.z : b.w));
    return (c & 1) ? __uint_as_float(w & 0xffff0000u) : __uint_as_float(w << 16);
}
template <bool FULL> __device__ __forceinline__ void hgrn_seg(unsigned char* lds, const bf16* PB, bf16* OB, const float* lbp, float* HU, const float* HS, float* HLD,
                                                              const int layer, const int chain, const int seg, const int tid) {
    if (!FULL && seg == NSEG - 1) return;
    const int lane = tid & 63, wave = __builtin_amdgcn_readfirstlane(tid >> 6), fr = lane & 15, fq = lane >> 4;
    const int b = chain >> 3, hd = (chain >> 1) & 3, dir = chain & 1;
    const int c0 = (seg * NCHUNK) / NSEG, c1 = ((seg + 1) * NCHUNK) / NSEG;
    float oml[16];
#pragma unroll
    for (int c = 0; c < 16; ++c) { float lb = 0.f; if (layer > 0) { const int ch = dir * 512 + hd * 128 + 16 * wave + c; lb = sigm_acc(lbp[1024 + ch] - lbp[ch]); } oml[c] = 1.0f - lb; }
    bf16* QT = (bf16*)(lds + OFF_QT); bf16* KT = (bf16*)(lds + OFF_KT); bf16* KTT = (bf16*)(lds + OFF_KTT); bf16* VT = (bf16*)(lds + OFF_VT); bf16* S0T = (bf16*)(lds + OFF_S0T); bf16* AS = (bf16*)(lds + OFF_AS);
    float* ER = (float*)(lds + OFF_ER); float* D2 = (float*)(lds + OFF_D2);
    if (FULL) for (int i = tid; i < 64 * TS / 2; i += 512) ((unsigned*)AS)[i] = 0u;
    const bf16* pz = PB + (size_t)b * SPB * 2560 + hd * 128 + 16 * wave;
    const int vt_t = tid >> 3, vt_seg = tid & 7;
    const bf16* pv = PB + (size_t)b * SPB * 2560 + 1536 + hd * 128 + vt_seg * 16;
    f32x4 S[8];
#pragma unroll
    for (int vt = 0; vt < 8; ++vt) S[vt] = (f32x4){0.f, 0.f, 0.f, 0.f};
    if (FULL && seg > 0) { const float* sp = HS + ((size_t)(chain * NSEG + seg) * 128 + 16 * wave + 4 * fq) * 128 + fr;
#pragma unroll
        for (int vt = 0; vt < 8; ++vt)
#pragma unroll
            for (int i = 0; i < 4; ++i) S[vt][i] = sp[i * 128 + 16 * vt]; }
    float ldacc[16];
#pragma unroll
    for (int c = 0; c < 16; ++c) ldacc[c] = 0.f;
    v4u z0, z1, q0 = {0u, 0u, 0u, 0u}, q1 = q0, vraw0, vraw1;
    { const bf16* p = pz + (size_t)rowmap(dir, c0, lane) * 2560; z0 = *(const v4u*)(p + 512 + dir * 512); z1 = *(const v4u*)(p + 512 + dir * 512 + 8); if (FULL) { q0 = *(const v4u*)p; q1 = *(const v4u*)(p + 8); }
      const bf16* p2 = pv + (size_t)rowmap(dir, c0, vt_t) * 2560; vraw0 = *(const v4u*)p2; vraw1 = *(const v4u*)(p2 + 8); }
    for (int ci = c0; ci < c1; ++ci) {
        float kk[16], P[16];
#pragma unroll
        for (int c = 0; c < 16; ++c) { const float e = __expf(bfx(z0, z1, c)); const float kj = oml[c] * __builtin_amdgcn_rcpf(1.0f + e); kk[c] = kj; P[c] = 1.0f - kj; }
        scan32_mul16(P);
        unsigned qp[8], kp[8]; float Tv[16], Gv[16];
#pragma unroll
        for (int c = 0; c < 16; c += 2) { float qe[2], ke[2];
#pragma unroll
            for (int h = 0; h < 2; ++h) { const float Pc = P[c + h];
                const float T = fmaxf(__int_as_float(__builtin_amdgcn_readlane(__float_as_int(Pc), 31)), 1e-37f), Gl = __int_as_float(__builtin_amdgcn_readlane(__float_as_int(Pc), 63));
                Tv[c + h] = T; Gv[c + h] = Gl;
                const float inv = __builtin_amdgcn_rcpf(fmaxf(Pc, 1e-37f));
                const float eq = lane < 32 ? Pc * __builtin_amdgcn_rcpf(T) : Pc, ek = lane < 32 ? T * inv : inv;
                ke[h] = kk[c + h] * ek; qe[h] = FULL ? bfx(q0, q1, c + h) * eq : 0.f; }
            kp[c >> 1] = pg8::cvt_pk_bf16(ke[0], ke[1]); if (FULL) qp[c >> 1] = pg8::cvt_pk_bf16(qe[0], qe[1]); }
        if (!FULL) {
#pragma unroll
            for (int c = 0; c < 16; ++c) ldacc[c] += __logf(Tv[c]) + __logf(fmaxf(Gv[c], 1e-37f)); }
        const v4u vr0 = vraw0, vr1 = vraw1;
        { const int cn = ci + 1 < c1 ? ci + 1 : ci;
          const bf16* p = pz + (size_t)rowmap(dir, cn, lane) * 2560; z0 = *(const v4u*)(p + 512 + dir * 512); z1 = *(const v4u*)(p + 512 + dir * 512 + 8); if (FULL) { q0 = *(const v4u*)p; q1 = *(const v4u*)(p + 8); }
          const bf16* p2 = pv + (size_t)rowmap(dir, cn, vt_t) * 2560; vraw0 = *(const v4u*)p2; vraw1 = *(const v4u*)(p2 + 8); }
        __syncthreads();
        if (FULL) { *(v4u*)(QT + lane * QS + 16 * wave) = (v4u){qp[0], qp[1], qp[2], qp[3]}; *(v4u*)(QT + lane * QS + 16 * wave + 8) = (v4u){qp[4], qp[5], qp[6], qp[7]};
                    *(v4u*)(KT + lane * QS + 16 * wave) = (v4u){kp[0], kp[1], kp[2], kp[3]}; *(v4u*)(KT + lane * QS + 16 * wave + 8) = (v4u){kp[4], kp[5], kp[6], kp[7]}; }
#pragma unroll
        for (int c = 0; c < 16; c += 2) { KTT[(16 * wave + c) * TS + lane] = (bf16)(kp[c >> 1] & 0xffffu); KTT[(16 * wave + c + 1) * TS + lane] = (bf16)(kp[c >> 1] >> 16); }
        if (lane == 31) {
#pragma unroll
            for (int c = 0; c < 16; ++c) ER[16 * wave + c] = Tv[c]; }
        if (lane == 63) {
#pragma unroll
            for (int c = 0; c < 16; ++c) D2[16 * wave + c] = Gv[c]; }
        { bf16* vp = VT + (16 * vt_seg) * TS + 8 * ((vt_t >> 3) ^ vt_seg) + (vt_t & 7);
          vp[0 * TS] = (bf16)(vr0.x & 0xffffu); vp[1 * TS] = (bf16)(vr0.x >> 16); vp[2 * TS] = (bf16)(vr0.y & 0xffffu); vp[3 * TS] = (bf16)(vr0.y >> 16);
          vp[4 * TS] = (bf16)(vr0.z & 0xffffu); vp[5 * TS] = (bf16)(vr0.z >> 16); vp[6 * TS] = (bf16)(vr0.w & 0xffffu); vp[7 * TS] = (bf16)(vr0.w >> 16);
          vp[8 * TS] = (bf16)(vr1.x & 0xffffu); vp[9 * TS] = (bf16)(vr1.x >> 16); vp[10 * TS] = (bf16)(vr1.y & 0xffffu); vp[11 * TS] = (bf16)(vr1.y >> 16);
          vp[12 * TS] = (bf16)(vr1.z & 0xffffu); vp[13 * TS] = (bf16)(vr1.z >> 16); vp[14 * TS] = (bf16)(vr1.w & 0xffffu); vp[15 * TS] = (bf16)(vr1.w >> 16); }
        __syncthreads();
        float erv[4], d2v[4];
#pragma unroll
        for (int i = 0; i < 4; ++i) { erv[i] = ER[16 * wave + 4 * fq + i]; d2v[i] = D2[16 * wave + 4 * fq + i]; }
#pragma unroll
        for (int vt = 0; vt < 8; ++vt) { S[vt] = (f32x4){S[vt][0] * erv[0], S[vt][1] * erv[1], S[vt][2] * erv[2], S[vt][3] * erv[3]};
            if (FULL) { u32x2v w; w.x = pg8::cvt_pk_bf16(S[vt][0], S[vt][1]); w.y = pg8::cvt_pk_bf16(S[vt][2], S[vt][3]); *(u32x2v*)(S0T + (16 * vt + fr) * QS + 16 * wave + 4 * fq) = w; } }
        if (FULL) for (int ti = wave; ti < 10; ti += 8) { const int tb = ti >= 6 ? 3 : ti >= 3 ? 2 : ti >= 1 ? 1 : 0, sb = ti - (tb * (tb + 1)) / 2;
            f32x4 acc = {0.f, 0.f, 0.f, 0.f};
#pragma unroll
            for (int k4 = 0; k4 < 4; ++k4) { const bf16x8 a = *(const bf16x8*)(QT + (16 * tb + fr) * QS + 32 * k4 + 8 * fq), bb = *(const bf16x8*)(KT + (16 * sb + fr) * QS + 32 * k4 + 8 * fq); acc = HG_MFMA(a, bb, acc); }
#pragma unroll
            for (int i = 0; i < 4; ++i) { const int t = 16 * tb + 4 * fq + i, s = 16 * sb + fr; AS[t * TS + s] = (bf16)f2bf(s <= t ? acc[i] : 0.f); } }
        { const bf16x8 a0 = *(const bf16x8*)(KTT + (16 * wave + fr) * TS + 8 * fq), a1 = *(const bf16x8*)(KTT + (16 * wave + fr) * TS + 32 + 8 * fq);
#pragma unroll
          for (int vt = 0; vt < 8; ++vt) { const bf16* vrow = VT + (16 * vt + fr) * TS;
              f32x4 acc = HG_MFMA(a0, *(const bf16x8*)(vrow + 8 * (fq ^ vt)), S[vt]); acc = HG_MFMA(a1, *(const bf16x8*)(vrow + 8 * ((4 + fq) ^ vt)), acc);
              S[vt] = (f32x4){acc[0] * d2v[0], acc[1] * d2v[1], acc[2] * d2v[2], acc[3] * d2v[3]}; } }
        if (FULL) {
            __syncthreads();
            const int tb = wave & 3, v0t = (wave >> 2) * 4;
            bf16x8 aq[4], aa[2];
#pragma unroll
            for (int k4 = 0; k4 < 4; ++k4) aq[k4] = *(const bf16x8*)(QT + (16 * tb + fr) * QS + 32 * k4 + 8 * fq);
#pragma unroll
            for (int ks = 0; ks < 2; ++ks) aa[ks] = *(const bf16x8*)(AS + (16 * tb + fr) * TS + 32 * ks + 8 * fq);
            int orow[4];
#pragma unroll
            for (int i = 0; i < 4; ++i) orow[i] = b * SPB + rowmap(dir, ci, 16 * tb + 4 * fq + i);
#pragma unroll
            for (int vi = 0; vi < 4; ++vi) { const int vt = v0t + vi; f32x4 acc = {0.f, 0.f, 0.f, 0.f}; const bf16* srow = S0T + (16 * vt + fr) * QS + 8 * fq; const bf16* vrow = VT + (16 * vt + fr) * TS;
#pragma unroll
                for (int k4 = 0; k4 < 4; ++k4) acc = HG_MFMA(aq[k4], *(const bf16x8*)(srow + 32 * k4), acc);
                acc = HG_MFMA(aa[0], *(const bf16x8*)(vrow + 8 * (fq ^ vt)), acc); acc = HG_MFMA(aa[1], *(const bf16x8*)(vrow + 8 * ((4 + fq) ^ vt)), acc);
#pragma unroll
                for (int i = 0; i < 4; ++i) OB[((size_t)dir * MT + orow[i]) * 512 + hd * 128 + 16 * vt + fr] = (bf16)f2bf(acc[i]); }
        }
    }
    if (!FULL) { float* up = HU + ((size_t)(chain * NSEG + seg) * 128 + 16 * wave + 4 * fq) * 128 + fr;
#pragma unroll
        for (int vt = 0; vt < 8; ++vt)
#pragma unroll
            for (int i = 0; i < 4; ++i) up[i * 128 + 16 * vt] = S[vt][i];
        if (lane == 63) {
#pragma unroll
            for (int c = 0; c < 16; ++c) HLD[(chain * NSEG + seg) * 128 + 16 * wave + c] = ldacc[c]; } }
    __syncthreads();
}
__device__ __forceinline__ void hgrn_carry(const float* HU, float* HS, const float* HLD, const int vcu, const int G, const int tid) {
    for (int e = vcu * 512 + tid; e < 16 * 16384; e += G * 512) { const int chain = e >> 14, kv = e & 16383, k = kv >> 7; float s = 0.f;
        for (int g = 0; g + 1 < NSEG; ++g) { const size_t o = (size_t)(chain * NSEG + g) * 16384 + kv; s = __expf(HLD[(chain * NSEG + g) * 128 + k]) * s + HU[o]; HS[o + 16384] = s; } }
}
#undef HG_MFMA
}
constexpr int NPL = 13;
constexpr int NPHASE = 2 + DEPTH * NPL;
struct Args { const float* in[24]; float* out; unsigned char* ws; int ph_lo, ph_hi, li, pad; };
enum { I_X = 0, I_C, I_CTX, I_CCTX, I_WMOD, I_BMOD, I_N1G, I_N2G, I_WIN, I_CONVW, I_LBP, I_HNG, I_QNG, I_KNG, I_WA, I_WB, I_WC, I_WOUT, I_RW, I_RB, I_WG, I_WU, I_WD, I_FG };

typedef __attribute__((address_space(4))) const Args CArgs;
__device__ __forceinline__ const CArgs* kap() { const CArgs* p = (const CArgs*)__builtin_amdgcn_kernarg_segment_ptr(); asm volatile("" : "+s"(p)); return p; }
#define IN(k) (lo <= (k) && (k) < hi)
#define PHASE_VARS int tid_ = threadIdx.x; asm volatile("" : "+v"(tid_)); const int tid = tid_, lane = tid_ & 63; (void)tid; (void)lane; PHASE_PTRS
#define PHASE_PTRS const CArgs* A = kap(); unsigned char* ws = A->ws; (void)ws;
#define WSP(T, off) ((T*)(ws + (off)))
#define SEAM(k) do { if (IN(k) && IN((k) + 1)) xcd_barrier(bar); } while (0)
template <int LAYER> __device__ __forceinline__ void layer_phases(const int lo, const int hi, const XcdBarrier& bar, unsigned char* lds) {
    constexpr int layer = LAYER;
    LAS unsigned char* ldsl = (LAS unsigned char*)lds;
    const int wave = __builtin_amdgcn_readfirstlane((int)threadIdx.x >> 6);
    const int G = gridDim.x; const int bx = blockIdx.x; const int vcu = (G % 8 == 0) ? (bx % 8) * (G / 8) + bx / 8 : bx;
    const int gw = vcu * NWAVES + wave, NGW = G * NWAVES;
    LAS float* scr = (LAS float*)(ldsl + wave * 16384); (void)scr;
        const int pb = 2 + layer * NPL;
        if (IN(pb + 0)) { PHASE_PTRS
            pg8::Gemm g{WSP(bf16, WS_U), WSP(bf16, WS_WIN) + (size_t)layer * NWIN * D, MT, N1, D, D}; pg8::StaticOrder S; S.init(MT, N1, G, bx);
            pg8::EpiW1 E{WSP(bf16, WS_PA), WSP(bf16, WS_PB), WSP(bf16, WS_PC)};
            pg8::gemm_phase<pg8::EpiW1, pg8::StaticOrder, true, true>(ldsl, g, S, E);
        }
        SEAM(pb + 0);
        if (IN(pb + 1)) { PHASE_VARS
            const float* cw = A->in[I_CONVW] + layer * 3 * 512; const float* qg = A->in[I_QNG] + layer * 64; const float* kg = A->in[I_KNG] + layer * 64;
            const bf16* PAp = WSP(bf16, WS_PA); bf16* YCp = WSP(bf16, WS_YCAT); bf16* PCp = WSP(bf16, WS_PC); const float* ropet = WSP(float, WS_SMALL + SM_ROPE);
            const f32x4 w0a = *(const f32x4*)(cw + 8 * lane), w0b = *(const f32x4*)(cw + 8 * lane + 4), w1a = *(const f32x4*)(cw + 512 + 8 * lane), w1b = *(const f32x4*)(cw + 512 + 8 * lane + 4),
                        w2a = *(const f32x4*)(cw + 1024 + 8 * lane), w2b = *(const f32x4*)(cw + 1024 + 8 * lane + 4);
            const int c8 = lane & 7;
            const f32x4 qga = *(const f32x4*)(qg + 8 * c8), qgb = *(const f32x4*)(qg + 8 * c8 + 4), kga = *(const f32x4*)(kg + 8 * c8), kgb = *(const f32x4*)(kg + 8 * c8 + 4);
            for (int r0 = gw * 2; r0 < MT; r0 += NGW * 2) {
                f32x4 x0a[2], x0b[2], xma[2], xmb[2], xpa[2], xpb[2], aba[2], abb[2], qa[2], qb[2], ka[2], kb[2];
#pragma unroll
                for (int i = 0; i < 2; ++i) { const int r = r0 + i, b = r >= SPB ? 1 : 0, s = r - b * SPB; const bool first = (s == 0 || s == CTX), last = (s == CTX - 1 || s == SPB - 1);
                    const bf16* pa = PAp + (size_t)r * 1024 + 8 * lane; xma[i] = (f32x4){0.f, 0.f, 0.f, 0.f}; xmb[i] = xma[i]; xpa[i] = xma[i]; xpb[i] = xma[i];
                    pg8::ld8(pa, x0a[i], x0b[i]); if (!first) pg8::ld8(pa - 1024, xma[i], xmb[i]); if (!last) pg8::ld8(pa + 1024, xpa[i], xpb[i]); pg8::ld8(pa + 512, aba[i], abb[i]);
                    const bf16* pc = PCp + (size_t)r * 768; pg8::ld8(pc + 8 * lane, qa[i], qb[i]); pg8::ld8(pc + 512 + 8 * (lane & 15), ka[i], kb[i]); }
#pragma unroll
                for (int i = 0; i < 2; ++i) { const int r = r0 + i, b = r >= SPB ? 1 : 0, s = r - b * SPB, t = s - CTX;
                    pg8::st8(YCp + (size_t)r * 1536 + 8 * lane, aba[i] * (w0a * xma[i] + w1a * x0a[i] + w2a * xpa[i]), abb[i] * (w0b * xmb[i] + w1b * x0b[i] + w2b * xpb[i]));
                    const float* rp = s >= CTX ? ropet + 2 * (((c8 < 4) ? (t >> 6) : 256 + (t & 63)) * 16 + 8 * (c8 & 1)) : nullptr;
                    bf16* pc = PCp + (size_t)r * 768;
                    qk_norm_rope(qa[i], qb[i], qga, qgb, rp, (c8 & 2) != 0, attn_body::C2); { pg8::u32x2 w; w.x = pg8::pk_fp8x4(qa[i][0], qa[i][1], qa[i][2], qa[i][3]); w.y = pg8::pk_fp8x4(qb[i][0], qb[i][1], qb[i][2], qb[i][3]); *(pg8::u32x2*)((unsigned char*)pc + 8 * lane) = w; }
                    qk_norm_rope(ka[i], kb[i], kga, kgb, rp, (c8 & 2) != 0, 1.0f); if (lane < 16) { pg8::u32x2 w; w.x = pg8::pk_fp8x4(ka[i][0], ka[i][1], ka[i][2], ka[i][3]); w.y = pg8::pk_fp8x4(kb[i][0], kb[i][1], kb[i][2], kb[i][3]); *(pg8::u32x2*)((unsigned char*)pc + 1024 + 8 * lane) = w; } }
            }
            if (layer > 0) convert_experts(A->in[I_WG], A->in[I_WU], A->in[I_WD], layer, WSP(bf16, WS_WEXP), scr, gw, NGW, lane);
        }
        __syncthreads();
        if (IN(pb + 1)) { PHASE_VARS for (int u = vcu; u < 256; u += G) hg::hgrn_seg<false>(lds, WSP(bf16, WS_PB), WSP(bf16, WS_OBUF), A->in[I_LBP], WSP(float, WS_HGU), WSP(float, WS_HGS), WSP(float, WS_SMALL + SM_HLD), layer, u >> 4, u & 15, tid); }
        SEAM(pb + 1);
        if (IN(pb + 2)) { PHASE_VARS hg::hgrn_carry(WSP(float, WS_HGU), WSP(float, WS_HGS), WSP(float, WS_SMALL + SM_HLD), vcu, G, tid); }
        __syncthreads();
        if (IN(pb + 2)) { PHASE_PTRS
            const attn_body::bf16* PCb = (const attn_body::bf16*)WSP(bf16, WS_PC); attn_body::bf16* YCb = (attn_body::bf16*)WSP(bf16, WS_YCAT);
            const int per = (1024 + G - 1) / G;
            for (int i = 0; i < per; ++i) { const int id = vcu * per + i; if (id >= 1024) break;
                const int b = id >> 9, h = (id >> 6) & 7, q0 = CTX + (id & 63) * 256; const size_t rb = (size_t)b * SPB;
                attn_body::attn_unit((const unsigned char*)PCb + (rb + q0) * 1536 + h * 64, (const unsigned char*)PCb + rb * 1536 + 1024 + (h >> 2) * 64, (const unsigned char*)PCb + rb * 1536 + 1280 + (h >> 2) * 64, YCb + (rb + q0) * 1536 + 1024 + h * 64, SPB / 64, (char*)lds); }
            if (layer < DEPTH - 1) for (int x = vcu; x < 16; x += G) {
                const int b = x >> 3, h = x & 7; const size_t rb = (size_t)b * SPB;
                attn_body::attn_unit((const unsigned char*)PCb + rb * 1536 + h * 64, (const unsigned char*)PCb + rb * 1536 + 1024 + (h >> 2) * 64, (const unsigned char*)PCb + rb * 1536 + 1280 + (h >> 2) * 64, YCb + rb * 1536 + 1024 + h * 64, CTX / 64, (char*)lds); }
        }
        SEAM(pb + 2);
        if (IN(pb + 3)) { PHASE_VARS for (int u = vcu; u < 256; u += G) hg::hgrn_seg<true>(lds, WSP(bf16, WS_PB), WSP(bf16, WS_OBUF), A->in[I_LBP], WSP(float, WS_HGU), WSP(float, WS_HGS), WSP(float, WS_SMALL + SM_HLD), layer, u >> 4, u & 15, tid); }
        SEAM(pb + 3);
        if (IN(pb + 4)) { PHASE_VARS
            const float* hg = A->in[I_HNG] + layer * 512; const bf16* OBp = WSP(bf16, WS_OBUF); const bf16* PBp = WSP(bf16, WS_PB); bf16* YCp = WSP(bf16, WS_YCAT);
            const f32x4 n0 = *(const f32x4*)(hg + 8 * lane), n1 = *(const f32x4*)(hg + 8 * lane + 4);
            for (int r0 = gw * 4; r0 < MT; r0 += NGW * 4) { f32x4 a0[4], a1[4], b0[4], b1[4], g0[4], g1[4];
#pragma unroll
                for (int i = 0; i < 4; ++i) { const size_t r = r0 + i; pg8::ld8(OBp + r * 512 + 8 * lane, a0[i], a1[i]); pg8::ld8(OBp + ((size_t)MT + r) * 512 + 8 * lane, b0[i], b1[i]); pg8::ld8(PBp + r * 2560 + 2048 + 8 * lane, g0[i], g1[i]); }
#pragma unroll
                for (int i = 0; i < 4; ++i) { const size_t r = r0 + i; a0[i] += b0[i]; a1[i] += b1[i];
                    float ss = (a0[i][0] * a0[i][0] + a0[i][1] * a0[i][1]) + (a0[i][2] * a0[i][2] + a0[i][3] * a0[i][3]) + (a1[i][0] * a1[i][0] + a1[i][1] * a1[i][1]) + (a1[i][2] * a1[i][2] + a1[i][3] * a1[i][3]);
                    ss = row_sum16(ss);
                    const float rs = 1.0f / sqrtf(ss * (1.0f / 128.0f) + EPS);
                    pg8::st8(YCp + r * 1536 + 512 + 8 * lane, a0[i] * rs * n0 * g0[i], a1[i] * rs * n1 * g1[i]); } }
        }
        SEAM(pb + 4);
        if (IN(pb + 5)) { PHASE_PTRS
            pg8::Gemm g{WSP(bf16, WS_U8), (const bf16*)(WSP(unsigned char, WS_WG8) + (size_t)layer * NGATE * D), MT, NGATE, D / 2, D / 2};   pg8::RowOrder S; S.init(layer == DEPTH - 1, NGATE, 1, G, bx);
            pg8::EpiGate E{WSP(bf16, WS_GATES)};
            pg8::gemm_phase<pg8::EpiGate, pg8::RowOrder, true, true, true>(ldsl, g, S, E);
        }
        SEAM(pb + 5);
        if (IN(pb + 6)) { PHASE_PTRS pg8::Gemm g{WSP(bf16, WS_YCAT), WSP(bf16, WS_WABC) + (size_t)(layer * 3) * D * 512, MT, D, 512, 1536, (size_t)512 * 2, (size_t)D * 512 * 2};
            pg8::RowOrder S; S.init(layer == DEPTH - 1, D, 3, G, bx); pg8::EpiMerge3 E{WSP(bf16, WS_GATES), WSP(bf16, WS_U)};
            pg8::gemm_phase<pg8::EpiMerge3, pg8::RowOrder, true, true>(ldsl, g, S, E); }
        SEAM(pb + 6);
        if (IN(pb + 7)) { PHASE_PTRS pg8::Gemm g{WSP(bf16, WS_U), WSP(bf16, WS_WO) + (size_t)layer * D * D, MT, D, D, D}; pg8::RowOrder S; S.init(layer == DEPTH - 1, D, 1, G, bx); pg8::EpiWo E{WSP(bf16, WS_DELTA), (WSP(float, WS_MOD) + (size_t)layer * 3 * 6144)};
            pg8::gemm_phase<pg8::EpiWo, pg8::RowOrder, true, true>(ldsl, g, S, E); }
        SEAM(pb + 7);
        if (IN(pb + 8)) { PHASE_VARS
            int* lcnt = (int*)lds; float* rwT = (float*)(lds + 1024);
            if (tid < 16) lcnt[tid] = 0;
            { const float* rwg = A->in[I_RW]; for (int i = tid; i < D * NE; i += NWAVES * 64) rwT[(i & 15) * D + (i >> 4)] = rwg[i]; }
            __syncthreads();
            const float* rw = A->in[I_RW]; (void)rw; const float* rb = A->in[I_RB]; const float* hl = layer == 0 ? A->in[I_X] : (const float*)A->out; const float* hc = layer == 0 ? A->in[I_CTX] : (const float*)WSP(float, WS_HCTX); const bf16* DLp = WSP(bf16, WS_DELTA); const float* modl_ = WSP(float, WS_MOD) + (size_t)layer * 3 * 6144;
            const float* n2g = A->in[I_N2G] + layer * D; bf16* U = WSP(bf16, WS_U); int* re_ = WSP(int, WS_SMALL + SM_RE); float* rwt_ = WSP(float, WS_SMALL + SM_RW); int* rp_ = WSP(int, WS_SMALL + SM_RP);
            for (int r0 = gw * 2; r0 < MT; r0 += NGW * 2) { if (layer == DEPTH - 1 && mod_idx(r0) == 2) continue;
                f32x4 v[2][4], y[2][4];
#pragma unroll
                for (int i = 0; i < 2; ++i) { if (layer == 0) load_row(hrow(hl, hc, r0 + i), lane, v[i]); else load_h1(A->out, WSP(float, WS_HCTX), r0 + i, lane, v[i]); add_row_bf16(DLp + (size_t)(r0 + i) * D, lane, v[i]); }
#pragma unroll
                for (int i = 0; i < 2; ++i) { const float* m = modl_ + (size_t)mod_idx(r0 + i) * 6144; norm_mod(v[i], n2g, m + 4 * 1024, m + 3 * 1024, lane, y[i]); store_row_fp8((unsigned char*)U + (size_t)(r0 + i) * D, lane, y[i]); }
                float lg[2][16];
#pragma unroll
                for (int e = 0; e < 16; ++e) { lg[0][e] = 0.f; lg[1][e] = 0.f; }
#pragma unroll
                for (int j = 0; j < 4; ++j)
#pragma unroll
                    for (int e = 0; e < 16; ++e) { const f32x4 w = *(const f32x4*)(rwT + e * D + 4 * lane + 256 * j);
                        lg[0][e] = fmaf(y[0][j][0], w[0], fmaf(y[0][j][1], w[1], fmaf(y[0][j][2], w[2], fmaf(y[0][j][3], w[3], lg[0][e]))));
                        lg[1][e] = fmaf(y[1][j][0], w[0], fmaf(y[1][j][1], w[1], fmaf(y[1][j][2], w[2], fmaf(y[1][j][3], w[3], lg[1][e])))); }
#define RT_DPP(x, ctrl) __int_as_float(__builtin_amdgcn_update_dpp(__float_as_int(x), __float_as_int(x), (ctrl), 0xf, 0xf, false))
#define RT_XOR4(dst, x) do { int t_ = __builtin_amdgcn_update_dpp(__float_as_int(x), __float_as_int(x), 0x104, 0xf, 0x5, false); t_ = __builtin_amdgcn_update_dpp(t_, __float_as_int(x), 0x114, 0xf, 0xa, false); dst = __int_as_float(t_); } while (0)
                float z[16], w8[8], c4[4], d2[2];
#pragma unroll
                for (int e = 0; e < 16; ++e) { const auto rr = __builtin_amdgcn_permlane32_swap(__float_as_uint(lg[0][e]), __float_as_uint(lg[1][e]), false, false); z[e] = __uint_as_float(rr[0]) + __uint_as_float(rr[1]); }
#pragma unroll
                for (int e = 0; e < 8; ++e) { const auto rr = __builtin_amdgcn_permlane16_swap(__float_as_uint(z[e]), __float_as_uint(z[e + 8]), false, false); w8[e] = __uint_as_float(rr[0]) + __uint_as_float(rr[1]); }
                const bool b4 = (lane & 16) != 0, b3 = (lane & 8) != 0, b2 = (lane & 4) != 0, b1 = (lane & 2) != 0;
#pragma unroll
                for (int p = 0; p < 4; ++p) { const float s1 = b3 ? w8[p + 4] : w8[p], s2 = b3 ? w8[p] : w8[p + 4]; c4[p] = s1 + RT_DPP(s2, 0x128); }
#pragma unroll
                for (int p = 0; p < 2; ++p) { const float s1 = b2 ? c4[p + 2] : c4[p], s2 = b2 ? c4[p] : c4[p + 2]; float x_; RT_XOR4(x_, s2); d2[p] = s1 + x_; }
                float lgt; { const float s1 = b1 ? d2[1] : d2[0], s2 = b1 ? d2[0] : d2[1]; lgt = s1 + RT_DPP(s2, 0x4e); }
                lgt += RT_DPP(lgt, 0xb1);
                const int ex = (lane >> 1) & 15; const float scv = __builtin_amdgcn_rcpf(1.0f + __expf(-lgt)); const float sel = scv + rb[ex];
                float o2_; RT_XOR4(o2_, sel); const float o1_ = RT_DPP(sel, 0x4e), o3_ = RT_DPP(o2_, 0x4e);
                const int rank = (int)(o1_ > sel || (o1_ == sel && b1)) + (int)(o2_ > sel || (o2_ == sel && b2)) + (int)(o3_ > sel || (o3_ == sel && b2));
                float gs = rank < 2 ? sel : 0.f; gs += RT_DPP(gs, 0x4e); { float x_; RT_XOR4(x_, gs); gs += x_; }
                float g2_; { const auto rr = __builtin_amdgcn_permlane16_swap(__float_as_uint(gs), __float_as_uint(gs), false, false); g2_ = b4 ? __uint_as_float(rr[0]) : __uint_as_float(rr[1]); }
                const float g1_ = RT_DPP(gs, 0x128), g3_ = RT_DPP(g2_, 0x128);
                const bool gbest = !(g1_ > gs || (g1_ == gs && b3)) && !(g2_ > gs || (g2_ == gs && b4)) && !(g3_ > gs || (g3_ == gs && b4));
                const unsigned long long m0 = __ballot(gbest && rank == 0), m1 = __ballot(gbest && rank == 1);
#undef RT_DPP
#undef RT_XOR4
#pragma unroll
                for (int i = 0; i < 2; ++i) { const int r = r0 + i;
                    const int l0 = 32 * i + __builtin_ctz((unsigned)(m0 >> (32 * i))), l1 = 32 * i + __builtin_ctz((unsigned)(m1 >> (32 * i)));
                    const int i0 = (l0 >> 1) & 15, i1 = (l1 >> 1) & 15; const float w0 = __int_as_float(__builtin_amdgcn_readlane(__float_as_int(scv), l0)), w1 = __int_as_float(__builtin_amdgcn_readlane(__float_as_int(scv), l1));
                    if (lane == 0) { const float inv = 1.0f / (w0 + w1); const int k0 = atomicAdd(&lcnt[i0], 1), k1 = atomicAdd(&lcnt[i1], 1);
                        re_[2 * r] = i0; re_[2 * r + 1] = i1; rwt_[2 * r] = w0 * inv; rwt_[2 * r + 1] = w1 * inv; rp_[2 * r] = k0; rp_[2 * r + 1] = k1; } }
            }
            __syncthreads();
            if (tid < 16) WSP(int, WS_SMALL + SM_BCNT)[vcu * 16 + tid] = lcnt[tid];
            __syncthreads();
        }
        SEAM(pb + 8);
        if (IN(pb + 9)) { PHASE_VARS
            int* ltot = (int*)lds; int* lbef = ltot + 16; int* lbase = ltot + 32;
            const int* bc = WSP(int, WS_SMALL + SM_BCNT); int* tab = WSP(int, WS_SMALL + SM_TAB); int* re_ = WSP(int, WS_SMALL + SM_RE); int* rp_ = WSP(int, WS_SMALL + SM_RP);
            const unsigned char* U = WSP(unsigned char, WS_U); unsigned char* XSp = WSP(unsigned char, WS_XS);
            if (tid < 32) ltot[tid] = 0;
            __syncthreads();
            { const int e = tid & 15; int tot = 0, bef = 0;
              for (int b2 = (tid >> 4); b2 < G; b2 += 32) { const int c = bc[b2 * 16 + e]; tot += c; if (b2 < vcu) bef += c; }
              atomicAdd(&ltot[e], tot); atomicAdd(&lbef[e], bef); }
            __syncthreads();
            if (tid == 0) { int run = 0;
                for (int e = 0; e < 16; ++e) { const int pad = (ltot[e] + 255) / 256 * 256; lbase[e] = run + lbef[e];
                    if (vcu == 0) for (int t2 = run / 256; t2 < (run + pad) / 256; ++t2) tab[1 + t2] = e;
                    run += pad; }
                if (vcu == 0) tab[0] = run / 256; }
            __syncthreads();
            for (int r0 = gw * 2; r0 < MT; r0 += NGW * 4) {
                int p0[4], p1[4]; v4u a[4]; bool ok[4];
#pragma unroll
                for (int i = 0; i < 4; ++i) { const int r = r0 + (i >> 1) * NGW * 2 + (i & 1); ok[i] = r < MT && !(layer == DEPTH - 1 && mod_idx(r) == 2); const int rc = ok[i] ? r : 0;
                    p0[i] = lbase[re_[2 * rc]] + rp_[2 * rc]; p1[i] = lbase[re_[2 * rc + 1]] + rp_[2 * rc + 1];
                    a[i] = *(const v4u*)(U + (size_t)rc * D + 16 * lane); }
                asm volatile("" ::: "memory");
#pragma unroll
                for (int i = 0; i < 4; ++i) { const int r = r0 + (i >> 1) * NGW * 2 + (i & 1); if (!ok[i]) continue; if (lane == 0) { rp_[2 * r] = p0[i]; rp_[2 * r + 1] = p1[i]; }
                    const v4u q8 = a[i];
                    *(v4u*)(XSp + (size_t)p0[i] * D + 16 * lane) = q8; *(v4u*)(XSp + (size_t)p1[i] * D + 16 * lane) = q8; } }
            __syncthreads();
        }
        SEAM(pb + 9);
        if (IN(pb + 10)) { PHASE_PTRS pg8::Gemm g{WSP(bf16, WS_XS), WSP(bf16, WS_WEXP), PMAX, 2048, D / 2, D / 2}; pg8::MoeOrder S; S.init(WSP(int, WS_SMALL + SM_TAB), 8, G, vcu); pg8::EpiMoe1 E{WSP(unsigned char, WS_HID)};
            pg8::gemm_phase<pg8::EpiMoe1, pg8::MoeOrder, true, true, true>(ldsl, g, S, E); }
        SEAM(pb + 10);
        if (IN(pb + 11)) { PHASE_PTRS pg8::Gemm g{WSP(bf16, WS_HID), (const bf16*)(WSP(unsigned char, WS_WEXP) + (size_t)NE * 2048 * 1024), PMAX, 1024, DFF / 2, DFF / 2}; pg8::MoeOrder S; S.init(WSP(int, WS_SMALL + SM_TAB), 4, G, vcu); pg8::EpiMoe2 E{WSP(bf16, WS_YS)};
            pg8::gemm_phase<pg8::EpiMoe2, pg8::MoeOrder, true, true, true>(ldsl, g, S, E); }
        SEAM(pb + 11);
        if (IN(pb + 12)) { PHASE_VARS
            float* hl = A->out; float* hc = WSP(float, WS_HCTX); const float* modl_ = WSP(float, WS_MOD) + (size_t)layer * 3 * 6144; const int* rp_ = WSP(int, WS_SMALL + SM_RP); const float* rwt_ = WSP(float, WS_SMALL + SM_RW);
            const float* sl = layer == 0 ? A->in[I_X] : (const float*)A->out; const float* sc_ = layer == 0 ? A->in[I_CTX] : (const float*)WSP(float, WS_HCTX); const bf16* DLp = WSP(bf16, WS_DELTA);
            const bf16* YS = WSP(bf16, WS_YS); bf16* U = WSP(bf16, WS_U); const float* n1g = A->in[I_N1G] + (layer + 1 < DEPTH ? layer + 1 : layer) * D; const float* fg = A->in[I_FG];
            for (int r0 = gw * 4; r0 < MT; r0 += NGW * 4) {
                if (layer == DEPTH - 1 && mod_idx(r0) == 2) continue;
                f32x4 v[4][4]; u32x2v ya[4][4], yb[4][4]; float w0[4], w1[4]; float* hp[4]; int p0[4], p1[4];
#pragma unroll
                for (int i = 0; i < 4; ++i) { const int r = r0 + i; p0[i] = rp_[2 * r]; p1[i] = rp_[2 * r + 1]; w0[i] = rwt_[2 * r]; w1[i] = rwt_[2 * r + 1]; hp[i] = (float*)hrow(hl, hc, r); if (layer == 0) load_row(hrow(sl, sc_, r), lane, v[i]); else load_h1(A->out, WSP(float, WS_HCTX), r, lane, v[i]); add_row_bf16(DLp + (size_t)r * D, lane, v[i]); }
#pragma unroll
                for (int i = 0; i < 4; ++i)
#pragma unroll
                    for (int j = 0; j < 4; ++j) { const int c = 4 * lane + 256 * j; ya[i][j] = *(const u32x2v*)(YS + (size_t)p0[i] * D + c); yb[i][j] = *(const u32x2v*)(YS + (size_t)p1[i] * D + c); }
#pragma unroll
                for (int i = 0; i < 4; ++i) { const int r = r0 + i, mi = mod_idx(r); const float* g2 = modl_ + (size_t)mi * 6144 + 5 * 1024;
#pragma unroll
                    for (int j = 0; j < 4; ++j) { const int c = 4 * lane + 256 * j; const f32x4 gg = *(const f32x4*)(g2 + c);
                        const f32x4 fa = {pg8::bflo(ya[i][j].x), pg8::bfhi(ya[i][j].x), pg8::bflo(ya[i][j].y), pg8::bfhi(ya[i][j].y)}, fb = {pg8::bflo(yb[i][j].x), pg8::bfhi(yb[i][j].x), pg8::bflo(yb[i][j].y), pg8::bfhi(yb[i][j].y)};
                        v[i][j] += gg * (fa * w0[i] + fb * w1[i]); }
                    if (layer < DEPTH - 1) {
#pragma unroll
                        for (int j = 0; j < 4; ++j) { if (mi == 2) *(f32x4*)(hp[i] + 4 * lane + 256 * j) = v[i][j]; }
                        if (mi != 2) store_row_bf16((bf16*)hp[i] + D, lane, v[i]);
                        f32x4 y[4]; const float* m = WSP(float, WS_MOD) + (size_t)((layer + 1) * 3 + mi) * 6144; norm_mod(v[i], n1g, m + 1024, m, lane, y); store_row_bf16(U + (size_t)r * D, lane, y); store_row_fp8(WSP(unsigned char, WS_U8) + (size_t)r * D, lane, y);
                    } else {
                        const float rstd = row_rstd(v[i]);
#pragma unroll
                        for (int j = 0; j < 4; ++j) *(f32x4*)(hp[i] + 4 * lane + 256 * j) = v[i][j] * rstd * *(const f32x4*)(fg + 4 * lane + 256 * j);
                    } }
            }
        }
        SEAM(pb + 12);
    }
__global__ void __launch_bounds__(NWAVES * 64, 2) fwd(Args args) {
    extern __shared__ __attribute__((aligned(16))) unsigned char lds[];
    LAS unsigned char* ldsl = (LAS unsigned char*)lds;
    volatile LAS unsigned* MISC = (volatile LAS unsigned*)(ldsl + MISC_OFF);
    const int tid = threadIdx.x, lane = tid & 63, wave = __builtin_amdgcn_readfirstlane(tid >> 6);
    const int G = gridDim.x; const int bx = blockIdx.x; const int vcu = (G % 8 == 0) ? (bx % 8) * (G / 8) + bx / 8 : bx;
    const int gw = vcu * NWAVES + wave, NGW = G * NWAVES;
    gu32* ctl = (gu32*)(args.ws + WS_CTL);
    for (int u = tid; u < (LDS_BYTES - LDSCTL_OFF) / 4; u += NWAVES * 64) ((LAS unsigned*)(ldsl + LDSCTL_OFF))[u] = 0u;
    __syncthreads();
    const int lo = args.ph_lo, hi = args.ph_hi;
    const bool multi = (hi - lo) > 1;
    XcdBarrier bar; bar.bar = (unsigned*)(ctl + CW_BAR) + args.li * XCD_BAR_WORDS; bar.x = 0; bar.st = nullptr;
    if (multi) bar = xcd_barrier_post((unsigned*)(ctl + CW_BAR) + args.li * XCD_BAR_WORDS, MISC + 8);

    LAS float* scr = (LAS float*)(ldsl + wave * 16384);

    if (IN(0)) { PHASE_VARS
        for (int it = gw; it < DEPTH * 16 * 248; it += NGW) { const int l = it / (16 * 248), r = it % (16 * 248), kb = r / 248, nb = r % 248;
            if (32 * nb < N1) transpose_item(A->in[I_WIN] + (size_t)l * D * NWIN, NWIN, WSP(bf16, WS_WIN) + (size_t)l * NWIN * D, D, win_drow(32 * nb), 64 * kb, 32 * nb, scr, lane);
            else transpose_item<true>(A->in[I_WIN] + (size_t)l * D * NWIN, NWIN, (bf16*)(WSP(unsigned char, WS_WG8) + (size_t)l * NGATE * D), D, 32 * nb - N1, 64 * kb, 32 * nb, scr, lane); }
        for (int it = gw; it < DEPTH * 3 * 256; it += NGW) { const int mat = it / 256, r = it % 256, kb = r / 32, nb = r % 32, l = mat / 3, br = mat % 3;
            const float* W = (br == 0 ? A->in[I_WA] : br == 1 ? A->in[I_WB] : A->in[I_WC]) + (size_t)l * 512 * D;
            transpose_item(W, D, WSP(bf16, WS_WABC) + (size_t)(l * 3 + br) * D * 512, 512, 32 * nb, 64 * kb, 32 * nb, scr, lane); }
        for (int it = gw; it < DEPTH * 512; it += NGW) { const int l = it / 512, r = it % 512, kb = r / 32, nb = r % 32;
            transpose_item(A->in[I_WOUT] + (size_t)l * D * D, D, WSP(bf16, WS_WO) + (size_t)l * D * D, D, 32 * nb, 64 * kb, 32 * nb, scr, lane); }
        convert_experts(A->in[I_WG], A->in[I_WU], A->in[I_WD], 0, WSP(bf16, WS_WEXP), scr, gw, NGW, lane);
        __syncthreads();
        { float* sc = (float*)lds;
          float* red = sc + 3 * 1024;
          for (int i = tid; i < 3 * 1024; i += NWAVES * 64) { const int j = i >> 10, k = i & 1023; const float c = j < 2 ? A->in[I_C][j * 1024 + k] : A->in[I_CCTX][k]; sc[i] = c * sigm_acc(c); }
          __syncthreads();
          for (int unit = vcu; unit < DEPTH * 96; unit += G) { const int l = unit / 96, cg = unit % 96, col = cg * 64 + lane;
              const float* W = A->in[I_WMOD] + (size_t)l * D * 6144 + col; float a0 = 0.f, a1 = 0.f, a2 = 0.f;
#pragma unroll 8
              for (int k = wave * 128; k < wave * 128 + 128; ++k) { const float w = W[(size_t)k * 6144]; a0 += sc[k] * w; a1 += sc[1024 + k] * w; a2 += sc[2048 + k] * w; }
              red[(wave * 3 + 0) * 64 + lane] = a0; red[(wave * 3 + 1) * 64 + lane] = a1; red[(wave * 3 + 2) * 64 + lane] = a2;
              __syncthreads();
              if (tid < 192) { const int j = tid >> 6, ln = tid & 63; float s = 0.f;
#pragma unroll
                  for (int w = 0; w < 8; ++w) s += red[(w * 3 + j) * 64 + ln];
                  const int c = cg * 64 + ln; WSP(float, WS_MOD)[(size_t)(l * 3 + j) * 6144 + c] = s + A->in[I_BMOD][l * 6144 + c]; }
              __syncthreads(); }
        }
        for (int i = gw * 64 + lane; i < 320 * 16; i += NGW * 64) { const int pos = (i >> 4) < 256 ? (i >> 4) : (i >> 4) - 256, fi = i & 15;
            const float inv = __builtin_amdgcn_exp2f(-(float)(2 * fi) * (13.287712379549449f / 32.0f)); const float a = (float)pos * inv;
            const double ad = (double)a; const double rev = ad * 0.15915494309189535; const double fr = rev - __builtin_rint(rev); const float red = (float)(fr * 6.283185307179586);
            WSP(float, WS_SMALL + SM_ROPE)[2 * i] = __cosf(red); WSP(float, WS_SMALL + SM_ROPE)[2 * i + 1] = __sinf(red); }
    }
    SEAM(0);
    if (IN(1)) { PHASE_VARS
        const float* mod0 = WSP(float, WS_MOD); bf16* U = WSP(bf16, WS_U); unsigned char* U8 = WSP(unsigned char, WS_U8); const float* xin = A->in[I_X]; const float* cin = A->in[I_CTX]; const float* n1g = A->in[I_N1G];
        for (int r0 = gw * 4; r0 < MT; r0 += NGW * 4) { f32x4 v[4][4];
#pragma unroll
            for (int i = 0; i < 4; ++i) load_row(hrow(xin, cin, r0 + i), lane, v[i]);
#pragma unroll
            for (int i = 0; i < 4; ++i) { f32x4 y[4]; const float* m = mod0 + (size_t)mod_idx(r0 + i) * 6144; norm_mod(v[i], n1g, m + 1024, m, lane, y); store_row_bf16(U + (size_t)(r0 + i) * D, lane, y); store_row_fp8(U8 + (size_t)(r0 + i) * D, lane, y); } }
    }
    SEAM(1);

    layer_phases<0>(lo, hi, bar, lds);
    layer_phases<1>(lo, hi, bar, lds);
#undef PHASE_VARS
#undef PHASE_PTRS
#undef WSP
#undef IN
#undef SEAM
}

extern "C" void kernel_launch(void* const* d_in, const int* in_sizes, int n_in, void* d_out, int out_size, void* d_ws, size_t ws_size, hipStream_t stream) {
    static int grid = 0;
    if (grid == 0) {
        if (n_in != 24 || out_size != NB * SEQ * D || ws_size < WS_END) { fprintf(stderr, "kernel_launch: unexpected shapes (n_in %d, out %d, ws %zu < %zu); nothing launched\n", n_in, out_size, ws_size, (size_t)WS_END); grid = -1; return; }
        int dev = 0, cus = 0, per_cu = 0;
        if (hipGetDevice(&dev) != hipSuccess || hipDeviceGetAttribute(&cus, hipDeviceAttributeMultiprocessorCount, dev) != hipSuccess) { grid = -1; return; }
        if (hipFuncSetAttribute((const void*)fwd, hipFuncAttributeMaxDynamicSharedMemorySize, LDS_BYTES) != hipSuccess) { fprintf(stderr, "kernel_launch: hipFuncSetAttribute failed\n"); grid = -1; return; }
        if (hipOccupancyMaxActiveBlocksPerMultiprocessor(&per_cu, (const void*)fwd, NWAVES * 64, LDS_BYTES) != hipSuccess || per_cu < 1) { fprintf(stderr, "kernel_launch: occupancy query says %d\n", per_cu); }
        (void)hipGetLastError();
        grid = cus;
    }
    if (grid < 0) return;
    if (hipMemsetAsync((char*)d_ws + WS_CTL, 0, CTL_ZERO_BYTES, stream) != hipSuccess) return;
    Args a{};
    for (int i = 0; i < 24; ++i) a.in[i] = (const float*)d_in[i];
    a.out = (float*)d_out; a.ws = (unsigned char*)d_ws;
#ifndef MK_ONE_LAUNCH
#define MK_ONE_LAUNCH 1
#endif
    if (MK_ONE_LAUNCH) { a.ph_lo = 0; a.ph_hi = NPHASE; a.li = 0; hipLaunchKernelGGL(fwd, dim3(grid), dim3(NWAVES * 64), LDS_BYTES, stream, a); }
    else for (int ph = 0; ph < NPHASE; ++ph) { a.ph_lo = ph; a.ph_hi = ph + 1; a.li = 0; hipLaunchKernelGGL(fwd, dim3(grid), dim3(NWAVES * 64), LDS_BYTES, stream, a); }
}
```

```cpp
#include <hip/hip_runtime.h>
#include <cstdio>
#include <cstdint>
#include <cmath>
#include <hip/hip_bf16.h>
#ifndef ATTN_NSUM
#define ATTN_NSUM 4
#endif
namespace pg8 {
#define PG8_LAS __attribute__((address_space(3)))
typedef unsigned short bf16_t;
typedef short bf16x8 __attribute__((ext_vector_type(8)));
typedef float f32x4 __attribute__((ext_vector_type(4)));
typedef unsigned u32x4 __attribute__((ext_vector_type(4)));
typedef int v4i_t __attribute__((ext_vector_type(4)));
typedef int v8i_t __attribute__((ext_vector_type(8)));
constexpr int BM = 256, BK = 64, HALF = 128, HTB = HALF * BK * 2  , STAGE_BYTES = 8 * HTB, NXCD = 8, WGM = 8;

__host__ __device__ __forceinline__ int lds_byte(int r, int c) { const int st = (r >> 4) * 2 + (c >> 5), rr = r & 15, cc = c & 31, ob = rr * 64 + cc * 2; return st * 1024 + (ob ^ (((ob >> 9) & 1) << 5)); }
__host__ __device__ __forceinline__ void stage_rc(int b, int& R, int& C) { const int st = b / 1024, sb = b % 1024, swz = sb ^ (((sb >> 9) & 1) << 5); R = (st >> 1) * 16 + swz / 64; C = (st & 1) * 32 + (swz % 64) / 2; }
__host__ __device__ __forceinline__ int perm32(int rho) { const int n = rho >> 4, i = rho & 15; return 8 * (i >> 2) + 4 * n + (i & 3); }

struct Unit { int pm, pn, seg; };
struct Gemm { const bf16_t* A; const bf16_t* Bt; int M, N, K, lda; size_t segA, segB; };

struct StaticOrder {
    int nM, nN, nwg, G, c;
    __host__ __device__ void init(int M, int N, int G_, int c_) { nM = M / BM; nN = N / BM; nwg = nM * nN; G = G_; c = c_; }
    __host__ __device__ bool next(int i, Unit& u) const {
        const long L = (long)i * G + c; if (L >= nwg) return false;
        int wgid = (int)L; { const int q = nwg / NXCD, r = nwg % NXCD, xcd = wgid % NXCD, off = wgid / NXCD; wgid = (xcd < r ? xcd * (q + 1) : r * (q + 1) + (xcd - r) * q) + off; }
        const int nig = WGM * nN, gid = wgid / nig, fm = gid * WGM, gsz = (nM - fm) < WGM ? (nM - fm) : WGM;
        u.pm = fm + ((wgid % nig) % gsz); u.pn = (wgid % nig) / gsz; u.seg = 0; return true;
    }
    __device__ __forceinline__ void a_ready(const Unit&) const {}
    __device__ __forceinline__ void done(const Unit&) const {}
};

typedef float f32x2c __attribute__((ext_vector_type(2))); typedef __bf16 bf16x2c __attribute__((ext_vector_type(2)));
__device__ __forceinline__ unsigned cvt_pk_bf16(float lo, float hi) { const f32x2c v = {lo, hi}; const bf16x2c b = __builtin_convertvector(v, bf16x2c); return __builtin_bit_cast(unsigned, b); }
typedef float f32x2 __attribute__((ext_vector_type(2)));
typedef unsigned u32x2 __attribute__((ext_vector_type(2)));
__device__ __forceinline__ float fsigmoid(float x) { return __builtin_amdgcn_rcpf(1.0f + __builtin_amdgcn_exp2f(-1.4426950408889634f * x)); }
__device__ __forceinline__ float fsilu(float x) { return x * fsigmoid(x); }
__device__ __forceinline__ f32x4 silu4(f32x4 v) { return (f32x4){fsilu(v[0]), fsilu(v[1]), fsilu(v[2]), fsilu(v[3])}; }
__device__ __forceinline__ f32x4 sigm4(f32x4 v) { return (f32x4){fsigmoid(v[0]), fsigmoid(v[1]), fsigmoid(v[2]), fsigmoid(v[3])}; }
__device__ __forceinline__ void st8(bf16_t* p, const f32x4 a, const f32x4 b) {
    u32x4 w; w.x = cvt_pk_bf16(a[0], a[1]); w.y = cvt_pk_bf16(a[2], a[3]); w.z = cvt_pk_bf16(b[0], b[1]); w.w = cvt_pk_bf16(b[2], b[3]); *(u32x4*)p = w; }
__device__ __forceinline__ float bflo(unsigned w) { return __uint_as_float(w << 16); }
__device__ __forceinline__ float bfhi(unsigned w) { return __uint_as_float(w & 0xffff0000u); }
__device__ __forceinline__ void ld8(const bf16_t* p, f32x4& a, f32x4& b) { const u32x4 w = *(const u32x4*)p; a = (f32x4){bflo(w.x), bfhi(w.x), bflo(w.y), bfhi(w.y)}; b = (f32x4){bflo(w.z), bfhi(w.z), bflo(w.w), bfhi(w.w)}; }

__device__ __forceinline__ unsigned pk_fp8x4(float a, float b, float c, float d) { int p = __builtin_amdgcn_cvt_pk_fp8_f32(a, b, 0, false); p = __builtin_amdgcn_cvt_pk_fp8_f32(c, d, p, true); return (unsigned)p; }
constexpr float WSCALE8 = 64.0f, WINV8 = 1.0f / 64.0f;
struct EpiW1 {
    static constexpr bool PERM = true, AFTER_DRAIN = false; __device__ __forceinline__ bool keep(const Unit&) const { return false; }
    bf16_t *PA, *PB, *PC;
    __device__ __forceinline__ void operator()(const f32x4 (&acc)[2][2][4][2], const Unit& u, int wr, int wc, int fr, int fq) const {
        const int row0 = u.pm * BM + wr * 64 + fr, c8 = wc * 32 + 8 * fq;
        if (u.pn < 4) {
#pragma unroll
            for (int ai = 0; ai < 2; ++ai)
#pragma unroll
                for (int m = 0; m < 4; ++m)
                    st8(PA + (size_t)(row0 + ai * HALF + m * 16) * 1024 + u.pn * 128 + c8, acc[ai][0][m][0] * acc[ai][1][m][0], acc[ai][0][m][1] * acc[ai][1][m][1]);
        } else {
            bf16_t* base; int ldc, cb; bool act;
            if (u.pn < 6) { base = PA; ldc = 1024; cb = 512 + 256 * (u.pn - 4); act = false; }
            else if (u.pn < 16) { base = PB; ldc = 2560; cb = 256 * (u.pn - 6); act = (u.pn < 8) || (u.pn >= 14); }
            else { base = PC; ldc = 768; cb = 256 * (u.pn - 16); act = false; }
#pragma unroll
            for (int ai = 0; ai < 2; ++ai)
#pragma unroll
                for (int m = 0; m < 4; ++m)
#pragma unroll
                    for (int bj = 0; bj < 2; ++bj) { f32x4 v0 = acc[ai][bj][m][0], v1 = acc[ai][bj][m][1]; if (act) { v0 = silu4(v0); v1 = silu4(v1); }
                        if (u.pn == 18 && bj == 1) { u32x2 w; w.x = pk_fp8x4(v0[0], v0[1], v0[2], v0[3]); w.y = pk_fp8x4(v1[0], v1[1], v1[2], v1[3]);
                            *(u32x2*)((unsigned char*)(base + (size_t)(row0 + ai * HALF + m * 16) * ldc) + 1280 + c8) = w; }
                        else st8(base + (size_t)(row0 + ai * HALF + m * 16) * ldc + cb + bj * HALF + c8, v0, v1); }
        }
    }
};
struct EpiGate {
    static constexpr bool PERM = true, AFTER_DRAIN = false; __device__ __forceinline__ bool keep(const Unit&) const { return false; }
    bf16_t* G;
    __device__ __forceinline__ void operator()(const f32x4 (&acc)[2][2][4][2], const Unit& u, int wr, int wc, int fr, int fq) const {
        bf16_t* tp = G + ((size_t)(u.pm * 12 + u.pn) * 65536) + (((wr * 4 + wc) * 64 + fq * 16 + fr) * 8);
#pragma unroll
        for (int ai = 0; ai < 2; ++ai)
#pragma unroll
            for (int m = 0; m < 4; ++m)
#pragma unroll
                for (int bj = 0; bj < 2; ++bj) st8(tp + ((ai * 4 + m) * 2 + bj) * 4096, sigm4(acc[ai][bj][m][0] * WINV8), sigm4(acc[ai][bj][m][1] * WINV8));
    }
};
template <int BR> struct EpiMerge {
    static constexpr bool PERM = true, AFTER_DRAIN = false; __device__ __forceinline__ bool keep(const Unit&) const { return false; }
    const bf16_t* G; bf16_t* Mb;
    __device__ __forceinline__ void operator()(const f32x4 (&acc)[2][2][4][2], const Unit& u, int wr, int wc, int fr, int fq) const {
        const int row0 = u.pm * BM + wr * 64 + fr, c8 = u.pn * BM + wc * 32 + 8 * fq;
#pragma unroll
        for (int ai = 0; ai < 2; ++ai)
#pragma unroll
            for (int m = 0; m < 4; ++m) {
#pragma unroll
                for (int bj = 0; bj < 2; ++bj) { const size_t row = (size_t)(row0 + ai * HALF + m * 16); const int col = bj * HALF + c8;
                    f32x4 g0, g1; ld8(G + row * 3072 + BR * 1024 + col, g0, g1);
                    f32x4 v0 = g0 * acc[ai][bj][m][0], v1 = g1 * acc[ai][bj][m][1];
                    if (BR > 0) { f32x4 p0, p1; ld8(Mb + row * 1024 + col, p0, p1); v0 += p0; v1 += p1; }
                    st8(Mb + row * 1024 + col, v0, v1); }
                asm volatile("" ::: "memory"); }
    }
};
struct EpiWo {
    static constexpr bool PERM = true, AFTER_DRAIN = false; __device__ __forceinline__ bool keep(const Unit&) const { return false; }
    bf16_t* DL; const float* mod;
    __device__ __forceinline__ void operator()(const f32x4 (&acc)[2][2][4][2], const Unit& u, int wr, int wc, int fr, int fq) const {
        const int b = u.pm / 65, j = u.pm % 65; const float* g1 = mod + ((j == 0 ? 2 : b) * 6 + 2) * 1024;
        const int row0 = u.pm * BM + wr * 64 + fr, c8 = u.pn * BM + wc * 32 + 8 * fq;
        f32x4 gv[2][2];
#pragma unroll
        for (int bj = 0; bj < 2; ++bj)
#pragma unroll
            for (int n = 0; n < 2; ++n) gv[bj][n] = *(const f32x4*)(g1 + c8 + bj * HALF + 4 * n);
#pragma unroll
        for (int ai = 0; ai < 2; ++ai)
#pragma unroll
            for (int m = 0; m < 4; ++m)
#pragma unroll
                for (int bj = 0; bj < 2; ++bj) st8(DL + (size_t)(row0 + ai * HALF + m * 16) * 1024 + bj * HALF + c8, gv[bj][0] * acc[ai][bj][m][0], gv[bj][1] * acc[ai][bj][m][1]);
    }
};
struct EpiMoe1 {
    static constexpr bool PERM = true, AFTER_DRAIN = false; __device__ __forceinline__ bool keep(const Unit&) const { return false; }
    unsigned char* HID;
    __device__ __forceinline__ void operator()(const f32x4 (&acc)[2][2][4][2], const Unit& u, int wr, int wc, int fr, int fq) const {
        const int row0 = u.pm * BM + wr * 64 + fr, c8 = (u.pn & 7) * 128 + wc * 32 + 8 * fq;
#pragma unroll
        for (int ai = 0; ai < 2; ++ai)
#pragma unroll
            for (int m = 0; m < 4; ++m) { const f32x4 h0 = silu4(acc[ai][0][m][0] * WINV8) * (acc[ai][1][m][0] * WINV8), h1 = silu4(acc[ai][0][m][1] * WINV8) * (acc[ai][1][m][1] * WINV8);
                u32x2 w; w.x = pk_fp8x4(h0[0], h0[1], h0[2], h0[3]); w.y = pk_fp8x4(h1[0], h1[1], h1[2], h1[3]);
                *(u32x2*)(HID + (size_t)(row0 + ai * HALF + m * 16) * 1024 + c8) = w; }
    }
};
struct EpiMoe2 {
    static constexpr bool PERM = true, AFTER_DRAIN = false; __device__ __forceinline__ bool keep(const Unit&) const { return false; }
    bf16_t* YS;
    __device__ __forceinline__ void operator()(const f32x4 (&acc)[2][2][4][2], const Unit& u, int wr, int wc, int fr, int fq) const {
        const int row0 = u.pm * BM + wr * 64 + fr, c8 = (u.pn & 3) * BM + wc * 32 + 8 * fq;
#pragma unroll
        for (int ai = 0; ai < 2; ++ai)
#pragma unroll
            for (int m = 0; m < 4; ++m)
#pragma unroll
                for (int bj = 0; bj < 2; ++bj) st8(YS + (size_t)(row0 + ai * HALF + m * 16) * 1024 + bj * HALF + c8, acc[ai][bj][m][0] * WINV8, acc[ai][bj][m][1] * WINV8);
    }
};
struct MoeOrder {
    const int* tab; int nN, G, c, n_units;
    __device__ __forceinline__ void init(const int* tab_, int nN_, int G_, int c_) { tab = tab_; nN = nN_; G = G_; c = c_; n_units = __builtin_amdgcn_readfirstlane(tab_[0]) * nN_; }
    __device__ __forceinline__ bool next(int i, Unit& u) const {
        const int L = i * G + c; if (L >= n_units) return false;
        const int t = L / nN, j = L - t * nN; const int e = __builtin_amdgcn_readfirstlane(tab[1 + t]);
        u.pm = t; u.pn = e * nN + j; u.seg = 0; return true;
    }
    __device__ __forceinline__ void a_ready(const Unit&) const {}
    __device__ __forceinline__ void done(const Unit&) const {}
};


struct EpiMerge3 {
    static constexpr bool PERM = true, AFTER_DRAIN = false;
    const bf16_t* G; bf16_t* Mb;
    __device__ __forceinline__ bool keep(const Unit& u) const { return u.seg < 2; }
    __device__ __forceinline__ void operator()(f32x4 (&acc)[2][2][4][2], const Unit& u, int wr, int wc, int fr, int fq) const {
        const int row0 = u.pm * BM + wr * 64 + fr, c8 = u.pn * BM + wc * 32 + 8 * fq;
#pragma unroll
        for (int ai = 0; ai < 2; ++ai) {
            u32x4 gw[4][2], hw[4][2];
#pragma unroll
            for (int m = 0; m < 4; ++m)
#pragma unroll
                for (int bj = 0; bj < 2; ++bj) { const bf16_t* gp = G + ((size_t)(u.pm * 12 + u.seg * 4 + u.pn) * 65536) + (((wr * 4 + wc) * 64 + fq * 16 + fr) * 8) + ((ai * 4 + m) * 2 + bj) * 4096;
                    gw[m][bj] = *(const u32x4*)gp; if (u.seg < 2) hw[m][bj] = *(const u32x4*)(gp + 4 * 65536); }
#pragma unroll
            for (int m = 0; m < 4; ++m)
#pragma unroll
                for (int bj = 0; bj < 2; ++bj) { const u32x4 w = gw[m][bj];
                    f32x4 g0 = {bflo(w.x), bfhi(w.x), bflo(w.y), bfhi(w.y)}, g1 = {bflo(w.z), bfhi(w.z), bflo(w.w), bfhi(w.w)};
                    if (u.seg < 2) { const u32x4 x = hw[m][bj]; const f32x4 h0 = {bflo(x.x), bfhi(x.x), bflo(x.y), bfhi(x.y)}, h1 = {bflo(x.z), bfhi(x.z), bflo(x.w), bfhi(x.w)};
#pragma unroll
                        for (int q = 0; q < 4; ++q) { g0[q] *= __builtin_amdgcn_rcpf(fmaxf(h0[q], 1e-6f)); g1[q] *= __builtin_amdgcn_rcpf(fmaxf(h1[q], 1e-6f)); }
                        acc[ai][bj][m][0] *= g0; acc[ai][bj][m][1] *= g1; }
                    else st8(Mb + (size_t)(row0 + ai * HALF + m * 16) * 1024 + bj * HALF + c8, acc[ai][bj][m][0] * g0, acc[ai][bj][m][1] * g1); }
            asm volatile("" ::: "memory"); }
    }
};
struct RowOrder {
    StaticOrder so; bool lat; int nseg;
    __device__ __forceinline__ void init(bool lat_, int N, int nseg_, int G_, int c_) { lat = lat_; nseg = nseg_; so.init(lat_ ? 128 * BM : 130 * BM, N, G_, c_); }
    __device__ __forceinline__ bool next(int i, Unit& u) const { const int ti = i / nseg; if (!so.next(ti, u)) return false; u.seg = i - ti * nseg; if (lat) u.pm += 1 + (u.pm >= 64 ? 1 : 0); return true; }
    __device__ __forceinline__ void a_ready(const Unit&) const {}
    __device__ __forceinline__ void done(const Unit&) const {}
};
template <class Epi, class Sched, bool ALIGN_EPI = false, bool SP2 = false, bool FP8 = false>
__device__ __forceinline__ void gemm_phase(PG8_LAS unsigned char* lds, const Gemm g, const Sched& S, const Epi& E) {
    int tid_ = threadIdx.x; asm volatile("" : "+v"(tid_));
    const int tid = tid_, wid = __builtin_amdgcn_readfirstlane(tid >> 6), lane = tid & 63, wr = wid >> 2, wc = wid & 3, fr = lane & 15, fq = lane >> 4;
    const int K = g.K, nt = K / BK;
    unsigned voffA[2], voffB[2];
#pragma unroll
    for (int i = 0; i < 2; ++i) { int R, C; stage_rc(tid * 16 + i * 8192, R, C); const int Rb = Epi::PERM ? ((R & ~31) + perm32(R & 31)) : R;
        voffA[i] = (unsigned)(R * g.lda + C) * 2u; voffB[i] = (unsigned)(Rb * K + C) * 2u; }
    const size_t kstep = (size_t)(BK * 2);
    const size_t hstepA = (size_t)HALF * g.lda * 2, hstepB = (size_t)HALF * K * 2;
    const size_t tstepA = 2 * hstepA, tstepB = 2 * hstepB;
    const unsigned ldsw = (unsigned)wid * 1024u;
    const int aoff = lds_byte(wr * 64 + fr, fq * 8), boff = lds_byte(wc * 32 + fr, fq * 8);
#define PG8_SA(b, h) (((b) * 2 + (h)) * HTB)
#define PG8_SB(b, h) ((4 + (b) * 2 + (h)) * HTB)
#define PG8_UPTR(p) ((const char*)(((unsigned long long)(unsigned)__builtin_amdgcn_readfirstlane((int)(unsigned)((unsigned long long)(p) >> 32)) << 32) | (unsigned long long)(unsigned)__builtin_amdgcn_readfirstlane((int)(unsigned)(unsigned long long)(p))))
#define PG8_STAGE(bufoff, gbase, voff) do { const char* gb_ = PG8_UPTR(gbase); _Pragma("unroll") for (int _i = 0; _i < 2; ++_i) \
        __builtin_amdgcn_global_load_lds((const unsigned*)(gb_ + (voff)[_i]), (PG8_LAS unsigned*)(lds + (bufoff) + ldsw + _i * 8192), 16, 0, 0); } while (0)
#define PG8_LD32(p) __builtin_shufflevector(*(const PG8_LAS v4i_t*)(p), *(const PG8_LAS v4i_t*)((p) + 1024), 0, 1, 2, 3, 4, 5, 6, 7)
#define PG8_LDA(dst, b, h) do { _Pragma("unroll") for (int m = 0; m < 4; ++m) { if constexpr (FP8) dst##8[m] = PG8_LD32(lds + PG8_SA(b, h) + aoff + m * 2048); else { _Pragma("unroll") for (int k = 0; k < 2; ++k) dst[m][k] = *(const PG8_LAS bf16x8*)(lds + PG8_SA(b, h) + aoff + m * 2048 + k * 1024); } } } while (0)
#define PG8_LDB(dst, b, h) do { _Pragma("unroll") for (int n = 0; n < 2; ++n) { if constexpr (FP8) dst##8[n] = PG8_LD32(lds + PG8_SB(b, h) + boff + n * 2048); else { _Pragma("unroll") for (int k = 0; k < 2; ++k) dst[n][k] = *(const PG8_LAS bf16x8*)(lds + PG8_SB(b, h) + boff + n * 2048 + k * 1024); } } } while (0)
#define PG8_MMA(ai, bj, At, Bt) do { __builtin_amdgcn_s_setprio(1); _Pragma("unroll") for (int m = 0; m < 4; ++m) _Pragma("unroll") for (int n = 0; n < 2; ++n) { \
        if constexpr (FP8) acc[ai][bj][m][n] = __builtin_amdgcn_mfma_scale_f32_16x16x128_f8f6f4(Bt##8[n], At##8[m], acc[ai][bj][m][n], 0, 0, 0, 0, 0, 0); \
        else { _Pragma("unroll") for (int k = 0; k < 2; ++k) acc[ai][bj][m][n] = __builtin_amdgcn_mfma_f32_16x16x32_bf16(Bt[n][k], At[m][k], acc[ai][bj][m][n], 0, 0, 0); } } __builtin_amdgcn_s_setprio(0); } while (0)
#define PG8_WAIT_V(n) asm volatile("s_waitcnt vmcnt(" #n ")" ::: "memory")
#define PG8_WAIT_L(n) asm volatile("s_waitcnt lgkmcnt(" #n ")" ::: "memory")
#define PG8_BAR __builtin_amdgcn_s_barrier()
#define PG8_SCHED __builtin_amdgcn_sched_barrier(0)
    Unit cur, nxt; int ui = 0;
    if (!S.next(0, cur)) return;
    f32x4 acc[2][2][4][2];
#pragma unroll
    for (int a = 0; a < 2; ++a)
#pragma unroll
        for (int b = 0; b < 2; ++b)
#pragma unroll
            for (int m = 0; m < 4; ++m)
#pragma unroll
                for (int n = 0; n < 2; ++n) acc[a][b][m][n] = (f32x4){0.f, 0.f, 0.f, 0.f};
    bf16x8 At[4][2], B0[2][2], B1[2][2]; v8i_t At8[4], B08[2], B18[2];
    const char* cA = (const char*)g.A + (size_t)cur.pm * tstepA + (size_t)cur.seg * g.segA; const char* cB = (const char*)g.Bt + (size_t)cur.pn * tstepB + (size_t)cur.seg * g.segB;
    S.a_ready(cur);
    if constexpr (SP2) {
        PG8_STAGE(PG8_SB(0, 0), cB, voffB); PG8_STAGE(PG8_SB(0, 1), cB + hstepB, voffB); PG8_STAGE(PG8_SA(0, 0), cA, voffA); PG8_STAGE(PG8_SA(0, 1), cA + hstepA, voffA);
        if (wr == 1) PG8_BAR;
        PG8_WAIT_V(2); PG8_BAR;
        PG8_STAGE(PG8_SB(1, 0), cB + kstep, voffB); PG8_STAGE(PG8_SA(1, 0), cA + kstep, voffA); PG8_STAGE(PG8_SB(1, 1), cB + hstepB + kstep, voffB);
        PG8_WAIT_V(6); PG8_BAR;
    } else {
        PG8_STAGE(PG8_SB(0, 0), cB, voffB); PG8_STAGE(PG8_SA(0, 0), cA, voffA); PG8_STAGE(PG8_SB(0, 1), cB + hstepB, voffB); PG8_STAGE(PG8_SA(0, 1), cA + hstepA, voffA);
        if (wr == 1) PG8_BAR;
        PG8_WAIT_V(4); PG8_BAR;
        PG8_STAGE(PG8_SB(1, 0), cB + kstep, voffB); PG8_STAGE(PG8_SA(1, 0), cA + kstep, voffA); PG8_STAGE(PG8_SB(1, 1), cB + hstepB + kstep, voffB);
        PG8_WAIT_V(6); PG8_BAR;
    }
    for (;;) {
        const bool has_next = S.next(ui + 1, nxt);
        const char* nA = has_next ? (const char*)g.A + (size_t)nxt.pm * tstepA + (size_t)nxt.seg * g.segA : cA; const char* nB = has_next ? (const char*)g.Bt + (size_t)nxt.pn * tstepB + (size_t)nxt.seg * g.segB : cB;
#pragma unroll 1
        for (int t = 0; t < nt; t += 2) {
            const bool last = (t == nt - 2);
            const char* a1 = cA + (size_t)(t + 1) * kstep;
            const char* a2 = last ? nA : cA + (size_t)(t + 2) * kstep; const char* b2 = last ? nB : cB + (size_t)(t + 2) * kstep;
            const char* a3 = a2 + kstep; const char* b3 = b2 + kstep;
            if (last && has_next) S.a_ready(nxt);
            if constexpr (SP2) {
            PG8_LDB(B0, 0, 0); PG8_LDB(B1, 0, 1); PG8_SCHED; PG8_LDA(At, 0, 0); PG8_STAGE(PG8_SA(1, 1), a1 + hstepA, voffA);
            PG8_WAIT_V(8); PG8_WAIT_L(0); PG8_BAR; PG8_MMA(0, 0, At, B0); PG8_MMA(0, 1, At, B1); PG8_BAR; PG8_SCHED;
            PG8_LDA(At, 0, 1); PG8_STAGE(PG8_SB(0, 0), b2, voffB); PG8_STAGE(PG8_SB(0, 1), b2 + hstepB, voffB); PG8_STAGE(PG8_SA(0, 0), a2, voffA);
            PG8_WAIT_V(8); PG8_WAIT_L(0); PG8_BAR; PG8_MMA(1, 0, At, B0); PG8_MMA(1, 1, At, B1); PG8_BAR; PG8_SCHED;
            PG8_LDB(B0, 1, 0); PG8_LDB(B1, 1, 1); PG8_SCHED; PG8_LDA(At, 1, 0); PG8_STAGE(PG8_SA(0, 1), a2 + hstepA, voffA);
            PG8_WAIT_V(8); PG8_WAIT_L(0); PG8_BAR; PG8_MMA(0, 0, At, B0); PG8_MMA(0, 1, At, B1); PG8_BAR; PG8_SCHED;
            PG8_LDA(At, 1, 1); PG8_STAGE(PG8_SB(1, 0), b3, voffB); PG8_STAGE(PG8_SB(1, 1), b3 + hstepB, voffB); PG8_STAGE(PG8_SA(1, 0), a3, voffA);
            PG8_WAIT_V(8); PG8_WAIT_L(0); PG8_BAR; PG8_MMA(1, 0, At, B0); PG8_MMA(1, 1, At, B1); PG8_BAR; PG8_SCHED;
            } else {
            PG8_LDB(B0, 0, 0); PG8_SCHED; PG8_LDA(At, 0, 0); PG8_STAGE(PG8_SA(1, 1), a1 + hstepA, voffA);
            PG8_WAIT_L(8); PG8_BAR; PG8_WAIT_L(0); PG8_MMA(0, 0, At, B0); PG8_BAR; PG8_SCHED;
            PG8_LDB(B1, 0, 1); PG8_STAGE(PG8_SB(0, 0), b2, voffB);
            PG8_BAR; PG8_WAIT_L(0); PG8_MMA(0, 1, At, B1); PG8_BAR;
            PG8_LDA(At, 0, 1); PG8_STAGE(PG8_SA(0, 0), a2, voffA);
            PG8_BAR; PG8_WAIT_L(0); PG8_MMA(1, 0, At, B0); PG8_BAR; PG8_SCHED;
            PG8_STAGE(PG8_SB(0, 1), b2 + hstepB, voffB);
            PG8_WAIT_V(6); PG8_BAR; PG8_MMA(1, 1, At, B1); PG8_BAR;
            PG8_LDB(B0, 1, 0); PG8_SCHED; PG8_LDA(At, 1, 0); PG8_STAGE(PG8_SA(0, 1), a2 + hstepA, voffA);
            PG8_WAIT_L(8); PG8_BAR; PG8_WAIT_L(0); PG8_MMA(0, 0, At, B0); PG8_BAR; PG8_SCHED;
            PG8_LDB(B1, 1, 1); PG8_STAGE(PG8_SB(1, 0), b3, voffB);
            PG8_BAR; PG8_WAIT_L(0); PG8_MMA(0, 1, At, B1); PG8_BAR;
            PG8_LDA(At, 1, 1); PG8_STAGE(PG8_SA(1, 0), a3, voffA);
            PG8_BAR; PG8_WAIT_L(0); PG8_MMA(1, 0, At, B0); PG8_BAR; PG8_SCHED;
            PG8_STAGE(PG8_SB(1, 1), b3 + hstepB, voffB);
            PG8_WAIT_V(6); PG8_BAR; PG8_MMA(1, 1, At, B1); PG8_BAR;
            }
        }
        if constexpr (ALIGN_EPI) { if (wr == 0) PG8_BAR; }
        if constexpr (!Epi::AFTER_DRAIN) { int le_; asm volatile("v_mbcnt_lo_u32_b32 %0, -1, 0\n\tv_mbcnt_hi_u32_b32 %0, -1, %0" : "=v"(le_));
            E(acc, cur, wr, wc, le_ & 15, le_ >> 4); S.done(cur); }
        if (!has_next) break;
        if (!E.keep(cur)) {
#pragma unroll
        for (int a = 0; a < 2; ++a)
#pragma unroll
            for (int b = 0; b < 2; ++b)
#pragma unroll
                for (int m = 0; m < 4; ++m)
#pragma unroll
                    for (int n = 0; n < 2; ++n) acc[a][b][m][n] = (f32x4){0.f, 0.f, 0.f, 0.f};
        }
        cur = nxt; cA = nA; cB = nB; ++ui;
        if constexpr (ALIGN_EPI) { if (wr == 1) PG8_BAR; }
    }
    PG8_WAIT_V(0);
    if constexpr (!ALIGN_EPI) { if (wr == 0) PG8_BAR; }
    PG8_BAR;
    if constexpr (Epi::AFTER_DRAIN) { E.fused(acc, cur, wr, wc, fr, fq, lds, wid, lane); S.done(cur); }
#undef PG8_SA
#undef PG8_SB
#undef PG8_STAGE
#undef PG8_UPTR
#undef PG8_LDA
#undef PG8_LDB
#undef PG8_MMA
#undef PG8_LD32
#undef PG8_WAIT_V
#undef PG8_WAIT_L
#undef PG8_BAR
#undef PG8_SCHED
}
}
namespace attn_body {
using bf16=__hip_bfloat16;
using f32x16=__attribute__((ext_vector_type(16)))float;
using f32x4_t=__attribute__((ext_vector_type(4)))float;
using u32x4=__attribute__((ext_vector_type(4)))unsigned;
using v2i=__attribute__((ext_vector_type(2)))int; using v4i=__attribute__((ext_vector_type(4)))int; using v8i=__attribute__((ext_vector_type(8)))int;
constexpr int D=64,PKV=768,PO=1536;
constexpr int PKVB=PKV*2;
#define MF8(a,b,c) __builtin_amdgcn_mfma_scale_f32_32x32x64_f8f6f4((a),(b),(c),0,0,0,0,0,0)
#define MF8A(D,A,B,C) asm volatile("v_mfma_f32_32x32x64_f8f6f4 %0, %1, %2, %3":"=&v"(D):"v"(A),"v"(B),"v"(C))
constexpr int NW=8,QBLK=32,QB=QBLK*NW,KVBLK=64;
constexpr int ATTN_UNIT_ROWS=QB;
__device__ __forceinline__ int crow(int r,int hi){return (r&3)+8*(r>>2)+4*hi;}
#define SBAR() __builtin_amdgcn_sched_barrier(0)
constexpr int NSLOT=3, SLOTB=4096;
constexpr int LDS_K=0, LDS_V=NSLOT*SLOTB, LDS_WS=2*NSLOT*SLOTB, LDS_OST=LDS_WS+NW*64*4, LDS_BYTES=LDS_OST+NW*4096;
constexpr float C2=0.125f*1.4426950408889634f;
__device__ __forceinline__ void glds16s(const void*sbase,unsigned voff,unsigned lds_dst){unsigned keep;
  asm volatile("s_mov_b32 %0, m0\n\ts_mov_b32 m0, %3\n\ts_nop 0\n\tglobal_load_lds_dwordx4 %1, %2\n\ts_mov_b32 m0, %0":"=&s"(keep):"v"(voff),"s"(sbase),"s"(lds_dst):"memory");}
__device__ __forceinline__ void glds16m(const void*sbase,unsigned voff,unsigned lds_dst){
  asm volatile("s_mov_b32 m0, %2\n\ts_nop 0\n\tglobal_load_lds_dwordx4 %0, %1"::"v"(voff),"s"(sbase),"s"(lds_dst):"memory","m0");}
__device__ __forceinline__ const char* uptr(const void*p){ const unsigned long long u=(unsigned long long)p; return (const char*)(((unsigned long long)(unsigned)__builtin_amdgcn_readfirstlane((int)(unsigned)(u>>32))<<32)|(unsigned long long)(unsigned)__builtin_amdgcn_readfirstlane((int)(unsigned)u)); }
#define WAIT_BAR(N) asm volatile("s_waitcnt vmcnt(" #N ") lgkmcnt(0)\n\ts_barrier":::"memory")
typedef __attribute__((address_space(3))) const char* lds_cptr;
typedef __attribute__((address_space(3))) const v4i* lds_v4p;
__device__ __forceinline__ void kload2(v8i*kf,lds_cptr kp,int j){ const v4i x=*(lds_v4p)(kp+j*512), y=*(lds_v4p)(kp+j*512+1024); kf[j]=__builtin_shufflevector(x,y,0,1,2,3,4,5,6,7); }
typedef __attribute__((address_space(3))) v2i* lds_v2p;
__device__ __forceinline__ v8i vload(lds_cptr vp){
  const v2i a=__builtin_amdgcn_ds_read_tr8_b64_v2i32((lds_v2p)(vp)),b=__builtin_amdgcn_ds_read_tr8_b64_v2i32((lds_v2p)(vp+1024)),c=__builtin_amdgcn_ds_read_tr8_b64_v2i32((lds_v2p)(vp+2048)),d=__builtin_amdgcn_ds_read_tr8_b64_v2i32((lds_v2p)(vp+3072));
  return (v8i){a[0],a[1],b[0],b[1],c[0],c[1],d[0],d[1]}; }
__device__ __forceinline__ int pk8(int old,float a,float b,float c,float d){ const int p=__builtin_amdgcn_cvt_pk_fp8_f32(a,b,old,false); return __builtin_amdgcn_cvt_pk_fp8_f32(c,d,p,true); }

#ifndef ATTN_STORE16
#define ATTN_STORE16(p,v) (*(u32x4*)(p)=(v))
#endif
__device__ __forceinline__ void attn_unit(const unsigned char*Qw0,const unsigned char*__restrict__ Kh,const unsigned char*__restrict__ Vh,bf16*Ow0,const int NT,char*shm){
  int tid_=threadIdx.x; asm volatile("":"+v"(tid_)); const int tid=tid_,lane=tid&63,r32=lane&31,hi=lane>>5; const int wid=__builtin_amdgcn_readfirstlane(tid>>6);
  const unsigned char*Qw=Qw0+(long)(wid*QBLK)*PKVB; const bool kw=wid<4;
  const unsigned lds0=(unsigned)(uintptr_t)shm;
  float*wsf=(float*)(shm+LDS_WS)+wid*64;
  const char*kvbase=kw?uptr(Kh+wid*16):uptr(Vh+(long)(16*(wid&3))*PKVB);
  const unsigned kvoff=kw?(unsigned)(lane*PKVB):(unsigned)((lane>>2)*PKVB+(((lane&3)^(2*((lane>>5)&1)))*16));
  const unsigned kvdst=lds0+(kw?LDS_K:LDS_V)+(wid&3)*1024;
  #define DMA_KV(t,slot) glds16s(kvbase+(long)(t)*(KVBLK*PKVB),kvoff,(unsigned)__builtin_amdgcn_readfirstlane(kvdst+(slot)))
  v8i kf[2];
  const lds_cptr shm3=(lds_cptr)shm; const lds_cptr kp0=shm3+LDS_K+hi*2048+r32*16;
  const int vr_=(lane&15)>>1; const lds_cptr vp0=shm3+LDS_V+((vr_&3)+8*(vr_>>2)+4*hi)*64+((2*((vr_>>2)&1)+((lane>>4)&1))*16)+8*(lane&1);
  const lds_cptr vp1=shm3+LDS_V+((vr_&3)+8*(vr_>>2)+4*hi)*64+(((2*((vr_>>2)&1)+((lane>>4)&1))*16)^32)+8*(lane&1);
  if(kw){DMA_KV(0,0);DMA_KV(1,SLOTB);}else{DMA_KV(0,0);}
  v8i qr; { const v4i q0=*reinterpret_cast<const v4i*>(Qw+(long)r32*PKVB+hi*32), q1=*reinterpret_cast<const v4i*>(Qw+(long)r32*PKVB+hi*32+16); qr=__builtin_shufflevector(q0,q1,0,1,2,3,4,5,6,7); }
  constexpr float REF=3.0f; f32x16 o[2];o[0]=f32x16{};o[1]=f32x16{};
  f32x4_t osum4={0.f,0.f,0.f,0.f}; v8i msk8; { const int mv=((((lane>>4)&1)==0)==((lane&15)<8))?0x38383838:0; msk8=(v8i){mv,mv,mv,mv,mv,mv,mv,mv}; } asm volatile("":"+v"(msk8));
  f32x16 negm; _Pragma("unroll") for(int r=0;r<16;++r)negm[r]=-REF; asm volatile("":"+v"(negm));
  f32x16 pA0,pA1,pB0,pB1;
  int sl_prev=0,sl_cur=0,sl_next=SLOTB;
  #define ROT() do{sl_prev=sl_cur;sl_cur=sl_next;sl_next=(sl_next==(NSLOT-1)*SLOTB)?0:sl_next+SLOTB;}while(0)
  if(kw){DMA_KV(2,2*SLOTB);}
  WAIT_BAR(3);
  { kload2(kf,kp0,0); kload2(kf,kp0,1); pA0=MF8(kf[0],qr,negm); pA1=MF8(kf[1],qr,negm); }
  _Pragma("unroll") for(int r=0;r<16;++r){pA0[r]=__builtin_amdgcn_exp2f(pA0[r]);pA1[r]=__builtin_amdgcn_exp2f(pA1[r]);}
  WAIT_BAR(0);
  if(kw){DMA_KV(3,0);}else{DMA_KV(1,SLOTB);}
  ROT();
  kload2(kf,kp0+sl_cur,0); kload2(kf,kp0+sl_cur,1);
  WAIT_BAR(1);
  v8i vb8[2], p8={0,0,0,0,0,0,0,0};
  #define PIN(x) asm volatile("":"+v"(x))
  #define EX(v) __builtin_amdgcn_exp2f(v)
  #define EX8(X,B) do{ X[B]=EX(X[B]); X[B+1]=EX(X[B+1]); X[B+2]=EX(X[B+2]); X[B+3]=EX(X[B+3]); X[B+4]=EX(X[B+4]); X[B+5]=EX(X[B+5]); X[B+6]=EX(X[B+6]); X[B+7]=EX(X[B+7]); }while(0)
  #define KRD(G,SLN,j) do{ if(G){ kload2(kf,kp0+(SLN),j); SBAR(); } }while(0)
  const int dt_=kw?3:1; const char*dptr=kvbase+(long)(1+dt_)*(KVBLK*PKVB); unsigned dslot=(unsigned)(((1+dt_)%3)*SLOTB);
  const unsigned dq0=(unsigned)__builtin_amdgcn_readfirstlane(kvdst+((1+dt_)%3)*SLOTB),dq1=(unsigned)__builtin_amdgcn_readfirstlane(kvdst+((2+dt_)%3)*SLOTB),dq2=(unsigned)__builtin_amdgcn_readfirstlane(kvdst+((3+dt_)%3)*SLOTB);
  #define DMA_NEXT(dst) do{ glds16m(dptr,kvoff,(dst)); dptr+=KVBLK*PKVB; }while(0)
  #define DMA_RT(cond) do{ if(cond){ glds16m(dptr,kvoff,(unsigned)__builtin_amdgcn_readfirstlane(kvdst+dslot)); } dptr+=KVBLK*PKVB; dslot=(dslot==(NSLOT-1)*SLOTB)?0u:dslot+SLOTB; }while(0)
  #define STEP(C0,C1,P0,P1,SLP,SLN,DMASTMT,GL) do{ SBAR(); \
    vb8[0]=vload(vp0+(SLP)); vb8[1]=vload(vp1+(SLP)); SBAR(); \
    MF8A(C0,kf[0],qr,negm); PIN(P0); \
    p8[0]=pk8(p8[0],P0[0],P0[1],P0[2],P0[3]); p8[1]=pk8(p8[1],P0[4],P0[5],P0[6],P0[7]); p8[2]=pk8(p8[2],P0[8],P0[9],P0[10],P0[11]); p8[3]=pk8(p8[3],P0[12],P0[13],P0[14],P0[15]); SBAR(); \
    MF8A(C1,kf[1],qr,negm); PIN(P1); \
    p8[4]=pk8(p8[4],P1[0],P1[1],P1[2],P1[3]); p8[5]=pk8(p8[5],P1[4],P1[5],P1[6],P1[7]); p8[6]=pk8(p8[6],P1[8],P1[9],P1[10],P1[11]); p8[7]=pk8(p8[7],P1[12],P1[13],P1[14],P1[15]); PIN(p8); SBAR(); \
    DMASTMT; \
    SBAR(); \
    o[0]=MF8(p8,vb8[0],o[0]); EX8(C0,0); PIN(C0); SBAR(); \
    KRD(GL,SLN,0); o[1]=MF8(p8,vb8[1],o[1]); EX8(C0,8); PIN(C0); SBAR(); \
    KRD(GL,SLN,1); osum4=__builtin_amdgcn_mfma_scale_f32_16x16x128_f8f6f4(p8,msk8,osum4,0,0,0,0,0,0); EX8(C1,0); EX8(C1,8); PIN(C1); SBAR(); \
    }while(0)
  int t=1;
  for(;t+9<NT;t+=6){
    STEP(pB0,pB1,pA0,pA1,0,2*SLOTB,DMA_NEXT(dq0),true);       WAIT_BAR(1);
    STEP(pA0,pA1,pB0,pB1,SLOTB,0,DMA_NEXT(dq1),true);         WAIT_BAR(1);
    STEP(pB0,pB1,pA0,pA1,2*SLOTB,SLOTB,DMA_NEXT(dq2),true);   WAIT_BAR(1);
    STEP(pA0,pA1,pB0,pB1,0,2*SLOTB,DMA_NEXT(dq0),true);       WAIT_BAR(1);
    STEP(pB0,pB1,pA0,pA1,SLOTB,0,DMA_NEXT(dq1),true);         WAIT_BAR(1);
    STEP(pA0,pA1,pB0,pB1,2*SLOTB,SLOTB,DMA_NEXT(dq2),true);   WAIT_BAR(1);
  }
  for(;t+5<NT;t+=2){
    STEP(pB0,pB1,pA0,pA1,sl_prev,sl_next,DMA_RT(true),true);   WAIT_BAR(1); ROT();
    STEP(pA0,pA1,pB0,pB1,sl_prev,sl_next,DMA_RT(true),true);   WAIT_BAR(1); ROT();
  }
  #define ENDW(tt) do{ if((tt)+3<NT){WAIT_BAR(1);} else {WAIT_BAR(0);} }while(0)
  for(;t+1<NT;t+=2){
    STEP(pB0,pB1,pA0,pA1,sl_prev,sl_next,DMA_RT(t+dt_<NT),(t+1<NT));       ENDW(t);   ROT();
    STEP(pA0,pA1,pB0,pB1,sl_prev,sl_next,DMA_RT(t+1+dt_<NT),(t+2<NT));     ENDW(t+1); ROT();
  }
  STEP(pB0,pB1,pA0,pA1,sl_prev,sl_next,(void)0,false);
  { p8[0]=pk8(p8[0],pB0[0],pB0[1],pB0[2],pB0[3]); p8[1]=pk8(p8[1],pB0[4],pB0[5],pB0[6],pB0[7]); p8[2]=pk8(p8[2],pB0[8],pB0[9],pB0[10],pB0[11]); p8[3]=pk8(p8[3],pB0[12],pB0[13],pB0[14],pB0[15]);
    p8[4]=pk8(p8[4],pB1[0],pB1[1],pB1[2],pB1[3]); p8[5]=pk8(p8[5],pB1[4],pB1[5],pB1[6],pB1[7]); p8[6]=pk8(p8[6],pB1[8],pB1[9],pB1[10],pB1[11]); p8[7]=pk8(p8[7],pB1[12],pB1[13],pB1[14],pB1[15]);
    vb8[0]=vload(vp0+sl_cur); vb8[1]=vload(vp1+sl_cur);
    o[0]=MF8(p8,vb8[0],o[0]); o[1]=MF8(p8,vb8[1],o[1]); osum4=__builtin_amdgcn_mfma_scale_f32_16x16x128_f8f6f4(p8,msk8,osum4,0,0,0,0,0,0); }
  #undef PIN
  #undef EX
  #undef EX8
  #undef KRD
  #undef STEP
  #undef ENDW
  if((lane&7)==0){ float*wq=wsf+32+16*((lane>>3)&1)+4*(lane>>4); wq[0]=osum4[0];wq[1]=osum4[1];wq[2]=osum4[2];wq[3]=osum4[3]; } asm volatile("s_waitcnt lgkmcnt(0)":::"memory");
  float rli[16];
  #pragma unroll
  for(int r=0;r<16;++r)rli[r]=__builtin_amdgcn_rcpf(wsf[32+crow(r,hi)]);
  bf16*Ow=Ow0+(long)(wid*QBLK)*PO;
  { bf16*stg=(bf16*)(shm+LDS_OST)+wid*2048;
    #pragma unroll
    for(int r=0;r<16;++r){const int orow=crow(r,hi);
      #pragma unroll
      for(int d0=0;d0<2;++d0)stg[orow*64+d0*32+r32]=__float2bfloat16(o[d0][r]*rli[r]);}
    asm volatile("s_waitcnt lgkmcnt(0)":::"memory");
    #pragma unroll
    for(int i=0;i<4;++i){const int row=i*8+(lane>>3),ch=lane&7; const u32x4 v=*(const u32x4*)(stg+row*64+ch*8); ATTN_STORE16(Ow+(long)row*PO+ch*8,v);} }
  asm volatile("s_waitcnt lgkmcnt(0)\n\ts_barrier":::"memory");
  #undef DMA_KV
  #undef DMA_NEXT
  #undef DMA_RT
  #undef ROT
}
constexpr int ATTN_LDS_BYTES=LDS_BYTES;
#undef SBAR
#undef WAIT_BAR
}
#define GAS __attribute__((address_space(1)))
#define LAS __attribute__((address_space(3)))
typedef unsigned short bf16;
typedef unsigned v4u __attribute__((ext_vector_type(4)));
typedef float f32x4 __attribute__((ext_vector_type(4)));
typedef short bf16x8 __attribute__((ext_vector_type(8)));
typedef GAS unsigned gu32;
typedef GAS unsigned long long gu64;
#define RLX_AGENT __ATOMIC_RELAXED, __HIP_MEMORY_SCOPE_AGENT
#define LDS_WAIT() asm volatile("s_waitcnt lgkmcnt(0)" ::: "memory")
#define VM_WAIT() asm volatile("s_waitcnt vmcnt(0)" ::: "memory")
__device__ __forceinline__ unsigned long long rt() { return __builtin_amdgcn_s_memrealtime(); }
__device__ __forceinline__ unsigned f2bf(float f) { unsigned u = __builtin_bit_cast(unsigned, f); return (u + 0x7fffu + ((u >> 16) & 1u)) >> 16; }
__device__ __forceinline__ unsigned pk2(float lo, float hi) { return f2bf(lo) | (f2bf(hi) << 16); }
#define XB_TMO      128
#define XB_XCNT(j)  (256  + 64 * (j))
#define XB_XSUB(j)  (1280 + 64 * (j))
#define XB_XGEN(j)  (2304 + 64 * (j))
#define XB_TOP      3328
#define XB_TOPGEN   3392
#define XCD_BAR_WORDS 3456
#define XB_SPIN_CAP (1u << 18)

__device__ __forceinline__ unsigned xb_ld(unsigned* p)              { return __hip_atomic_load(p, __ATOMIC_RELAXED, __HIP_MEMORY_SCOPE_AGENT); }
__device__ __forceinline__ unsigned xb_add(unsigned* p, unsigned v) { return __hip_atomic_fetch_add(p, v, __ATOMIC_RELAXED, __HIP_MEMORY_SCOPE_AGENT); }
__device__ __forceinline__ unsigned xb_xcc_id() { return (unsigned)__builtin_amdgcn_s_getreg((3 << 11) | 20) & 0xFu; }
#define XB_SPIN(cond, bar) do { unsigned _sp = 0; while (cond) { __builtin_amdgcn_s_sleep(1); \
    if ((++_sp & 255u) == 0u) { if (xb_ld(&(bar)[XB_TMO])) break; if (_sp > XB_SPIN_CAP) { atomicAdd(&(bar)[XB_TMO], 1u); break; } } } } while (0)

struct XcdBarrier {
    unsigned* bar; unsigned x;
    volatile LAS unsigned* st;
};

__device__ __forceinline__ XcdBarrier xcd_barrier_post(unsigned* bar, volatile LAS unsigned* st) {
    XcdBarrier b; b.bar = bar; b.x = xb_xcc_id(); b.st = st;
    if (threadIdx.x == 0) (void)xb_add(&bar[XB_XCNT(b.x)], 1u);
    return b;
}
__device__ __forceinline__ void xcd_barrier_complete(unsigned* bar, unsigned x, unsigned& nloc, unsigned& nx) {
    const unsigned G = gridDim.x * gridDim.y * gridDim.z;
    unsigned sum, cnt, mine, sp = 0u;
    for (;;) {
        sum = 0u; cnt = 0u; mine = 0u;
#pragma unroll
        for (unsigned j = 0; j < 16; ++j) { const unsigned c = xb_ld(&bar[XB_XCNT(j)]); sum += c; cnt += (c > 0u) ? 1u : 0u; mine = (j == x) ? c : mine; }
        if (sum == G) break;
        __builtin_amdgcn_s_sleep(1);
        if ((++sp & 255u) == 0u) { if (xb_ld(&bar[XB_TMO])) break; if (sp > XB_SPIN_CAP) { atomicAdd(&bar[XB_TMO], 1u); break; } }
    }
    nloc = mine > 0u ? mine : 1u; nx = cnt > 0u ? cnt : 1u;
}

__device__ __forceinline__ void xcd_barrier(const XcdBarrier& b) {
    asm volatile("s_waitcnt vmcnt(0)" ::: "memory");
    __syncthreads();
    if (threadIdx.x == 0) {
        unsigned* bar = b.bar;
        __builtin_amdgcn_s_waitcnt(0);
        unsigned nloc = b.st[0], nx = b.st[1];
        if (nloc == 0u) { xcd_barrier_complete(bar, b.x, nloc, nx); b.st[0] = nloc; b.st[1] = nx; }
        const unsigned old = xb_add(&bar[XB_XSUB(b.x)], 1u);
        const unsigned gen = old / nloc;
        if (old + 1u == (gen + 1u) * nloc) {
            __builtin_amdgcn_fence(__ATOMIC_RELEASE, "agent");
            asm volatile("s_waitcnt vmcnt(0)" ::: "memory");
            const unsigned og = xb_add(&bar[XB_TOP], 1u);
            const unsigned tg = og / nx;
            if (og + 1u == (tg + 1u) * nx) xb_add(&bar[XB_TOPGEN], 1u);
            else XB_SPIN(xb_ld(&bar[XB_TOPGEN]) == tg, bar);
            __builtin_amdgcn_fence(__ATOMIC_ACQUIRE, "agent");
            xb_add(&bar[XB_XGEN(b.x)], 1u);
            asm volatile("s_waitcnt vmcnt(0)" ::: "memory");
        } else {
            XB_SPIN(xb_ld(&bar[XB_XGEN(b.x)]) == gen, bar);
            __builtin_amdgcn_fence(__ATOMIC_ACQUIRE, "agent");
            asm volatile("s_waitcnt vmcnt(0)" ::: "memory");
        }
    }
    __syncthreads();
}
constexpr int NWAVES = 8;
constexpr int D = 1024, NB = 2, SEQ = 16384, CTX = 256, SPB = SEQ + CTX  , MT = NB * SPB  , DEPTH = 2;
constexpr int NWIN = 7936, N1 = 4864, NGATE = 3072, NE = 16, DFF = 1024;
constexpr int PMAX_TILES = 276, PMAX = PMAX_TILES * 256;
constexpr float EPS = 1e-6f;
constexpr float C2 = 0.125f * 1.4426950408889634f;
constexpr size_t MiB = 1u << 20;
constexpr size_t WS_CTL = 0, CTL_ZERO_BYTES = 32 * 1024;
constexpr size_t WS_MOD = 1 * MiB;
constexpr size_t WS_SMALL = 2 * MiB;
constexpr size_t WS_HCTX = 8 * MiB;
constexpr size_t WS_HGU = 10 * MiB, WS_HGS = 26 * MiB;
constexpr size_t WS_WIN = 42 * MiB;
constexpr size_t WS_WABC = 73 * MiB;
constexpr size_t WS_WO = 79 * MiB;
constexpr size_t WS_WEXP = 83 * MiB;
constexpr size_t WS_WG8 = WS_WEXP + 48 * MiB;
constexpr size_t WS_U8 = WS_WEXP + 56 * MiB;
constexpr size_t WS_U = 179 * MiB;
constexpr size_t WS_PA = 244 * MiB;
constexpr size_t WS_PB = 309 * MiB;
constexpr size_t WS_PC = WS_PB + (size_t)MT * 2560 * 2;
constexpr size_t WS_YCAT = WS_PC + (size_t)MT * 768 * 2;
constexpr size_t WS_END = WS_YCAT + (size_t)MT * 1536 * 2;
constexpr size_t WS_DELTA = WS_YCAT;
constexpr size_t WS_GATES = WS_PA;
constexpr size_t WS_XS = WS_PA;
constexpr size_t WS_HID = WS_XS + (size_t)PMAX * 1024;
constexpr size_t WS_YS = WS_HID + (size_t)PMAX * 1024;
constexpr size_t WS_OBUF = WS_PA;
static_assert(WS_GATES + (size_t)MT * 3072 * 2 <= WS_PC, "gates overlay");
static_assert(WS_WG8 + (size_t)DEPTH * 3072 * 1024 <= WS_U8 && WS_U8 + (size_t)MT * 1024 <= WS_U, "fp8 gate weights / activations in the freed expert space");
static_assert(WS_YS + (size_t)PMAX * 1024 * 2 <= WS_YCAT, "expert buffers overlay PA..PC");
constexpr size_t SM_RE = 0, SM_RW = 512 * 1024, SM_RP = 1024 * 1024, SM_BCNT = 1536 * 1024, SM_TAB = 1600 * 1024, SM_ROPE = 1664 * 1024, SM_HLD = 1792 * 1024;
constexpr int CW_BAR = 4096;
static_assert((CW_BAR + 3456) * 4 <= (int)CTL_ZERO_BYTES, "barrier words inside the per-call memset");
constexpr int RING_BYTES = 131072, LDS_BYTES = 147456, LDSCTL_OFF = LDS_BYTES - 1024, MISC_OFF = LDSCTL_OFF + 320;

typedef unsigned u32x2v __attribute__((ext_vector_type(2)));
template <int CTRL> __device__ __forceinline__ float dppf(float v) { return __int_as_float(__builtin_amdgcn_mov_dpp(__float_as_int(v), CTRL, 0xf, 0xf, true)); }
__device__ __forceinline__ float quad_sum(float v) { v += dppf<0xB1>(v); v += dppf<0x4E>(v); return v; }
__device__ __forceinline__ float row_sum16(float v) { v = quad_sum(v); v += dppf<0x124>(v); v += dppf<0x128>(v); return v; }
__device__ __forceinline__ float wave_sum(float v) {
    v = row_sum16(v);
    return (__int_as_float(__builtin_amdgcn_readlane(__float_as_int(v), 0)) + __int_as_float(__builtin_amdgcn_readlane(__float_as_int(v), 16)))
         + (__int_as_float(__builtin_amdgcn_readlane(__float_as_int(v), 32)) + __int_as_float(__builtin_amdgcn_readlane(__float_as_int(v), 48)));
}
__device__ __forceinline__ float bf2f(bf16 h) { return __uint_as_float((unsigned)h << 16); }
__device__ __forceinline__ float sigm_acc(float x) { return 1.0f / (1.0f + __expf(-x)); }
__device__ __forceinline__ const float* hrow(const float* lat, const float* ctx, int r) { const int b = r >= SPB ? 1 : 0, s = r - b * SPB; return s < CTX ? ctx + (size_t)(b * CTX + s) * D : lat + (size_t)(b * SEQ + s - CTX) * D; }
__device__ __forceinline__ int mod_idx(int r) { const int b = r >= SPB ? 1 : 0, s = r - b * SPB; return s < CTX ? 2 : b; }
__device__ __forceinline__ void load_row(const float* p, int lane, f32x4 (&v)[4]) {
#pragma unroll
    for (int j = 0; j < 4; ++j) v[j] = *(const f32x4*)(p + 4 * lane + 256 * j);
}
__device__ __forceinline__ void add_row_bf16(const bf16* p, int lane, f32x4 (&v)[4]) {
#pragma unroll
    for (int j = 0; j < 4; ++j) { const u32x2v w = *(const u32x2v*)(p + 4 * lane + 256 * j); v[j] += (f32x4){__uint_as_float(w.x << 16), __uint_as_float(w.x & 0xffff0000u), __uint_as_float(w.y << 16), __uint_as_float(w.y & 0xffff0000u)}; }
}
__device__ __forceinline__ void load_h1(const float* outp, const float* hctx, int r, int lane, f32x4 (&v)[4]) {
    const int b = r >= SPB ? 1 : 0, s = r - b * SPB;
    if (s < CTX) { load_row(hctx + (size_t)(b * CTX + s) * D, lane, v); return; }
    const bf16* p = (const bf16*)(outp + (size_t)(b * SEQ + s - CTX) * D) + D;
#pragma unroll
    for (int j = 0; j < 4; ++j) { const u32x2v w = *(const u32x2v*)(p + 4 * lane + 256 * j); v[j] = (f32x4){__uint_as_float(w.x << 16), __uint_as_float(w.x & 0xffff0000u), __uint_as_float(w.y << 16), __uint_as_float(w.y & 0xffff0000u)}; }
}
__device__ __forceinline__ float row_rstd(const f32x4 (&v)[4]) {
    float s = 0.f;
#pragma unroll
    for (int j = 0; j < 4; ++j) s += (v[j][0] * v[j][0] + v[j][1] * v[j][1]) + (v[j][2] * v[j][2] + v[j][3] * v[j][3]);
    return 1.0f / sqrtf(wave_sum(s) * (1.0f / D) + EPS);
}
__device__ __forceinline__ void norm_mod(const f32x4 (&v)[4], const float* gain, const float* sc, const float* sh, int lane, f32x4 (&y)[4]) {
    const float rstd = row_rstd(v);
#pragma unroll
    for (int j = 0; j < 4; ++j) { const int i = 4 * lane + 256 * j; const f32x4 g = *(const f32x4*)(gain + i), c = *(const f32x4*)(sc + i), h = *(const f32x4*)(sh + i);
        y[j] = v[j] * rstd * g * (1.0f + c) + h; }
}
__device__ __forceinline__ void store_row_bf16(bf16* p, int lane, const f32x4 (&y)[4]) {
#pragma unroll
    for (int j = 0; j < 4; ++j) { u32x2v w; w.x = pk2(y[j][0], y[j][1]); w.y = pk2(y[j][2], y[j][3]); *(u32x2v*)(p + 4 * lane + 256 * j) = w; }
}

__device__ __forceinline__ void store_row_fp8(unsigned char* p, int lane, const f32x4 (&y)[4]) {
#pragma unroll
    for (int j = 0; j < 4; ++j) *(unsigned*)(p + 4 * lane + 256 * j) = pg8::pk_fp8x4(y[j][0], y[j][1], y[j][2], y[j][3]);
}
__device__ __forceinline__ void qk_norm_rope(f32x4& a, f32x4& b2, const f32x4 ga, const f32x4 gb, const float* rp, const bool second, const float scale) {
    float ss = (a[0] * a[0] + a[1] * a[1]) + (a[2] * a[2] + a[3] * a[3]) + (b2[0] * b2[0] + b2[1] * b2[1]) + (b2[2] * b2[2] + b2[3] * b2[3]);
    ss = quad_sum(ss); { const float up = dppf<0x124>(ss), dn = dppf<0x12C>(ss); ss += (threadIdx.x & 4) ? up : dn; }
    const float rs = 1.0f / sqrtf(ss * (1.0f / 64.0f) + EPS);
    a = a * rs * ga; b2 = b2 * rs * gb;
    f32x4 pa, pb;
#pragma unroll
    for (int e = 0; e < 4; ++e) { pa[e] = dppf<0x4E>(a[e]); pb[e] = dppf<0x4E>(b2[e]); }
    if (rp) { const f32x4 t0 = *(const f32x4*)rp, t1 = *(const f32x4*)(rp + 4), t2 = *(const f32x4*)(rp + 8), t3 = *(const f32x4*)(rp + 12); const float sg = second ? 1.0f : -1.0f;
        a = (f32x4){a[0] * t0[0] + sg * pa[0] * t0[1], a[1] * t0[2] + sg * pa[1] * t0[3], a[2] * t1[0] + sg * pa[2] * t1[1], a[3] * t1[2] + sg * pa[3] * t1[3]};
        b2 = (f32x4){b2[0] * t2[0] + sg * pb[0] * t2[1], b2[1] * t2[2] + sg * pb[1] * t2[3], b2[2] * t3[0] + sg * pb[2] * t3[1], b2[3] * t3[2] + sg * pb[3] * t3[3]}; }
    a = a * scale; b2 = b2 * scale;
}

template <bool FP8OUT = false> __device__ __forceinline__ void transpose_item(const float* W, int pitch, bf16* WT, int K, int drow0, int k0, int n0, LAS float* scr, int lane) {
    const int rr = lane >> 3, c4 = (lane & 7) * 4;
    f32x4 t[8];
#pragma unroll
    for (int i = 0; i < 8; ++i) t[i] = *(const f32x4*)(W + (size_t)(k0 + 8 * i + rr) * pitch + n0 + c4);
#pragma unroll
    for (int i = 0; i < 8; ++i) { LAS float* d = scr + (8 * i + rr) * 33 + c4; d[0] = t[i][0]; d[1] = t[i][1]; d[2] = t[i][2]; d[3] = t[i][3]; }
    LDS_WAIT(); asm volatile("" ::: "memory");
    const int c = lane & 7;
#pragma unroll
    for (int j = 0; j < 4; ++j) { const int n = (lane >> 3) + 8 * j; const LAS float* s = scr + (8 * c) * 33 + n;
        if constexpr (FP8OUT) { u32x2v o; o.x = pg8::pk_fp8x4(s[0 * 33] * pg8::WSCALE8, s[1 * 33] * pg8::WSCALE8, s[2 * 33] * pg8::WSCALE8, s[3 * 33] * pg8::WSCALE8); o.y = pg8::pk_fp8x4(s[4 * 33] * pg8::WSCALE8, s[5 * 33] * pg8::WSCALE8, s[6 * 33] * pg8::WSCALE8, s[7 * 33] * pg8::WSCALE8);
            *(u32x2v*)((unsigned char*)WT + (size_t)(drow0 + n) * K + k0 + 8 * c) = o; }
        else { v4u o; o.x = pk2(s[0 * 33], s[1 * 33]); o.y = pk2(s[2 * 33], s[3 * 33]); o.z = pk2(s[4 * 33], s[5 * 33]); o.w = pk2(s[6 * 33], s[7 * 33]);
        *(v4u*)(WT + (size_t)(drow0 + n) * K + k0 + 8 * c) = o; } }
    LDS_WAIT(); asm volatile("" ::: "memory");
}
__device__ __forceinline__ int win_drow(int n0) {
    if (n0 < 512) return (n0 >> 7) * 256 + (n0 & 127);
    if (n0 < 1024) return 1024 + (n0 - 512);
    if (n0 < 1536) return ((n0 - 1024) >> 7) * 256 + 128 + (n0 & 127);
    return n0;
}
__device__ __forceinline__ void convert_experts(const float* wg, const float* wu, const float* wd, int layer, bf16* WE, LAS float* scr, int gw, int NGW, int lane) {
    const size_t lo = (size_t)layer * NE * D * DFF;
    unsigned char* GU = (unsigned char*)WE; unsigned char* DN = GU + (size_t)NE * 2048 * 1024;
    constexpr int IPM = 16 * 32;
    for (int it = gw; it < 3 * NE * IPM; it += NGW) {
        const int mat = it / IPM, r = it % IPM, kb = r / 32, nb = r % 32, e = mat % NE, kind = mat / NE, n0 = 32 * nb;
        if (kind == 0) transpose_item<true>(wg + lo + (size_t)e * D * DFF, DFF, (bf16*)(GU + (size_t)e * 2048 * 1024), 1024, (n0 >> 7) * 256 + (n0 & 127), 64 * kb, n0, scr, lane);
        else if (kind == 1) transpose_item<true>(wu + lo + (size_t)e * D * DFF, DFF, (bf16*)(GU + (size_t)e * 2048 * 1024), 1024, (n0 >> 7) * 256 + 128 + (n0 & 127), 64 * kb, n0, scr, lane);
        else transpose_item<true>(wd + lo + (size_t)e * DFF * D, D, (bf16*)(DN + (size_t)e * 1024 * 1024), 1024, n0, 64 * kb, n0, scr, lane);
    }
}

__device__ __forceinline__ void attn_naive(unsigned char* lds, const bf16* PC, bf16* YC, int vcu, int G, int tid) {
    float* Ks = (float*)lds; float* Vs = Ks + 64 * 64;
    for (int unit = vcu; unit < 528; unit += G) {
        int b, h, q0, nq, nkeys;
        if (unit < 512) { b = unit >> 8; h = (unit >> 5) & 7; q0 = CTX + (unit & 31) * 512; nq = 512; nkeys = SPB; }
        else { const int x = unit - 512; b = x >> 3; h = x & 7; q0 = 0; nq = 256; nkeys = CTX; }
        const int kvh = h >> 2;
        const int qi = tid < nq ? tid : nq - 1;
        const size_t row = (size_t)b * SPB + q0 + qi;
        float q[64], o[64];
#pragma unroll
        for (int d = 0; d < 64; d += 8) { f32x4 a, c; pg8::ld8(PC + row * 768 + h * 64 + d, a, c); q[d] = a[0]; q[d + 1] = a[1]; q[d + 2] = a[2]; q[d + 3] = a[3]; q[d + 4] = c[0]; q[d + 5] = c[1]; q[d + 6] = c[2]; q[d + 7] = c[3]; }
#pragma unroll
        for (int d = 0; d < 64; ++d) o[d] = 0.f;
        float mrun = -INFINITY, lrun = 0.f;
        for (int kt = 0; kt < nkeys; kt += 64) {
            __syncthreads();
            { const int key = tid >> 3, d0 = (tid & 7) * 8; const size_t kr = ((size_t)b * SPB + kt + key) * 768;
              f32x4 a, c; pg8::ld8(PC + kr + 512 + kvh * 64 + d0, a, c); *(f32x4*)(Ks + key * 64 + d0) = a; *(f32x4*)(Ks + key * 64 + d0 + 4) = c;
              pg8::ld8(PC + kr + 640 + kvh * 64 + d0, a, c); *(f32x4*)(Vs + key * 64 + d0) = a; *(f32x4*)(Vs + key * 64 + d0 + 4) = c; }
            __syncthreads();
#pragma unroll 1
            for (int j = 0; j < 64; ++j) { const float* kp = Ks + j * 64; const float* vp = Vs + j * 64; float a = 0.f;
#pragma unroll
                for (int d = 0; d < 64; d += 4) { const f32x4 kv = *(const f32x4*)(kp + d); a += q[d] * kv[0]; a += q[d + 1] * kv[1]; a += q[d + 2] * kv[2]; a += q[d + 3] * kv[3]; }
                if (a > mrun) { const float alpha = __builtin_amdgcn_exp2f(mrun - a); lrun *= alpha; mrun = a;
#pragma unroll
                    for (int d = 0; d < 64; ++d) o[d] *= alpha; }
                const float pj = __builtin_amdgcn_exp2f(a - mrun); lrun += pj;
#pragma unroll
                for (int d = 0; d < 64; d += 4) { const f32x4 vv = *(const f32x4*)(vp + d); o[d] += pj * vv[0]; o[d + 1] += pj * vv[1]; o[d + 2] += pj * vv[2]; o[d + 3] += pj * vv[3]; }
            }
        }
        if (tid < nq) { const float il = 1.0f / lrun; bf16* op = YC + row * 1536 + 1024 + h * 64;
#pragma unroll
            for (int d = 0; d < 64; d += 8) pg8::st8(op + d, (f32x4){o[d] * il, o[d + 1] * il, o[d + 2] * il, o[d + 3] * il}, (f32x4){o[d + 4] * il, o[d + 5] * il, o[d + 6] * il, o[d + 7] * il}); }
    }
    __syncthreads();
}

__device__ __forceinline__ void hgrn_naive(const bf16* PB, bf16* OB, const float* lbp, int layer, int gw, int NGW, int lane) {
    for (int wu = gw; wu < 2048; wu += NGW) {
        const int chain = wu >> 7, v = wu & 127, b = chain >> 3, hd = (chain >> 1) & 3, dir = chain & 1;
        float lb0 = 0.f, lb1 = 0.f;
        if (layer > 0) { const int c0 = dir * 512 + hd * 128 + lane; lb0 = sigm_acc(lbp[1024 + c0] - lbp[c0]); lb1 = sigm_acc(lbp[1024 + c0 + 64] - lbp[c0 + 64]); }
        float S0 = 0.f, S1 = 0.f;
        for (int tb = 0; tb < SPB; tb += 8) {
            float q0[8], q1[8], z0[8], z1[8], vv[8]; int rr[8];
#pragma unroll
            for (int i = 0; i < 8; ++i) { const int tau = tb + i; const int s = dir == 0 ? tau : (tau < CTX ? CTX - 1 - tau : SPB + CTX - 1 - tau); const int r = b * SPB + s; rr[i] = r;
                const bf16* p = PB + (size_t)r * 2560 + hd * 128;
                q0[i] = bf2f(p[lane]); q1[i] = bf2f(p[lane + 64]); z0[i] = bf2f(p[512 + dir * 512 + lane]); z1[i] = bf2f(p[512 + dir * 512 + lane + 64]); vv[i] = bf2f(p[1536 + v]); }
            float part[8];
#pragma unroll
            for (int i = 0; i < 8; ++i) {
                const float e0 = __expf(z0[i]), e1 = __expf(z1[i]);
                const float n0 = 1.0f / (1.0f + e0), n1 = 1.0f / (1.0f + e1);
                const float k0 = (1.0f - lb0) * n0, k1 = (1.0f - lb1) * n1, f0 = 1.0f - k0, f1 = 1.0f - k1;
                S0 = f0 * S0 + k0 * vv[i]; S1 = f1 * S1 + k1 * vv[i];
                part[i] = S0 * q0[i] + S1 * q1[i]; }
#pragma unroll
            for (int i = 0; i < 8; ++i) part[i] = wave_sum(part[i]);
            float mine = part[0]; int myr = rr[0];
#pragma unroll
            for (int i = 1; i < 8; ++i) if (lane == i) { mine = part[i]; myr = rr[i]; }
            if (lane < 8) OB[((size_t)dir * MT + myr) * 512 + hd * 128 + v] = (bf16)f2bf(mine);
        }
    }
}
namespace hg {
typedef short bf16x8 __attribute__((ext_vector_type(8)));
typedef float f32x4 __attribute__((ext_vector_type(4)));
constexpr int QS = 136, TS = 72;
constexpr int NSEG = 16, NCHUNK = SPB / 64;
constexpr int OFF_QT = 0, OFF_KT = OFF_QT + 64 * QS * 2, OFF_KTT = OFF_KT + 64 * QS * 2, OFF_VT = OFF_KTT + 128 * TS * 2, OFF_S0T = OFF_VT + 128 * TS * 2,
              OFF_AS = OFF_S0T + 128 * QS * 2, OFF_ER = OFF_AS + 64 * TS * 2, OFF_D2 = OFF_ER + 128 * 4, HG_LDS = OFF_D2 + 128 * 4;
static_assert(OFF_KT % 16 == 0 && OFF_KTT % 16 == 0 && OFF_VT % 16 == 0 && OFF_S0T % 16 == 0 && OFF_AS % 16 == 0 && OFF_ER % 16 == 0 && HG_LDS <= LDSCTL_OFF, "hgrn LDS map");
#define HG_MFMA(a, b, c) __builtin_amdgcn_mfma_f32_16x16x32_bf16((a), (b), (c), 0, 0, 0)
__device__ __forceinline__ int rowmap(int dir, int ci, int t) { return dir == 0 ? 64 * ci + t : (ci < 4 ? 255 - 64 * ci - t : 16895 - 64 * ci - t); }

__device__ __forceinline__ float scan32_mul(float v) {
    const int one = __float_as_int(1.0f);
    v *= __int_as_float(__builtin_amdgcn_update_dpp(one, __float_as_int(v), 0x111, 0xf, 0xf, false));
    v *= __int_as_float(__builtin_amdgcn_update_dpp(one, __float_as_int(v), 0x112, 0xf, 0xf, false));
    v *= __int_as_float(__builtin_amdgcn_update_dpp(one, __float_as_int(v), 0x114, 0xf, 0xf, false));
    v *= __int_as_float(__builtin_amdgcn_update_dpp(one, __float_as_int(v), 0x118, 0xf, 0xf, false));
    v *= __int_as_float(__builtin_amdgcn_update_dpp(one, __float_as_int(v), 0x142, 0xa, 0xf, false));
    return v;
}
__device__ __forceinline__ float bfx(const v4u& a, const v4u& b, int c) {
    const unsigned w = c < 8 ? (c < 4 ? (c < 2 ? a.x : a.y) : (c < 6 ? a.z : a.w)) : (c < 12 ? (c < 10 ? b.x : b.y) : (c < 14 ? b.z : b.w));
    return (c & 1) ? __uint_as_float(w & 0xffff0000u) : __uint_as_float(w << 16);
}
template <bool FULL> __device__ __forceinline__ void hgrn_seg(unsigned char* lds, const bf16* PB, bf16* OB, const float* lbp, float* HU, const float* HS, float* HLD,
                                                              const int layer, const int chain, const int seg, const int tid) {
    if (!FULL && seg == NSEG - 1) return;
    const int lane = tid & 63, wave = __builtin_amdgcn_readfirstlane(tid >> 6), fr = lane & 15, fq = lane >> 4;
    const int b = chain >> 3, hd = (chain >> 1) & 3, dir = chain & 1;
    const int c0 = (seg * NCHUNK) / NSEG, c1 = ((seg + 1) * NCHUNK) / NSEG;
    float oml[16];
#pragma unroll
    for (int c = 0; c < 16; ++c) { float lb = 0.f; if (layer > 0) { const int ch = dir * 512 + hd * 128 + 16 * wave + c; lb = sigm_acc(lbp[1024 + ch] - lbp[ch]); } oml[c] = 1.0f - lb; }
    bf16* QT = (bf16*)(lds + OFF_QT); bf16* KT = (bf16*)(lds + OFF_KT); bf16* KTT = (bf16*)(lds + OFF_KTT); bf16* VT = (bf16*)(lds + OFF_VT); bf16* S0T = (bf16*)(lds + OFF_S0T); bf16* AS = (bf16*)(lds + OFF_AS);
    float* ER = (float*)(lds + OFF_ER); float* D2 = (float*)(lds + OFF_D2);
    if (FULL) for (int i = tid; i < 64 * TS / 2; i += 512) ((unsigned*)AS)[i] = 0u;
    const bf16* pz = PB + (size_t)b * SPB * 2560 + hd * 128 + 16 * wave;
    const int vt_t = tid >> 3, vt_seg = tid & 7;
    const bf16* pv = PB + (size_t)b * SPB * 2560 + 1536 + hd * 128 + vt_seg * 16;
    f32x4 S[8];
#pragma unroll
    for (int vt = 0; vt < 8; ++vt) S[vt] = (f32x4){0.f, 0.f, 0.f, 0.f};
    if (FULL && seg > 0) { const float* sp = HS + ((size_t)(chain * NSEG + seg) * 128 + 16 * wave + 4 * fq) * 128 + fr;
#pragma unroll
        for (int vt = 0; vt < 8; ++vt)
#pragma unroll
            for (int i = 0; i < 4; ++i) S[vt][i] = sp[i * 128 + 16 * vt]; }
    float ldacc[16];
#pragma unroll
    for (int c = 0; c < 16; ++c) ldacc[c] = 0.f;
    v4u z0, z1, q0 = {0u, 0u, 0u, 0u}, q1 = q0, vraw0, vraw1;
    { const bf16* p = pz + (size_t)rowmap(dir, c0, lane) * 2560; z0 = *(const v4u*)(p + 512 + dir * 512); z1 = *(const v4u*)(p + 512 + dir * 512 + 8); if (FULL) { q0 = *(const v4u*)p; q1 = *(const v4u*)(p + 8); }
      const bf16* p2 = pv + (size_t)rowmap(dir, c0, vt_t) * 2560; vraw0 = *(const v4u*)p2; vraw1 = *(const v4u*)(p2 + 8); }
    for (int ci = c0; ci < c1; ++ci) {
        float kk[16], P[16];
#pragma unroll
        for (int c = 0; c < 16; ++c) { const float e = __expf(bfx(z0, z1, c)); const float kj = oml[c] * __builtin_amdgcn_rcpf(1.0f + e); kk[c] = kj; P[c] = 1.0f - kj; }
#pragma unroll
        for (int c = 0; c < 16; ++c) P[c] = scan32_mul(P[c]);
        unsigned qp[8], kp[8]; float Tv[16], Gv[16];
#pragma unroll
        for (int c = 0; c < 16; c += 2) { float qe[2], ke[2];
#pragma unroll
            for (int h = 0; h < 2; ++h) { const float Pc = P[c + h];
                const float T = fmaxf(__int_as_float(__builtin_amdgcn_readlane(__float_as_int(Pc), 31)), 1e-37f), Gl = __int_as_float(__builtin_amdgcn_readlane(__float_as_int(Pc), 63));
                Tv[c + h] = T; Gv[c + h] = Gl;
                const float inv = __builtin_amdgcn_rcpf(fmaxf(Pc, 1e-37f));
                const float eq = lane < 32 ? Pc * __builtin_amdgcn_rcpf(T) : Pc, ek = lane < 32 ? T * inv : inv;
                ke[h] = kk[c + h] * ek; qe[h] = FULL ? bfx(q0, q1, c + h) * eq : 0.f; }
            kp[c >> 1] = pg8::cvt_pk_bf16(ke[0], ke[1]); if (FULL) qp[c >> 1] = pg8::cvt_pk_bf16(qe[0], qe[1]); }
        if (!FULL) {
#pragma unroll
            for (int c = 0; c < 16; ++c) ldacc[c] += __logf(Tv[c]) + __logf(fmaxf(Gv[c], 1e-37f)); }
        const v4u vr0 = vraw0, vr1 = vraw1;
        { const int cn = ci + 1 < c1 ? ci + 1 : ci;
          const bf16* p = pz + (size_t)rowmap(dir, cn, lane) * 2560; z0 = *(const v4u*)(p + 512 + dir * 512); z1 = *(const v4u*)(p + 512 + dir * 512 + 8); if (FULL) { q0 = *(const v4u*)p; q1 = *(const v4u*)(p + 8); }
          const bf16* p2 = pv + (size_t)rowmap(dir, cn, vt_t) * 2560; vraw0 = *(const v4u*)p2; vraw1 = *(const v4u*)(p2 + 8); }
        __syncthreads();
        if (FULL) { *(v4u*)(QT + lane * QS + 16 * wave) = (v4u){qp[0], qp[1], qp[2], qp[3]}; *(v4u*)(QT + lane * QS + 16 * wave + 8) = (v4u){qp[4], qp[5], qp[6], qp[7]};
                    *(v4u*)(KT + lane * QS + 16 * wave) = (v4u){kp[0], kp[1], kp[2], kp[3]}; *(v4u*)(KT + lane * QS + 16 * wave + 8) = (v4u){kp[4], kp[5], kp[6], kp[7]}; }
#pragma unroll
        for (int c = 0; c < 16; c += 2) { KTT[(16 * wave + c) * TS + lane] = (bf16)(kp[c >> 1] & 0xffffu); KTT[(16 * wave + c + 1) * TS + lane] = (bf16)(kp[c >> 1] >> 16); }
        if (lane == 31) {
#pragma unroll
            for (int c = 0; c < 16; ++c) ER[16 * wave + c] = Tv[c]; }
        if (lane == 63) {
#pragma unroll
            for (int c = 0; c < 16; ++c) D2[16 * wave + c] = Gv[c]; }
        { bf16* vp = VT + (16 * vt_seg) * TS + 8 * ((vt_t >> 3) ^ vt_seg) + (vt_t & 7);
          vp[0 * TS] = (bf16)(vr0.x & 0xffffu); vp[1 * TS] = (bf16)(vr0.x >> 16); vp[2 * TS] = (bf16)(vr0.y & 0xffffu); vp[3 * TS] = (bf16)(vr0.y >> 16);
          vp[4 * TS] = (bf16)(vr0.z & 0xffffu); vp[5 * TS] = (bf16)(vr0.z >> 16); vp[6 * TS] = (bf16)(vr0.w & 0xffffu); vp[7 * TS] = (bf16)(vr0.w >> 16);
          vp[8 * TS] = (bf16)(vr1.x & 0xffffu); vp[9 * TS] = (bf16)(vr1.x >> 16); vp[10 * TS] = (bf16)(vr1.y & 0xffffu); vp[11 * TS] = (bf16)(vr1.y >> 16);
          vp[12 * TS] = (bf16)(vr1.z & 0xffffu); vp[13 * TS] = (bf16)(vr1.z >> 16); vp[14 * TS] = (bf16)(vr1.w & 0xffffu); vp[15 * TS] = (bf16)(vr1.w >> 16); }
        __syncthreads();
        float erv[4], d2v[4];
#pragma unroll
        for (int i = 0; i < 4; ++i) { erv[i] = ER[16 * wave + 4 * fq + i]; d2v[i] = D2[16 * wave + 4 * fq + i]; }
#pragma unroll
        for (int vt = 0; vt < 8; ++vt) { S[vt] = (f32x4){S[vt][0] * erv[0], S[vt][1] * erv[1], S[vt][2] * erv[2], S[vt][3] * erv[3]};
            if (FULL) { u32x2v w; w.x = pg8::cvt_pk_bf16(S[vt][0], S[vt][1]); w.y = pg8::cvt_pk_bf16(S[vt][2], S[vt][3]); *(u32x2v*)(S0T + (16 * vt + fr) * QS + 16 * wave + 4 * fq) = w; } }
        if (FULL) for (int ti = wave; ti < 10; ti += 8) { const int tb = ti >= 6 ? 3 : ti >= 3 ? 2 : ti >= 1 ? 1 : 0, sb = ti - (tb * (tb + 1)) / 2;
            f32x4 acc = {0.f, 0.f, 0.f, 0.f};
#pragma unroll
            for (int k4 = 0; k4 < 4; ++k4) { const bf16x8 a = *(const bf16x8*)(QT + (16 * tb + fr) * QS + 32 * k4 + 8 * fq), bb = *(const bf16x8*)(KT + (16 * sb + fr) * QS + 32 * k4 + 8 * fq); acc = HG_MFMA(a, bb, acc); }
#pragma unroll
            for (int i = 0; i < 4; ++i) { const int t = 16 * tb + 4 * fq + i, s = 16 * sb + fr; AS[t * TS + s] = (bf16)f2bf(s <= t ? acc[i] : 0.f); } }
        { const bf16x8 a0 = *(const bf16x8*)(KTT + (16 * wave + fr) * TS + 8 * fq), a1 = *(const bf16x8*)(KTT + (16 * wave + fr) * TS + 32 + 8 * fq);
#pragma unroll
          for (int vt = 0; vt < 8; ++vt) { const bf16* vrow = VT + (16 * vt + fr) * TS;
              f32x4 acc = HG_MFMA(a0, *(const bf16x8*)(vrow + 8 * (fq ^ vt)), S[vt]); acc = HG_MFMA(a1, *(const bf16x8*)(vrow + 8 * ((4 + fq) ^ vt)), acc);
              S[vt] = (f32x4){acc[0] * d2v[0], acc[1] * d2v[1], acc[2] * d2v[2], acc[3] * d2v[3]}; } }
        if (FULL) {
            __syncthreads();
            const int tb = wave & 3, v0t = (wave >> 2) * 4;
            bf16x8 aq[4], aa[2];
#pragma unroll
            for (int k4 = 0; k4 < 4; ++k4) aq[k4] = *(const bf16x8*)(QT + (16 * tb + fr) * QS + 32 * k4 + 8 * fq);
#pragma unroll
            for (int ks = 0; ks < 2; ++ks) aa[ks] = *(const bf16x8*)(AS + (16 * tb + fr) * TS + 32 * ks + 8 * fq);
            int orow[4];
#pragma unroll
            for (int i = 0; i < 4; ++i) orow[i] = b * SPB + rowmap(dir, ci, 16 * tb + 4 * fq + i);
#pragma unroll
            for (int vi = 0; vi < 4; ++vi) { const int vt = v0t + vi; f32x4 acc = {0.f, 0.f, 0.f, 0.f}; const bf16* srow = S0T + (16 * vt + fr) * QS + 8 * fq; const bf16* vrow = VT + (16 * vt + fr) * TS;
#pragma unroll
                for (int k4 = 0; k4 < 4; ++k4) acc = HG_MFMA(aq[k4], *(const bf16x8*)(srow + 32 * k4), acc);
                acc = HG_MFMA(aa[0], *(const bf16x8*)(vrow + 8 * (fq ^ vt)), acc); acc = HG_MFMA(aa[1], *(const bf16x8*)(vrow + 8 * ((4 + fq) ^ vt)), acc);
#pragma unroll
                for (int i = 0; i < 4; ++i) OB[((size_t)dir * MT + orow[i]) * 512 + hd * 128 + 16 * vt + fr] = (bf16)f2bf(acc[i]); }
        }
    }
    if (!FULL) { float* up = HU + ((size_t)(chain * NSEG + seg) * 128 + 16 * wave + 4 * fq) * 128 + fr;
#pragma unroll
        for (int vt = 0; vt < 8; ++vt)
#pragma unroll
            for (int i = 0; i < 4; ++i) up[i * 128 + 16 * vt] = S[vt][i];
        if (lane == 63) {
#pragma unroll
            for (int c = 0; c < 16; ++c) HLD[(chain * NSEG + seg) * 128 + 16 * wave + c] = ldacc[c]; } }
    __syncthreads();
}
__device__ __forceinline__ void hgrn_carry(const float* HU, float* HS, const float* HLD, const int vcu, const int G, const int tid) {
    for (int e = vcu * 512 + tid; e < 16 * 16384; e += G * 512) { const int chain = e >> 14, kv = e & 16383, k = kv >> 7; float s = 0.f;
        for (int g = 0; g + 1 < NSEG; ++g) { const size_t o = (size_t)(chain * NSEG + g) * 16384 + kv; s = __expf(HLD[(chain * NSEG + g) * 128 + k]) * s + HU[o]; HS[o + 16384] = s; } }
}
#undef HG_MFMA
}
constexpr int NPL = 13;
constexpr int NPHASE = 2 + DEPTH * NPL;
struct Args { const float* in[24]; float* out; unsigned char* ws; int ph_lo, ph_hi, li, pad; };
enum { I_X = 0, I_C, I_CTX, I_CCTX, I_WMOD, I_BMOD, I_N1G, I_N2G, I_WIN, I_CONVW, I_LBP, I_HNG, I_QNG, I_KNG, I_WA, I_WB, I_WC, I_WOUT, I_RW, I_RB, I_WG, I_WU, I_WD, I_FG };

typedef __attribute__((address_space(4))) const Args CArgs;
__device__ __forceinline__ const CArgs* kap() { const CArgs* p = (const CArgs*)__builtin_amdgcn_kernarg_segment_ptr(); asm volatile("" : "+s"(p)); return p; }
#define IN(k) (lo <= (k) && (k) < hi)
#define PHASE_VARS int tid_ = threadIdx.x; asm volatile("" : "+v"(tid_)); const int tid = tid_, lane = tid_ & 63; (void)tid; (void)lane; PHASE_PTRS
#define PHASE_PTRS const CArgs* A = kap(); unsigned char* ws = A->ws; (void)ws;
#define WSP(T, off) ((T*)(ws + (off)))
#define SEAM(k) do { if (IN(k) && IN((k) + 1)) xcd_barrier(bar); } while (0)
template <int LAYER> __device__ __forceinline__ void layer_phases(const int lo, const int hi, const XcdBarrier& bar, unsigned char* lds) {
    constexpr int layer = LAYER;
    LAS unsigned char* ldsl = (LAS unsigned char*)lds;
    const int wave = __builtin_amdgcn_readfirstlane((int)threadIdx.x >> 6);
    const int G = gridDim.x; const int bx = blockIdx.x; const int vcu = (G % 8 == 0) ? (bx % 8) * (G / 8) + bx / 8 : bx;
    const int gw = vcu * NWAVES + wave, NGW = G * NWAVES;
    LAS float* scr = (LAS float*)(ldsl + wave * 16384); (void)scr;
        const int pb = 2 + layer * NPL;
        if (IN(pb + 0)) { PHASE_PTRS
            pg8::Gemm g{WSP(bf16, WS_U), WSP(bf16, WS_WIN) + (size_t)layer * NWIN * D, MT, N1, D, D}; pg8::StaticOrder S; S.init(MT, N1, G, bx);
            pg8::EpiW1 E{WSP(bf16, WS_PA), WSP(bf16, WS_PB), WSP(bf16, WS_PC)};
            pg8::gemm_phase<pg8::EpiW1, pg8::StaticOrder, true, true>(ldsl, g, S, E);
        }
        SEAM(pb + 0);
        if (IN(pb + 1)) { PHASE_VARS
            const float* cw = A->in[I_CONVW] + layer * 3 * 512; const float* qg = A->in[I_QNG] + layer * 64; const float* kg = A->in[I_KNG] + layer * 64;
            const bf16* PAp = WSP(bf16, WS_PA); bf16* YCp = WSP(bf16, WS_YCAT); bf16* PCp = WSP(bf16, WS_PC); const float* ropet = WSP(float, WS_SMALL + SM_ROPE);
            const f32x4 w0a = *(const f32x4*)(cw + 8 * lane), w0b = *(const f32x4*)(cw + 8 * lane + 4), w1a = *(const f32x4*)(cw + 512 + 8 * lane), w1b = *(const f32x4*)(cw + 512 + 8 * lane + 4),
                        w2a = *(const f32x4*)(cw + 1024 + 8 * lane), w2b = *(const f32x4*)(cw + 1024 + 8 * lane + 4);
            const int c8 = lane & 7;
            const f32x4 qga = *(const f32x4*)(qg + 8 * c8), qgb = *(const f32x4*)(qg + 8 * c8 + 4), kga = *(const f32x4*)(kg + 8 * c8), kgb = *(const f32x4*)(kg + 8 * c8 + 4);
            for (int r0 = gw * 2; r0 < MT; r0 += NGW * 2) {
                f32x4 x0a[2], x0b[2], xma[2], xmb[2], xpa[2], xpb[2], aba[2], abb[2], qa[2], qb[2], ka[2], kb[2];
#pragma unroll
                for (int i = 0; i < 2; ++i) { const int r = r0 + i, b = r >= SPB ? 1 : 0, s = r - b * SPB; const bool first = (s == 0 || s == CTX), last = (s == CTX - 1 || s == SPB - 1);
                    const bf16* pa = PAp + (size_t)r * 1024 + 8 * lane; xma[i] = (f32x4){0.f, 0.f, 0.f, 0.f}; xmb[i] = xma[i]; xpa[i] = xma[i]; xpb[i] = xma[i];
                    pg8::ld8(pa, x0a[i], x0b[i]); if (!first) pg8::ld8(pa - 1024, xma[i], xmb[i]); if (!last) pg8::ld8(pa + 1024, xpa[i], xpb[i]); pg8::ld8(pa + 512, aba[i], abb[i]);
                    const bf16* pc = PCp + (size_t)r * 768; pg8::ld8(pc + 8 * lane, qa[i], qb[i]); pg8::ld8(pc + 512 + 8 * (lane & 15), ka[i], kb[i]); }
#pragma unroll
                for (int i = 0; i < 2; ++i) { const int r = r0 + i, b = r >= SPB ? 1 : 0, s = r - b * SPB, t = s - CTX;
                    pg8::st8(YCp + (size_t)r * 1536 + 8 * lane, aba[i] * (w0a * xma[i] + w1a * x0a[i] + w2a * xpa[i]), abb[i] * (w0b * xmb[i] + w1b * x0b[i] + w2b * xpb[i]));
                    const float* rp = s >= CTX ? ropet + 2 * (((c8 < 4) ? (t >> 6) : 256 + (t & 63)) * 16 + 8 * (c8 & 1)) : nullptr;
                    bf16* pc = PCp + (size_t)r * 768;
                    qk_norm_rope(qa[i], qb[i], qga, qgb, rp, (c8 & 2) != 0, attn_body::C2); { pg8::u32x2 w; w.x = pg8::pk_fp8x4(qa[i][0], qa[i][1], qa[i][2], qa[i][3]); w.y = pg8::pk_fp8x4(qb[i][0], qb[i][1], qb[i][2], qb[i][3]); *(pg8::u32x2*)((unsigned char*)pc + 8 * lane) = w; }
                    qk_norm_rope(ka[i], kb[i], kga, kgb, rp, (c8 & 2) != 0, 1.0f); if (lane < 16) { pg8::u32x2 w; w.x = pg8::pk_fp8x4(ka[i][0], ka[i][1], ka[i][2], ka[i][3]); w.y = pg8::pk_fp8x4(kb[i][0], kb[i][1], kb[i][2], kb[i][3]); *(pg8::u32x2*)((unsigned char*)pc + 1024 + 8 * lane) = w; } }
            }
            if (layer > 0) convert_experts(A->in[I_WG], A->in[I_WU], A->in[I_WD], layer, WSP(bf16, WS_WEXP), scr, gw, NGW, lane);
        }
        __syncthreads();
        if (IN(pb + 1)) { PHASE_VARS for (int u = vcu; u < 256; u += G) hg::hgrn_seg<false>(lds, WSP(bf16, WS_PB), WSP(bf16, WS_OBUF), A->in[I_LBP], WSP(float, WS_HGU), WSP(float, WS_HGS), WSP(float, WS_SMALL + SM_HLD), layer, u >> 4, u & 15, tid); }
        SEAM(pb + 1);
        if (IN(pb + 2)) { PHASE_VARS hg::hgrn_carry(WSP(float, WS_HGU), WSP(float, WS_HGS), WSP(float, WS_SMALL + SM_HLD), vcu, G, tid); }
        __syncthreads();
        if (IN(pb + 2)) { PHASE_PTRS
            const attn_body::bf16* PCb = (const attn_body::bf16*)WSP(bf16, WS_PC); attn_body::bf16* YCb = (attn_body::bf16*)WSP(bf16, WS_YCAT);
            const int per = (1024 + G - 1) / G;
            for (int i = 0; i < per; ++i) { const int id = vcu * per + i; if (id >= 1024) break;
                const int b = id >> 9, h = (id >> 6) & 7, q0 = CTX + (id & 63) * 256; const size_t rb = (size_t)b * SPB;
                attn_body::attn_unit((const unsigned char*)PCb + (rb + q0) * 1536 + h * 64, (const unsigned char*)PCb + rb * 1536 + 1024 + (h >> 2) * 64, (const unsigned char*)PCb + rb * 1536 + 1280 + (h >> 2) * 64, YCb + (rb + q0) * 1536 + 1024 + h * 64, SPB / 64, (char*)lds); }
            if (layer < DEPTH - 1) for (int x = vcu; x < 16; x += G) {
                const int b = x >> 3, h = x & 7; const size_t rb = (size_t)b * SPB;
                attn_body::attn_unit((const unsigned char*)PCb + rb * 1536 + h * 64, (const unsigned char*)PCb + rb * 1536 + 1024 + (h >> 2) * 64, (const unsigned char*)PCb + rb * 1536 + 1280 + (h >> 2) * 64, YCb + rb * 1536 + 1024 + h * 64, CTX / 64, (char*)lds); }
        }
        SEAM(pb + 2);
        if (IN(pb + 3)) { PHASE_VARS for (int u = vcu; u < 256; u += G) hg::hgrn_seg<true>(lds, WSP(bf16, WS_PB), WSP(bf16, WS_OBUF), A->in[I_LBP], WSP(float, WS_HGU), WSP(float, WS_HGS), WSP(float, WS_SMALL + SM_HLD), layer, u >> 4, u & 15, tid); }
        SEAM(pb + 3);
        if (IN(pb + 4)) { PHASE_VARS
            const float* hg = A->in[I_HNG] + layer * 512; const bf16* OBp = WSP(bf16, WS_OBUF); const bf16* PBp = WSP(bf16, WS_PB); bf16* YCp = WSP(bf16, WS_YCAT);
            const f32x4 n0 = *(const f32x4*)(hg + 8 * lane), n1 = *(const f32x4*)(hg + 8 * lane + 4);
            for (int r0 = gw * 4; r0 < MT; r0 += NGW * 4) { f32x4 a0[4], a1[4], b0[4], b1[4], g0[4], g1[4];
#pragma unroll
                for (int i = 0; i < 4; ++i) { const size_t r = r0 + i; pg8::ld8(OBp + r * 512 + 8 * lane, a0[i], a1[i]); pg8::ld8(OBp + ((size_t)MT + r) * 512 + 8 * lane, b0[i], b1[i]); pg8::ld8(PBp + r * 2560 + 2048 + 8 * lane, g0[i], g1[i]); }
#pragma unroll
                for (int i = 0; i < 4; ++i) { const size_t r = r0 + i; a0[i] += b0[i]; a1[i] += b1[i];
                    float ss = (a0[i][0] * a0[i][0] + a0[i][1] * a0[i][1]) + (a0[i][2] * a0[i][2] + a0[i][3] * a0[i][3]) + (a1[i][0] * a1[i][0] + a1[i][1] * a1[i][1]) + (a1[i][2] * a1[i][2] + a1[i][3] * a1[i][3]);
                    ss = row_sum16(ss);
                    const float rs = 1.0f / sqrtf(ss * (1.0f / 128.0f) + EPS);
                    pg8::st8(YCp + r * 1536 + 512 + 8 * lane, a0[i] * rs * n0 * g0[i], a1[i] * rs * n1 * g1[i]); } }
        }
        SEAM(pb + 4);
        if (IN(pb + 5)) { PHASE_PTRS
            pg8::Gemm g{WSP(bf16, WS_U8), (const bf16*)(WSP(unsigned char, WS_WG8) + (size_t)layer * NGATE * D), MT, NGATE, D / 2, D / 2};   pg8::RowOrder S; S.init(layer == DEPTH - 1, NGATE, 1, G, bx);
            pg8::EpiGate E{WSP(bf16, WS_GATES)};
            pg8::gemm_phase<pg8::EpiGate, pg8::RowOrder, true, true, true>(ldsl, g, S, E);
        }
        SEAM(pb + 5);
        if (IN(pb + 6)) { PHASE_PTRS pg8::Gemm g{WSP(bf16, WS_YCAT), WSP(bf16, WS_WABC) + (size_t)(layer * 3) * D * 512, MT, D, 512, 1536, (size_t)512 * 2, (size_t)D * 512 * 2};
            pg8::RowOrder S; S.init(layer == DEPTH - 1, D, 3, G, bx); pg8::EpiMerge3 E{WSP(bf16, WS_GATES), WSP(bf16, WS_U)};
            pg8::gemm_phase<pg8::EpiMerge3, pg8::RowOrder, true, true>(ldsl, g, S, E); }
        SEAM(pb + 6);
        if (IN(pb + 7)) { PHASE_PTRS pg8::Gemm g{WSP(bf16, WS_U), WSP(bf16, WS_WO) + (size_t)layer * D * D, MT, D, D, D}; pg8::RowOrder S; S.init(layer == DEPTH - 1, D, 1, G, bx); pg8::EpiWo E{WSP(bf16, WS_DELTA), (WSP(float, WS_MOD) + (size_t)layer * 3 * 6144)};
            pg8::gemm_phase<pg8::EpiWo, pg8::RowOrder, true, true>(ldsl, g, S, E); }
        SEAM(pb + 7);
        if (IN(pb + 8)) { PHASE_VARS
            int* lcnt = (int*)lds; float* rwT = (float*)(lds + 1024);
            if (tid < 16) lcnt[tid] = 0;
            { const float* rwg = A->in[I_RW]; for (int i = tid; i < D * NE; i += NWAVES * 64) rwT[(i & 15) * D + (i >> 4)] = rwg[i]; }
            __syncthreads();
            const float* rw = A->in[I_RW]; (void)rw; const float* rb = A->in[I_RB]; const float* hl = layer == 0 ? A->in[I_X] : (const float*)A->out; const float* hc = layer == 0 ? A->in[I_CTX] : (const float*)WSP(float, WS_HCTX); const bf16* DLp = WSP(bf16, WS_DELTA); const float* modl_ = WSP(float, WS_MOD) + (size_t)layer * 3 * 6144;
            const float* n2g = A->in[I_N2G] + layer * D; bf16* U = WSP(bf16, WS_U); int* re_ = WSP(int, WS_SMALL + SM_RE); float* rwt_ = WSP(float, WS_SMALL + SM_RW); int* rp_ = WSP(int, WS_SMALL + SM_RP);
            for (int r0 = gw * 2; r0 < MT; r0 += NGW * 2) { if (layer == DEPTH - 1 && mod_idx(r0) == 2) continue;
                f32x4 v[2][4], y[2][4];
#pragma unroll
                for (int i = 0; i < 2; ++i) { if (layer == 0) load_row(hrow(hl, hc, r0 + i), lane, v[i]); else load_h1(A->out, WSP(float, WS_HCTX), r0 + i, lane, v[i]); add_row_bf16(DLp + (size_t)(r0 + i) * D, lane, v[i]); }
#pragma unroll
                for (int i = 0; i < 2; ++i) { const float* m = modl_ + (size_t)mod_idx(r0 + i) * 6144; norm_mod(v[i], n2g, m + 4 * 1024, m + 3 * 1024, lane, y[i]); store_row_fp8((unsigned char*)U + (size_t)(r0 + i) * D, lane, y[i]); }
                float lg[2][16];
#pragma unroll
                for (int e = 0; e < 16; ++e) { lg[0][e] = 0.f; lg[1][e] = 0.f; }
#pragma unroll
                for (int j = 0; j < 4; ++j)
#pragma unroll
                    for (int e = 0; e < 16; ++e) { const f32x4 w = *(const f32x4*)(rwT + e * D + 4 * lane + 256 * j);
                        lg[0][e] = fmaf(y[0][j][0], w[0], fmaf(y[0][j][1], w[1], fmaf(y[0][j][2], w[2], fmaf(y[0][j][3], w[3], lg[0][e]))));
                        lg[1][e] = fmaf(y[1][j][0], w[0], fmaf(y[1][j][1], w[1], fmaf(y[1][j][2], w[2], fmaf(y[1][j][3], w[3], lg[1][e])))); }
#define RT_DPP(x, ctrl) __int_as_float(__builtin_amdgcn_update_dpp(__float_as_int(x), __float_as_int(x), (ctrl), 0xf, 0xf, false))
#define RT_XOR4(dst, x) do { int t_ = __builtin_amdgcn_update_dpp(__float_as_int(x), __float_as_int(x), 0x104, 0xf, 0x5, false); t_ = __builtin_amdgcn_update_dpp(t_, __float_as_int(x), 0x114, 0xf, 0xa, false); dst = __int_as_float(t_); } while (0)
                float z[16], w8[8], c4[4], d2[2];
#pragma unroll
                for (int e = 0; e < 16; ++e) { const auto rr = __builtin_amdgcn_permlane32_swap(__float_as_uint(lg[0][e]), __float_as_uint(lg[1][e]), false, false); z[e] = __uint_as_float(rr[0]) + __uint_as_float(rr[1]); }
#pragma unroll
                for (int e = 0; e < 8; ++e) { const auto rr = __builtin_amdgcn_permlane16_swap(__float_as_uint(z[e]), __float_as_uint(z[e + 8]), false, false); w8[e] = __uint_as_float(rr[0]) + __uint_as_float(rr[1]); }
                const bool b4 = (lane & 16) != 0, b3 = (lane & 8) != 0, b2 = (lane & 4) != 0, b1 = (lane & 2) != 0;
#pragma unroll
                for (int p = 0; p < 4; ++p) { const float s1 = b3 ? w8[p + 4] : w8[p], s2 = b3 ? w8[p] : w8[p + 4]; c4[p] = s1 + RT_DPP(s2, 0x128); }
#pragma unroll
                for (int p = 0; p < 2; ++p) { const float s1 = b2 ? c4[p + 2] : c4[p], s2 = b2 ? c4[p] : c4[p + 2]; float x_; RT_XOR4(x_, s2); d2[p] = s1 + x_; }
                float lgt; { const float s1 = b1 ? d2[1] : d2[0], s2 = b1 ? d2[0] : d2[1]; lgt = s1 + RT_DPP(s2, 0x4e); }
                lgt += RT_DPP(lgt, 0xb1);
                const int ex = (lane >> 1) & 15; const float scv = __builtin_amdgcn_rcpf(1.0f + __expf(-lgt)); const float sel = scv + rb[ex];
                float o2_; RT_XOR4(o2_, sel); const float o1_ = RT_DPP(sel, 0x4e), o3_ = RT_DPP(o2_, 0x4e);
                const int rank = (int)(o1_ > sel || (o1_ == sel && b1)) + (int)(o2_ > sel || (o2_ == sel && b2)) + (int)(o3_ > sel || (o3_ == sel && b2));
                float gs = rank < 2 ? sel : 0.f; gs += RT_DPP(gs, 0x4e); { float x_; RT_XOR4(x_, gs); gs += x_; }
                float g2_; { const auto rr = __builtin_amdgcn_permlane16_swap(__float_as_uint(gs), __float_as_uint(gs), false, false); g2_ = b4 ? __uint_as_float(rr[0]) : __uint_as_float(rr[1]); }
                const float g1_ = RT_DPP(gs, 0x128), g3_ = RT_DPP(g2_, 0x128);
                const bool gbest = !(g1_ > gs || (g1_ == gs && b3)) && !(g2_ > gs || (g2_ == gs && b4)) && !(g3_ > gs || (g3_ == gs && b4));
                const unsigned long long m0 = __ballot(gbest && rank == 0), m1 = __ballot(gbest && rank == 1);
#undef RT_DPP
#undef RT_XOR4
#pragma unroll
                for (int i = 0; i < 2; ++i) { const int r = r0 + i;
                    const int l0 = 32 * i + __builtin_ctz((unsigned)(m0 >> (32 * i))), l1 = 32 * i + __builtin_ctz((unsigned)(m1 >> (32 * i)));
                    const int i0 = (l0 >> 1) & 15, i1 = (l1 >> 1) & 15; const float w0 = __int_as_float(__builtin_amdgcn_readlane(__float_as_int(scv), l0)), w1 = __int_as_float(__builtin_amdgcn_readlane(__float_as_int(scv), l1));
                    if (lane == 0) { const float inv = 1.0f / (w0 + w1); const int k0 = atomicAdd(&lcnt[i0], 1), k1 = atomicAdd(&lcnt[i1], 1);
                        re_[2 * r] = i0; re_[2 * r + 1] = i1; rwt_[2 * r] = w0 * inv; rwt_[2 * r + 1] = w1 * inv; rp_[2 * r] = k0; rp_[2 * r + 1] = k1; } }
            }
            __syncthreads();
            if (tid < 16) WSP(int, WS_SMALL + SM_BCNT)[vcu * 16 + tid] = lcnt[tid];
            __syncthreads();
        }
        SEAM(pb + 8);
        if (IN(pb + 9)) { PHASE_VARS
            int* ltot = (int*)lds; int* lbef = ltot + 16; int* lbase = ltot + 32;
            const int* bc = WSP(int, WS_SMALL + SM_BCNT); int* tab = WSP(int, WS_SMALL + SM_TAB); int* re_ = WSP(int, WS_SMALL + SM_RE); int* rp_ = WSP(int, WS_SMALL + SM_RP);
            const unsigned char* U = WSP(unsigned char, WS_U); unsigned char* XSp = WSP(unsigned char, WS_XS);
            if (tid < 32) ltot[tid] = 0;
            __syncthreads();
            { const int e = tid & 15; int tot = 0, bef = 0;
              for (int b2 = (tid >> 4); b2 < G; b2 += 32) { const int c = bc[b2 * 16 + e]; tot += c; if (b2 < vcu) bef += c; }
              atomicAdd(&ltot[e], tot); atomicAdd(&lbef[e], bef); }
            __syncthreads();
            if (tid == 0) { int run = 0;
                for (int e = 0; e < 16; ++e) { const int pad = (ltot[e] + 255) / 256 * 256; lbase[e] = run + lbef[e];
                    if (vcu == 0) for (int t2 = run / 256; t2 < (run + pad) / 256; ++t2) tab[1 + t2] = e;
                    run += pad; }
                if (vcu == 0) tab[0] = run / 256; }
            __syncthreads();
            for (int r0 = gw * 2; r0 < MT; r0 += NGW * 4) {
                int p0[4], p1[4]; v4u a[4]; bool ok[4];
#pragma unroll
                for (int i = 0; i < 4; ++i) { const int r = r0 + (i >> 1) * NGW * 2 + (i & 1); ok[i] = r < MT && !(layer == DEPTH - 1 && mod_idx(r) == 2); const int rc = ok[i] ? r : 0;
                    p0[i] = lbase[re_[2 * rc]] + rp_[2 * rc]; p1[i] = lbase[re_[2 * rc + 1]] + rp_[2 * rc + 1];
                    a[i] = *(const v4u*)(U + (size_t)rc * D + 16 * lane); }
                asm volatile("" ::: "memory");
#pragma unroll
                for (int i = 0; i < 4; ++i) { const int r = r0 + (i >> 1) * NGW * 2 + (i & 1); if (!ok[i]) continue; if (lane == 0) { rp_[2 * r] = p0[i]; rp_[2 * r + 1] = p1[i]; }
                    const v4u q8 = a[i];
                    *(v4u*)(XSp + (size_t)p0[i] * D + 16 * lane) = q8; *(v4u*)(XSp + (size_t)p1[i] * D + 16 * lane) = q8; } }
            __syncthreads();
        }
        SEAM(pb + 9);
        if (IN(pb + 10)) { PHASE_PTRS pg8::Gemm g{WSP(bf16, WS_XS), WSP(bf16, WS_WEXP), PMAX, 2048, D / 2, D / 2}; pg8::MoeOrder S; S.init(WSP(int, WS_SMALL + SM_TAB), 8, G, vcu); pg8::EpiMoe1 E{WSP(unsigned char, WS_HID)};
            pg8::gemm_phase<pg8::EpiMoe1, pg8::MoeOrder, true, true, true>(ldsl, g, S, E); }
        SEAM(pb + 10);
        if (IN(pb + 11)) { PHASE_PTRS pg8::Gemm g{WSP(bf16, WS_HID), (const bf16*)(WSP(unsigned char, WS_WEXP) + (size_t)NE * 2048 * 1024), PMAX, 1024, DFF / 2, DFF / 2}; pg8::MoeOrder S; S.init(WSP(int, WS_SMALL + SM_TAB), 4, G, vcu); pg8::EpiMoe2 E{WSP(bf16, WS_YS)};
            pg8::gemm_phase<pg8::EpiMoe2, pg8::MoeOrder, true, true, true>(ldsl, g, S, E); }
        SEAM(pb + 11);
        if (IN(pb + 12)) { PHASE_VARS
            float* hl = A->out; float* hc = WSP(float, WS_HCTX); const float* modl_ = WSP(float, WS_MOD) + (size_t)layer * 3 * 6144; const int* rp_ = WSP(int, WS_SMALL + SM_RP); const float* rwt_ = WSP(float, WS_SMALL + SM_RW);
            const float* sl = layer == 0 ? A->in[I_X] : (const float*)A->out; const float* sc_ = layer == 0 ? A->in[I_CTX] : (const float*)WSP(float, WS_HCTX); const bf16* DLp = WSP(bf16, WS_DELTA);
            const bf16* YS = WSP(bf16, WS_YS); bf16* U = WSP(bf16, WS_U); const float* n1g = A->in[I_N1G] + (layer + 1 < DEPTH ? layer + 1 : layer) * D; const float* fg = A->in[I_FG];
            for (int r0 = gw * 4; r0 < MT; r0 += NGW * 4) {
                if (layer == DEPTH - 1 && mod_idx(r0) == 2) continue;
                f32x4 v[4][4]; u32x2v ya[4][4], yb[4][4]; float w0[4], w1[4]; float* hp[4]; int p0[4], p1[4];
#pragma unroll
                for (int i = 0; i < 4; ++i) { const int r = r0 + i; p0[i] = rp_[2 * r]; p1[i] = rp_[2 * r + 1]; w0[i] = rwt_[2 * r]; w1[i] = rwt_[2 * r + 1]; hp[i] = (float*)hrow(hl, hc, r); if (layer == 0) load_row(hrow(sl, sc_, r), lane, v[i]); else load_h1(A->out, WSP(float, WS_HCTX), r, lane, v[i]); add_row_bf16(DLp + (size_t)r * D, lane, v[i]); }
#pragma unroll
                for (int i = 0; i < 4; ++i)
#pragma unroll
                    for (int j = 0; j < 4; ++j) { const int c = 4 * lane + 256 * j; ya[i][j] = *(const u32x2v*)(YS + (size_t)p0[i] * D + c); yb[i][j] = *(const u32x2v*)(YS + (size_t)p1[i] * D + c); }
#pragma unroll
                for (int i = 0; i < 4; ++i) { const int r = r0 + i, mi = mod_idx(r); const float* g2 = modl_ + (size_t)mi * 6144 + 5 * 1024;
#pragma unroll
                    for (int j = 0; j < 4; ++j) { const int c = 4 * lane + 256 * j; const f32x4 gg = *(const f32x4*)(g2 + c);
                        const f32x4 fa = {pg8::bflo(ya[i][j].x), pg8::bfhi(ya[i][j].x), pg8::bflo(ya[i][j].y), pg8::bfhi(ya[i][j].y)}, fb = {pg8::bflo(yb[i][j].x), pg8::bfhi(yb[i][j].x), pg8::bflo(yb[i][j].y), pg8::bfhi(yb[i][j].y)};
                        v[i][j] += gg * (fa * w0[i] + fb * w1[i]); }
                    if (layer < DEPTH - 1) {
#pragma unroll
                        for (int j = 0; j < 4; ++j) { if (mi == 2) *(f32x4*)(hp[i] + 4 * lane + 256 * j) = v[i][j]; }
                        if (mi != 2) store_row_bf16((bf16*)hp[i] + D, lane, v[i]);
                        f32x4 y[4]; const float* m = WSP(float, WS_MOD) + (size_t)((layer + 1) * 3 + mi) * 6144; norm_mod(v[i], n1g, m + 1024, m, lane, y); store_row_bf16(U + (size_t)r * D, lane, y); store_row_fp8(WSP(unsigned char, WS_U8) + (size_t)r * D, lane, y);
                    } else {
                        const float rstd = row_rstd(v[i]);
#pragma unroll
                        for (int j = 0; j < 4; ++j) *(f32x4*)(hp[i] + 4 * lane + 256 * j) = v[i][j] * rstd * *(const f32x4*)(fg + 4 * lane + 256 * j);
                    } }
            }
        }
        SEAM(pb + 12);
    }
__global__ void __launch_bounds__(NWAVES * 64, 2) fwd(Args args) {
    extern __shared__ __attribute__((aligned(16))) unsigned char lds[];
    LAS unsigned char* ldsl = (LAS unsigned char*)lds;
    volatile LAS unsigned* MISC = (volatile LAS unsigned*)(ldsl + MISC_OFF);
    const int tid = threadIdx.x, lane = tid & 63, wave = __builtin_amdgcn_readfirstlane(tid >> 6);
    const int G = gridDim.x; const int bx = blockIdx.x; const int vcu = (G % 8 == 0) ? (bx % 8) * (G / 8) + bx / 8 : bx;
    const int gw = vcu * NWAVES + wave, NGW = G * NWAVES;
    gu32* ctl = (gu32*)(args.ws + WS_CTL);
    for (int u = tid; u < (LDS_BYTES - LDSCTL_OFF) / 4; u += NWAVES * 64) ((LAS unsigned*)(ldsl + LDSCTL_OFF))[u] = 0u;
    __syncthreads();
    const int lo = args.ph_lo, hi = args.ph_hi;
    const bool multi = (hi - lo) > 1;
    XcdBarrier bar; bar.bar = (unsigned*)(ctl + CW_BAR) + args.li * XCD_BAR_WORDS; bar.x = 0; bar.st = nullptr;
    if (multi) bar = xcd_barrier_post((unsigned*)(ctl + CW_BAR) + args.li * XCD_BAR_WORDS, MISC + 8);

    LAS float* scr = (LAS float*)(ldsl + wave * 16384);

    if (IN(0)) { PHASE_VARS
        for (int it = gw; it < DEPTH * 16 * 248; it += NGW) { const int l = it / (16 * 248), r = it % (16 * 248), kb = r / 248, nb = r % 248;
            if (32 * nb < N1) transpose_item(A->in[I_WIN] + (size_t)l * D * NWIN, NWIN, WSP(bf16, WS_WIN) + (size_t)l * NWIN * D, D, win_drow(32 * nb), 64 * kb, 32 * nb, scr, lane);
            else transpose_item<true>(A->in[I_WIN] + (size_t)l * D * NWIN, NWIN, (bf16*)(WSP(unsigned char, WS_WG8) + (size_t)l * NGATE * D), D, 32 * nb - N1, 64 * kb, 32 * nb, scr, lane); }
        for (int it = gw; it < DEPTH * 3 * 256; it += NGW) { const int mat = it / 256, r = it % 256, kb = r / 32, nb = r % 32, l = mat / 3, br = mat % 3;
            const float* W = (br == 0 ? A->in[I_WA] : br == 1 ? A->in[I_WB] : A->in[I_WC]) + (size_t)l * 512 * D;
            transpose_item(W, D, WSP(bf16, WS_WABC) + (size_t)(l * 3 + br) * D * 512, 512, 32 * nb, 64 * kb, 32 * nb, scr, lane); }
        for (int it = gw; it < DEPTH * 512; it += NGW) { const int l = it / 512, r = it % 512, kb = r / 32, nb = r % 32;
            transpose_item(A->in[I_WOUT] + (size_t)l * D * D, D, WSP(bf16, WS_WO) + (size_t)l * D * D, D, 32 * nb, 64 * kb, 32 * nb, scr, lane); }
        convert_experts(A->in[I_WG], A->in[I_WU], A->in[I_WD], 0, WSP(bf16, WS_WEXP), scr, gw, NGW, lane);
        __syncthreads();
        { float* sc = (float*)lds;
          float* red = sc + 3 * 1024;
          for (int i = tid; i < 3 * 1024; i += NWAVES * 64) { const int j = i >> 10, k = i & 1023; const float c = j < 2 ? A->in[I_C][j * 1024 + k] : A->in[I_CCTX][k]; sc[i] = c * sigm_acc(c); }
          __syncthreads();
          for (int unit = vcu; unit < DEPTH * 96; unit += G) { const int l = unit / 96, cg = unit % 96, col = cg * 64 + lane;
              const float* W = A->in[I_WMOD] + (size_t)l * D * 6144 + col; float a0 = 0.f, a1 = 0.f, a2 = 0.f;
#pragma unroll 8
              for (int k = wave * 128; k < wave * 128 + 128; ++k) { const float w = W[(size_t)k * 6144]; a0 += sc[k] * w; a1 += sc[1024 + k] * w; a2 += sc[2048 + k] * w; }
              red[(wave * 3 + 0) * 64 + lane] = a0; red[(wave * 3 + 1) * 64 + lane] = a1; red[(wave * 3 + 2) * 64 + lane] = a2;
              __syncthreads();
              if (tid < 192) { const int j = tid >> 6, ln = tid & 63; float s = 0.f;
#pragma unroll
                  for (int w = 0; w < 8; ++w) s += red[(w * 3 + j) * 64 + ln];
                  const int c = cg * 64 + ln; WSP(float, WS_MOD)[(size_t)(l * 3 + j) * 6144 + c] = s + A->in[I_BMOD][l * 6144 + c]; }
              __syncthreads(); }
        }
        for (int i = gw * 64 + lane; i < 320 * 16; i += NGW * 64) { const int pos = (i >> 4) < 256 ? (i >> 4) : (i >> 4) - 256, fi = i & 15;
            const float inv = __builtin_amdgcn_exp2f(-(float)(2 * fi) * (13.287712379549449f / 32.0f)); const float a = (float)pos * inv;
            const double ad = (double)a; const double rev = ad * 0.15915494309189535; const double fr = rev - __builtin_rint(rev); const float red = (float)(fr * 6.283185307179586);
            WSP(float, WS_SMALL + SM_ROPE)[2 * i] = __cosf(red); WSP(float, WS_SMALL + SM_ROPE)[2 * i + 1] = __sinf(red); }
    }
    SEAM(0);
    if (IN(1)) { PHASE_VARS
        const float* mod0 = WSP(float, WS_MOD); bf16* U = WSP(bf16, WS_U); unsigned char* U8 = WSP(unsigned char, WS_U8); const float* xin = A->in[I_X]; const float* cin = A->in[I_CTX]; const float* n1g = A->in[I_N1G];
        for (int r0 = gw * 4; r0 < MT; r0 += NGW * 4) { f32x4 v[4][4];
#pragma unroll
            for (int i = 0; i < 4; ++i) load_row(hrow(xin, cin, r0 + i), lane, v[i]);
#pragma unroll
            for (int i = 0; i < 4; ++i) { f32x4 y[4]; const float* m = mod0 + (size_t)mod_idx(r0 + i) * 6144; norm_mod(v[i], n1g, m + 1024, m, lane, y); store_row_bf16(U + (size_t)(r0 + i) * D, lane, y); store_row_fp8(U8 + (size_t)(r0 + i) * D, lane, y); } }
    }
    SEAM(1);

    layer_phases<0>(lo, hi, bar, lds);
    layer_phases<1>(lo, hi, bar, lds);
#undef PHASE_VARS
#undef PHASE_PTRS
#undef WSP
#undef IN
#undef SEAM
}

extern "C" void kernel_launch(void* const* d_in, const int* in_sizes, int n_in, void* d_out, int out_size, void* d_ws, size_t ws_size, hipStream_t stream) {
    static int grid = 0;
    if (grid == 0) {
        if (n_in != 24 || out_size != NB * SEQ * D || ws_size < WS_END) { fprintf(stderr, "kernel_launch: unexpected shapes (n_in %d, out %d, ws %zu < %zu); nothing launched\n", n_in, out_size, ws_size, (size_t)WS_END); grid = -1; return; }
        int dev = 0, cus = 0, per_cu = 0;
        if (hipGetDevice(&dev) != hipSuccess || hipDeviceGetAttribute(&cus, hipDeviceAttributeMultiprocessorCount, dev) != hipSuccess) { grid = -1; return; }
        if (hipFuncSetAttribute((const void*)fwd, hipFuncAttributeMaxDynamicSharedMemorySize, LDS_BYTES) != hipSuccess) { fprintf(stderr, "kernel_launch: hipFuncSetAttribute failed\n"); grid = -1; return; }
        if (hipOccupancyMaxActiveBlocksPerMultiprocessor(&per_cu, (const void*)fwd, NWAVES * 64, LDS_BYTES) != hipSuccess || per_cu < 1) { fprintf(stderr, "kernel_launch: occupancy query says %d\n", per_cu); }
        (void)hipGetLastError();
        grid = cus;
    }
    if (grid < 0) return;
    if (hipMemsetAsync((char*)d_ws + WS_CTL, 0, CTL_ZERO_BYTES, stream) != hipSuccess) return;
    Args a{};
    for (int i = 0; i < 24; ++i) a.in[i] = (const float*)d_in[i];
    a.out = (float*)d_out; a.ws = (unsigned char*)d_ws;
#ifndef MK_ONE_LAUNCH
#define MK_ONE_LAUNCH 1
#endif
    if (MK_ONE_LAUNCH) { a.ph_lo = 0; a.ph_hi = NPHASE; a.li = 0; hipLaunchKernelGGL(fwd, dim3(grid), dim3(NWAVES * 64), LDS_BYTES, stream, a); }
    else for (int ph = 0; ph < NPHASE; ++ph) { a.ph_lo = ph; a.ph_hi = ph + 1; a.li = 0; hipLaunchKernelGGL(fwd, dim3(grid), dim3(NWAVES * 64), LDS_BYTES, stream, a); }
}
```

```cpp
#include <hip/hip_runtime.h>
#include <cstdio>
#include <cstdint>
#include <cmath>
#include <hip/hip_bf16.h>
#ifndef ATTN_NSUM
#define ATTN_NSUM 4
#endif
namespace pg8 {
#define PG8_LAS __attribute__((address_space(3)))
typedef unsigned short bf16_t;
typedef short bf16x8 __attribute__((ext_vector_type(8)));
typedef float f32x4 __attribute__((ext_vector_type(4)));
typedef unsigned u32x4 __attribute__((ext_vector_type(4)));
typedef int v4i_t __attribute__((ext_vector_type(4)));
typedef int v8i_t __attribute__((ext_vector_type(8)));
constexpr int BM = 256, BK = 64, HALF = 128, HTB = HALF * BK * 2  , STAGE_BYTES = 8 * HTB, NXCD = 8, WGM = 8;

__host__ __device__ __forceinline__ int lds_byte(int r, int c) { const int st = (r >> 4) * 2 + (c >> 5), rr = r & 15, cc = c & 31, ob = rr * 64 + cc * 2; return st * 1024 + (ob ^ (((ob >> 9) & 1) << 5)); }
__host__ __device__ __forceinline__ void stage_rc(int b, int& R, int& C) { const int st = b / 1024, sb = b % 1024, swz = sb ^ (((sb >> 9) & 1) << 5); R = (st >> 1) * 16 + swz / 64; C = (st & 1) * 32 + (swz % 64) / 2; }
__host__ __device__ __forceinline__ int perm32(int rho) { const int n = rho >> 4, i = rho & 15; return 8 * (i >> 2) + 4 * n + (i & 3); }

struct Unit { int pm, pn, seg; };
struct Gemm { const bf16_t* A; const bf16_t* Bt; int M, N, K, lda; size_t segA, segB; };

struct StaticOrder {
    int nM, nN, nwg, G, c;
    __host__ __device__ void init(int M, int N, int G_, int c_) { nM = M / BM; nN = N / BM; nwg = nM * nN; G = G_; c = c_; }
    __host__ __device__ bool next(int i, Unit& u) const {
        const long L = (long)i * G + c; if (L >= nwg) return false;
        int wgid = (int)L; { const int q = nwg / NXCD, r = nwg % NXCD, xcd = wgid % NXCD, off = wgid / NXCD; wgid = (xcd < r ? xcd * (q + 1) : r * (q + 1) + (xcd - r) * q) + off; }
        const int nig = WGM * nN, gid = wgid / nig, fm = gid * WGM, gsz = (nM - fm) < WGM ? (nM - fm) : WGM;
        u.pm = fm + ((wgid % nig) % gsz); u.pn = (wgid % nig) / gsz; u.seg = 0; return true;
    }
    __device__ __forceinline__ void a_ready(const Unit&) const {}
    __device__ __forceinline__ void done(const Unit&) const {}
};

typedef float f32x2c __attribute__((ext_vector_type(2))); typedef __bf16 bf16x2c __attribute__((ext_vector_type(2)));
__device__ __forceinline__ unsigned cvt_pk_bf16(float lo, float hi) { const f32x2c v = {lo, hi}; const bf16x2c b = __builtin_convertvector(v, bf16x2c); return __builtin_bit_cast(unsigned, b); }
typedef float f32x2 __attribute__((ext_vector_type(2)));
typedef unsigned u32x2 __attribute__((ext_vector_type(2)));
__device__ __forceinline__ float fsigmoid(float x) { return __builtin_amdgcn_rcpf(1.0f + __builtin_amdgcn_exp2f(-1.4426950408889634f * x)); }
__device__ __forceinline__ float fsilu(float x) { return x * fsigmoid(x); }
__device__ __forceinline__ f32x4 silu4(f32x4 v) { return (f32x4){fsilu(v[0]), fsilu(v[1]), fsilu(v[2]), fsilu(v[3])}; }
__device__ __forceinline__ f32x4 sigm4(f32x4 v) { return (f32x4){fsigmoid(v[0]), fsigmoid(v[1]), fsigmoid(v[2]), fsigmoid(v[3])}; }
__device__ __forceinline__ void st8(bf16_t* p, const f32x4 a, const f32x4 b) {
    u32x4 w; w.x = cvt_pk_bf16(a[0], a[1]); w.y = cvt_pk_bf16(a[2], a[3]); w.z = cvt_pk_bf16(b[0], b[1]); w.w = cvt_pk_bf16(b[2], b[3]); *(u32x4*)p = w; }
__device__ __forceinline__ float bflo(unsigned w) { return __uint_as_float(w << 16); }
__device__ __forceinline__ float bfhi(unsigned w) { return __uint_as_float(w & 0xffff0000u); }
__device__ __forceinline__ void ld8(const bf16_t* p, f32x4& a, f32x4& b) { const u32x4 w = *(const u32x4*)p; a = (f32x4){bflo(w.x), bfhi(w.x), bflo(w.y), bfhi(w.y)}; b = (f32x4){bflo(w.z), bfhi(w.z), bflo(w.w), bfhi(w.w)}; }

__device__ __forceinline__ unsigned pk_fp8x4(float a, float b, float c, float d) { int p = __builtin_amdgcn_cvt_pk_fp8_f32(a, b, 0, false); p = __builtin_amdgcn_cvt_pk_fp8_f32(c, d, p, true); return (unsigned)p; }
constexpr float WSCALE8 = 64.0f, WINV8 = 1.0f / 64.0f;
struct EpiW1 {
    static constexpr bool PERM = true, AFTER_DRAIN = false; __device__ __forceinline__ bool keep(const Unit&) const { return false; }
    bf16_t *PA, *PB, *PC;
    __device__ __forceinline__ void operator()(const f32x4 (&acc)[2][2][4][2], const Unit& u, int wr, int wc, int fr, int fq) const {
        const int row0 = u.pm * BM + wr * 64 + fr, c8 = wc * 32 + 8 * fq;
        if (u.pn < 4) {
#pragma unroll
            for (int ai = 0; ai < 2; ++ai)
#pragma unroll
                for (int m = 0; m < 4; ++m)
                    st8(PA + (size_t)(row0 + ai * HALF + m * 16) * 1024 + u.pn * 128 + c8, acc[ai][0][m][0] * acc[ai][1][m][0], acc[ai][0][m][1] * acc[ai][1][m][1]);
        } else {
            bf16_t* base; int ldc, cb; bool act;
            if (u.pn < 6) { base = PA; ldc = 1024; cb = 512 + 256 * (u.pn - 4); act = false; }
            else if (u.pn < 16) { base = PB; ldc = 2560; cb = 256 * (u.pn - 6); act = (u.pn < 8) || (u.pn >= 14); }
            else { base = PC; ldc = 768; cb = 256 * (u.pn - 16); act = false; }
#pragma unroll
            for (int ai = 0; ai < 2; ++ai)
#pragma unroll
                for (int m = 0; m < 4; ++m)
#pragma unroll
                    for (int bj = 0; bj < 2; ++bj) { f32x4 v0 = acc[ai][bj][m][0], v1 = acc[ai][bj][m][1]; if (act) { v0 = silu4(v0); v1 = silu4(v1); }
                        if (u.pn == 18 && bj == 1) { u32x2 w; w.x = pk_fp8x4(v0[0], v0[1], v0[2], v0[3]); w.y = pk_fp8x4(v1[0], v1[1], v1[2], v1[3]);
                            *(u32x2*)((unsigned char*)(base + (size_t)(row0 + ai * HALF + m * 16) * ldc) + 1280 + c8) = w; }
                        else st8(base + (size_t)(row0 + ai * HALF + m * 16) * ldc + cb + bj * HALF + c8, v0, v1); }
        }
    }
};
struct EpiGate {
    static constexpr bool PERM = true, AFTER_DRAIN = false; __device__ __forceinline__ bool keep(const Unit&) const { return false; }
    bf16_t* G;
    __device__ __forceinline__ void operator()(const f32x4 (&acc)[2][2][4][2], const Unit& u, int wr, int wc, int fr, int fq) const {
        bf16_t* tp = G + ((size_t)(u.pm * 12 + u.pn) * 65536) + (((wr * 4 + wc) * 64 + fq * 16 + fr) * 8);
#pragma unroll
        for (int ai = 0; ai < 2; ++ai)
#pragma unroll
            for (int m = 0; m < 4; ++m)
#pragma unroll
                for (int bj = 0; bj < 2; ++bj) st8(tp + ((ai * 4 + m) * 2 + bj) * 4096, sigm4(acc[ai][bj][m][0] * WINV8), sigm4(acc[ai][bj][m][1] * WINV8));
    }
};
template <int BR> struct EpiMerge {
    static constexpr bool PERM = true, AFTER_DRAIN = false; __device__ __forceinline__ bool keep(const Unit&) const { return false; }
    const bf16_t* G; bf16_t* Mb;
    __device__ __forceinline__ void operator()(const f32x4 (&acc)[2][2][4][2], const Unit& u, int wr, int wc, int fr, int fq) const {
        const int row0 = u.pm * BM + wr * 64 + fr, c8 = u.pn * BM + wc * 32 + 8 * fq;
#pragma unroll
        for (int ai = 0; ai < 2; ++ai)
#pragma unroll
            for (int m = 0; m < 4; ++m) {
#pragma unroll
                for (int bj = 0; bj < 2; ++bj) { const size_t row = (size_t)(row0 + ai * HALF + m * 16); const int col = bj * HALF + c8;
                    f32x4 g0, g1; ld8(G + row * 3072 + BR * 1024 + col, g0, g1);
                    f32x4 v0 = g0 * acc[ai][bj][m][0], v1 = g1 * acc[ai][bj][m][1];
                    if (BR > 0) { f32x4 p0, p1; ld8(Mb + row * 1024 + col, p0, p1); v0 += p0; v1 += p1; }
                    st8(Mb + row * 1024 + col, v0, v1); }
                asm volatile("" ::: "memory"); }
    }
};
struct EpiWo {
    static constexpr bool PERM = true, AFTER_DRAIN = false; __device__ __forceinline__ bool keep(const Unit&) const { return false; }
    bf16_t* DL; const float* mod;
    __device__ __forceinline__ void operator()(const f32x4 (&acc)[2][2][4][2], const Unit& u, int wr, int wc, int fr, int fq) const {
        const int b = u.pm / 65, j = u.pm % 65; const float* g1 = mod + ((j == 0 ? 2 : b) * 6 + 2) * 1024;
        const int row0 = u.pm * BM + wr * 64 + fr, c8 = u.pn * BM + wc * 32 + 8 * fq;
        f32x4 gv[2][2];
#pragma unroll
        for (int bj = 0; bj < 2; ++bj)
#pragma unroll
            for (int n = 0; n < 2; ++n) gv[bj][n] = *(const f32x4*)(g1 + c8 + bj * HALF + 4 * n);
#pragma unroll
        for (int ai = 0; ai < 2; ++ai)
#pragma unroll
            for (int m = 0; m < 4; ++m)
#pragma unroll
                for (int bj = 0; bj < 2; ++bj) st8(DL + (size_t)(row0 + ai * HALF + m * 16) * 1024 + bj * HALF + c8, gv[bj][0] * acc[ai][bj][m][0], gv[bj][1] * acc[ai][bj][m][1]);
    }
};
struct EpiMoe1 {
    static constexpr bool PERM = true, AFTER_DRAIN = false; __device__ __forceinline__ bool keep(const Unit&) const { return false; }
    unsigned char* HID;
    __device__ __forceinline__ void operator()(const f32x4 (&acc)[2][2][4][2], const Unit& u, int wr, int wc, int fr, int fq) const {
        const int row0 = u.pm * BM + wr * 64 + fr, c8 = (u.pn & 7) * 128 + wc * 32 + 8 * fq;
#pragma unroll
        for (int ai = 0; ai < 2; ++ai)
#pragma unroll
            for (int m = 0; m < 4; ++m) { const f32x4 h0 = silu4(acc[ai][0][m][0] * WINV8) * (acc[ai][1][m][0] * WINV8), h1 = silu4(acc[ai][0][m][1] * WINV8) * (acc[ai][1][m][1] * WINV8);
                u32x2 w; w.x = pk_fp8x4(h0[0], h0[1], h0[2], h0[3]); w.y = pk_fp8x4(h1[0], h1[1], h1[2], h1[3]);
                *(u32x2*)(HID + (size_t)(row0 + ai * HALF + m * 16) * 1024 + c8) = w; }
    }
};
struct EpiMoe2 {
    static constexpr bool PERM = true, AFTER_DRAIN = false; __device__ __forceinline__ bool keep(const Unit&) const { return false; }
    bf16_t* YS;
    __device__ __forceinline__ void operator()(const f32x4 (&acc)[2][2][4][2], const Unit& u, int wr, int wc, int fr, int fq) const {
        const int row0 = u.pm * BM + wr * 64 + fr, c8 = (u.pn & 3) * BM + wc * 32 + 8 * fq;
#pragma unroll
        for (int ai = 0; ai < 2; ++ai)
#pragma unroll
            for (int m = 0; m < 4; ++m)
#pragma unroll
                for (int bj = 0; bj < 2; ++bj) st8(YS + (size_t)(row0 + ai * HALF + m * 16) * 1024 + bj * HALF + c8, acc[ai][bj][m][0] * WINV8, acc[ai][bj][m][1] * WINV8);
    }
};
struct MoeOrder {
    const int* tab; int nN, G, c, n_units;
    __device__ __forceinline__ void init(const int* tab_, int nN_, int G_, int c_) { tab = tab_; nN = nN_; G = G_; c = c_; n_units = __builtin_amdgcn_readfirstlane(tab_[0]) * nN_; }
    __device__ __forceinline__ bool next(int i, Unit& u) const {
        const int L = i * G + c; if (L >= n_units) return false;
        const int t = L / nN, j = L - t * nN; const int e = __builtin_amdgcn_readfirstlane(tab[1 + t]);
        u.pm = t; u.pn = e * nN + j; u.seg = 0; return true;
    }
    __device__ __forceinline__ void a_ready(const Unit&) const {}
    __device__ __forceinline__ void done(const Unit&) const {}
};


struct EpiMerge3 {
    static constexpr bool PERM = true, AFTER_DRAIN = false;
    const bf16_t* G; bf16_t* Mb;
    __device__ __forceinline__ bool keep(const Unit& u) const { return u.seg < 2; }
    __device__ __forceinline__ void operator()(f32x4 (&acc)[2][2][4][2], const Unit& u, int wr, int wc, int fr, int fq) const {
        const int row0 = u.pm * BM + wr * 64 + fr, c8 = u.pn * BM + wc * 32 + 8 * fq;
#pragma unroll
        for (int ai = 0; ai < 2; ++ai) {
            u32x4 gw[4][2], hw[4][2];
#pragma unroll
            for (int m = 0; m < 4; ++m)
#pragma unroll
                for (int bj = 0; bj < 2; ++bj) { const bf16_t* gp = G + ((size_t)(u.pm * 12 + u.seg * 4 + u.pn) * 65536) + (((wr * 4 + wc) * 64 + fq * 16 + fr) * 8) + ((ai * 4 + m) * 2 + bj) * 4096;
                    gw[m][bj] = *(const u32x4*)gp; if (u.seg < 2) hw[m][bj] = *(const u32x4*)(gp + 4 * 65536); }
#pragma unroll
            for (int m = 0; m < 4; ++m)
#pragma unroll
                for (int bj = 0; bj < 2; ++bj) { const u32x4 w = gw[m][bj];
                    f32x4 g0 = {bflo(w.x), bfhi(w.x), bflo(w.y), bfhi(w.y)}, g1 = {bflo(w.z), bfhi(w.z), bflo(w.w), bfhi(w.w)};
                    if (u.seg < 2) { const u32x4 x = hw[m][bj]; const f32x4 h0 = {bflo(x.x), bfhi(x.x), bflo(x.y), bfhi(x.y)}, h1 = {bflo(x.z), bfhi(x.z), bflo(x.w), bfhi(x.w)};
#pragma unroll
                        for (int q = 0; q < 4; ++q) { g0[q] *= __builtin_amdgcn_rcpf(fmaxf(h0[q], 1e-6f)); g1[q] *= __builtin_amdgcn_rcpf(fmaxf(h1[q], 1e-6f)); }
                        acc[ai][bj][m][0] *= g0; acc[ai][bj][m][1] *= g1; }
                    else st8(Mb + (size_t)(row0 + ai * HALF + m * 16) * 1024 + bj * HALF + c8, acc[ai][bj][m][0] * g0, acc[ai][bj][m][1] * g1); }
            asm volatile("" ::: "memory"); }
    }
};
struct RowOrder {
    StaticOrder so; bool lat; int nseg;
    __device__ __forceinline__ void init(bool lat_, int N, int nseg_, int G_, int c_) { lat = lat_; nseg = nseg_; so.init(lat_ ? 128 * BM : 130 * BM, N, G_, c_); }
    __device__ __forceinline__ bool next(int i, Unit& u) const { const int ti = i / nseg; if (!so.next(ti, u)) return false; u.seg = i - ti * nseg; if (lat) u.pm += 1 + (u.pm >= 64 ? 1 : 0); return true; }
    __device__ __forceinline__ void a_ready(const Unit&) const {}
    __device__ __forceinline__ void done(const Unit&) const {}
};
template <class Epi, class Sched, bool ALIGN_EPI = false, bool SP2 = false, bool FP8 = false>
__device__ __forceinline__ void gemm_phase(PG8_LAS unsigned char* lds, const Gemm g, const Sched& S, const Epi& E) {
    int tid_ = threadIdx.x; asm volatile("" : "+v"(tid_));
    const int tid = tid_, wid = __builtin_amdgcn_readfirstlane(tid >> 6), lane = tid & 63, wr = wid >> 2, wc = wid & 3, fr = lane & 15, fq = lane >> 4;
    const int K = g.K, nt = K / BK;
    unsigned voffA[2], voffB[2];
#pragma unroll
    for (int i = 0; i < 2; ++i) { int R, C; stage_rc(tid * 16 + i * 8192, R, C); const int Rb = Epi::PERM ? ((R & ~31) + perm32(R & 31)) : R;
        voffA[i] = (unsigned)(R * g.lda + C) * 2u; voffB[i] = (unsigned)(Rb * K + C) * 2u; }
    const size_t kstep = (size_t)(BK * 2);
    const size_t hstepA = (size_t)HALF * g.lda * 2, hstepB = (size_t)HALF * K * 2;
    const size_t tstepA = 2 * hstepA, tstepB = 2 * hstepB;
    const unsigned ldsw = (unsigned)wid * 1024u;
    const int aoff = lds_byte(wr * 64 + fr, fq * 8), boff = lds_byte(wc * 32 + fr, fq * 8);
#define PG8_SA(b, h) (((b) * 2 + (h)) * HTB)
#define PG8_SB(b, h) ((4 + (b) * 2 + (h)) * HTB)
#define PG8_UPTR(p) ((const char*)(((unsigned long long)(unsigned)__builtin_amdgcn_readfirstlane((int)(unsigned)((unsigned long long)(p) >> 32)) << 32) | (unsigned long long)(unsigned)__builtin_amdgcn_readfirstlane((int)(unsigned)(unsigned long long)(p))))
#define PG8_STAGE(bufoff, gbase, voff) do { const char* gb_ = PG8_UPTR(gbase); _Pragma("unroll") for (int _i = 0; _i < 2; ++_i) \
        __builtin_amdgcn_global_load_lds((const unsigned*)(gb_ + (voff)[_i]), (PG8_LAS unsigned*)(lds + (bufoff) + ldsw + _i * 8192), 16, 0, 0); } while (0)
#define PG8_LD32(p) __builtin_shufflevector(*(const PG8_LAS v4i_t*)(p), *(const PG8_LAS v4i_t*)((p) + 1024), 0, 1, 2, 3, 4, 5, 6, 7)
#define PG8_LDA(dst, b, h) do { _Pragma("unroll") for (int m = 0; m < 4; ++m) { if constexpr (FP8) dst##8[m] = PG8_LD32(lds + PG8_SA(b, h) + aoff + m * 2048); else { _Pragma("unroll") for (int k = 0; k < 2; ++k) dst[m][k] = *(const PG8_LAS bf16x8*)(lds + PG8_SA(b, h) + aoff + m * 2048 + k * 1024); } } } while (0)
#define PG8_LDB(dst, b, h) do { _Pragma("unroll") for (int n = 0; n < 2; ++n) { if constexpr (FP8) dst##8[n] = PG8_LD32(lds + PG8_SB(b, h) + boff + n * 2048); else { _Pragma("unroll") for (int k = 0; k < 2; ++k) dst[n][k] = *(const PG8_LAS bf16x8*)(lds + PG8_SB(b, h) + boff + n * 2048 + k * 1024); } } } while (0)
#define PG8_MMA(ai, bj, At, Bt) do { __builtin_amdgcn_s_setprio(1); _Pragma("unroll") for (int m = 0; m < 4; ++m) _Pragma("unroll") for (int n = 0; n < 2; ++n) { \
        if constexpr (FP8) acc[ai][bj][m][n] = __builtin_amdgcn_mfma_scale_f32_16x16x128_f8f6f4(Bt##8[n], At##8[m], acc[ai][bj][m][n], 0, 0, 0, 0, 0, 0); \
        else { _Pragma("unroll") for (int k = 0; k < 2; ++k) acc[ai][bj][m][n] = __builtin_amdgcn_mfma_f32_16x16x32_bf16(Bt[n][k], At[m][k], acc[ai][bj][m][n], 0, 0, 0); } } __builtin_amdgcn_s_setprio(0); } while (0)
#define PG8_WAIT_V(n) asm volatile("s_waitcnt vmcnt(" #n ")" ::: "memory")
#define PG8_WAIT_L(n) asm volatile("s_waitcnt lgkmcnt(" #n ")" ::: "memory")
#define PG8_BAR __builtin_amdgcn_s_barrier()
#define PG8_SCHED __builtin_amdgcn_sched_barrier(0)
    Unit cur, nxt; int ui = 0;
    if (!S.next(0, cur)) return;
    f32x4 acc[2][2][4][2];
#pragma unroll
    for (int a = 0; a < 2; ++a)
#pragma unroll
        for (int b = 0; b < 2; ++b)
#pragma unroll
            for (int m = 0; m < 4; ++m)
#pragma unroll
                for (int n = 0; n < 2; ++n) acc[a][b][m][n] = (f32x4){0.f, 0.f, 0.f, 0.f};
    bf16x8 At[4][2], B0[2][2], B1[2][2]; v8i_t At8[4], B08[2], B18[2];
    const char* cA = (const char*)g.A + (size_t)cur.pm * tstepA + (size_t)cur.seg * g.segA; const char* cB = (const char*)g.Bt + (size_t)cur.pn * tstepB + (size_t)cur.seg * g.segB;
    S.a_ready(cur);
    if constexpr (SP2) {
        PG8_STAGE(PG8_SB(0, 0), cB, voffB); PG8_STAGE(PG8_SB(0, 1), cB + hstepB, voffB); PG8_STAGE(PG8_SA(0, 0), cA, voffA); PG8_STAGE(PG8_SA(0, 1), cA + hstepA, voffA);
        if (wr == 1) PG8_BAR;
        PG8_WAIT_V(2); PG8_BAR;
        PG8_STAGE(PG8_SB(1, 0), cB + kstep, voffB); PG8_STAGE(PG8_SA(1, 0), cA + kstep, voffA); PG8_STAGE(PG8_SB(1, 1), cB + hstepB + kstep, voffB);
        PG8_WAIT_V(6); PG8_BAR;
    } else {
        PG8_STAGE(PG8_SB(0, 0), cB, voffB); PG8_STAGE(PG8_SA(0, 0), cA, voffA); PG8_STAGE(PG8_SB(0, 1), cB + hstepB, voffB); PG8_STAGE(PG8_SA(0, 1), cA + hstepA, voffA);
        if (wr == 1) PG8_BAR;
        PG8_WAIT_V(4); PG8_BAR;
        PG8_STAGE(PG8_SB(1, 0), cB + kstep, voffB); PG8_STAGE(PG8_SA(1, 0), cA + kstep, voffA); PG8_STAGE(PG8_SB(1, 1), cB + hstepB + kstep, voffB);
        PG8_WAIT_V(6); PG8_BAR;
    }
    for (;;) {
        const bool has_next = S.next(ui + 1, nxt);
        const char* nA = has_next ? (const char*)g.A + (size_t)nxt.pm * tstepA + (size_t)nxt.seg * g.segA : cA; const char* nB = has_next ? (const char*)g.Bt + (size_t)nxt.pn * tstepB + (size_t)nxt.seg * g.segB : cB;
#pragma unroll 1
        for (int t = 0; t < nt; t += 2) {
            const bool last = (t == nt - 2);
            const char* a1 = cA + (size_t)(t + 1) * kstep;
            const char* a2 = last ? nA : cA + (size_t)(t + 2) * kstep; const char* b2 = last ? nB : cB + (size_t)(t + 2) * kstep;
            const char* a3 = a2 + kstep; const char* b3 = b2 + kstep;
            if (last && has_next) S.a_ready(nxt);
            if constexpr (SP2) {
            PG8_LDB(B0, 0, 0); PG8_LDB(B1, 0, 1); PG8_SCHED; PG8_LDA(At, 0, 0); PG8_STAGE(PG8_SA(1, 1), a1 + hstepA, voffA);
            PG8_WAIT_V(8); PG8_WAIT_L(0); PG8_BAR; PG8_MMA(0, 0, At, B0); PG8_MMA(0, 1, At, B1); PG8_BAR; PG8_SCHED;
            PG8_LDA(At, 0, 1); PG8_STAGE(PG8_SB(0, 0), b2, voffB); PG8_STAGE(PG8_SB(0, 1), b2 + hstepB, voffB); PG8_STAGE(PG8_SA(0, 0), a2, voffA);
            PG8_WAIT_V(8); PG8_WAIT_L(0); PG8_BAR; PG8_MMA(1, 0, At, B0); PG8_MMA(1, 1, At, B1); PG8_BAR; PG8_SCHED;
            PG8_LDB(B0, 1, 0); PG8_LDB(B1, 1, 1); PG8_SCHED; PG8_LDA(At, 1, 0); PG8_STAGE(PG8_SA(0, 1), a2 + hstepA, voffA);
            PG8_WAIT_V(8); PG8_WAIT_L(0); PG8_BAR; PG8_MMA(0, 0, At, B0); PG8_MMA(0, 1, At, B1); PG8_BAR; PG8_SCHED;
            PG8_LDA(At, 1, 1); PG8_STAGE(PG8_SB(1, 0), b3, voffB); PG8_STAGE(PG8_SB(1, 1), b3 + hstepB, voffB); PG8_STAGE(PG8_SA(1, 0), a3, voffA);
            PG8_WAIT_V(8); PG8_WAIT_L(0); PG8_BAR; PG8_MMA(1, 0, At, B0); PG8_MMA(1, 1, At, B1); PG8_BAR; PG8_SCHED;
            } else {
            PG8_LDB(B0, 0, 0); PG8_SCHED; PG8_LDA(At, 0, 0); PG8_STAGE(PG8_SA(1, 1), a1 + hstepA, voffA);
            PG8_WAIT_L(8); PG8_BAR; PG8_WAIT_L(0); PG8_MMA(0, 0, At, B0); PG8_BAR; PG8_SCHED;
            PG8_LDB(B1, 0, 1); PG8_STAGE(PG8_SB(0, 0), b2, voffB);
            PG8_BAR; PG8_WAIT_L(0); PG8_MMA(0, 1, At, B1); PG8_BAR;
            PG8_LDA(At, 0, 1); PG8_STAGE(PG8_SA(0, 0), a2, voffA);
            PG8_BAR; PG8_WAIT_L(0); PG8_MMA(1, 0, At, B0); PG8_BAR; PG8_SCHED;
            PG8_STAGE(PG8_SB(0, 1), b2 + hstepB, voffB);
            PG8_WAIT_V(6); PG8_BAR; PG8_MMA(1, 1, At, B1); PG8_BAR;
            PG8_LDB(B0, 1, 0); PG8_SCHED; PG8_LDA(At, 1, 0); PG8_STAGE(PG8_SA(0, 1), a2 + hstepA, voffA);
            PG8_WAIT_L(8); PG8_BAR; PG8_WAIT_L(0); PG8_MMA(0, 0, At, B0); PG8_BAR; PG8_SCHED;
            PG8_LDB(B1, 1, 1); PG8_STAGE(PG8_SB(1, 0), b3, voffB);
            PG8_BAR; PG8_WAIT_L(0); PG8_MMA(0, 1, At, B1); PG8_BAR;
            PG8_LDA(At, 1, 1); PG8_STAGE(PG8_SA(1, 0), a3, voffA);
            PG8_BAR; PG8_WAIT_L(0); PG8_MMA(1, 0, At, B0); PG8_BAR; PG8_SCHED;
            PG8_STAGE(PG8_SB(1, 1), b3 + hstepB, voffB);
            PG8_WAIT_V(6); PG8_BAR; PG8_MMA(1, 1, At, B1); PG8_BAR;
            }
        }
        if constexpr (ALIGN_EPI) { if (wr == 0) PG8_BAR; }
        if constexpr (!Epi::AFTER_DRAIN) { int le_; asm volatile("v_mbcnt_lo_u32_b32 %0, -1, 0\n\tv_mbcnt_hi_u32_b32 %0, -1, %0" : "=v"(le_));
            E(acc, cur, wr, wc, le_ & 15, le_ >> 4); S.done(cur); }
        if (!has_next) break;
        if (!E.keep(cur)) {
#pragma unroll
        for (int a = 0; a < 2; ++a)
#pragma unroll
            for (int b = 0; b < 2; ++b)
#pragma unroll
                for (int m = 0; m < 4; ++m)
#pragma unroll
                    for (int n = 0; n < 2; ++n) acc[a][b][m][n] = (f32x4){0.f, 0.f, 0.f, 0.f};
        }
        cur = nxt; cA = nA; cB = nB; ++ui;
        if constexpr (ALIGN_EPI) { if (wr == 1) PG8_BAR; }
    }
    PG8_WAIT_V(0);
    if constexpr (!ALIGN_EPI) { if (wr == 0) PG8_BAR; }
    PG8_BAR;
    if constexpr (Epi::AFTER_DRAIN) { E.fused(acc, cur, wr, wc, fr, fq, lds, wid, lane); S.done(cur); }
#undef PG8_SA
#undef PG8_SB
#undef PG8_STAGE
#undef PG8_UPTR
#undef PG8_LDA
#undef PG8_LDB
#undef PG8_MMA
#undef PG8_LD32
#undef PG8_WAIT_V
#undef PG8_WAIT_L
#undef PG8_BAR
#undef PG8_SCHED
}
}
namespace attn_body {
using bf16=__hip_bfloat16;
using f32x16=__attribute__((ext_vector_type(16)))float;
using f32x4_t=__attribute__((ext_vector_type(4)))float;
using u32x4=__attribute__((ext_vector_type(4)))unsigned;
using v2i=__attribute__((ext_vector_type(2)))int; using v4i=__attribute__((ext_vector_type(4)))int; using v8i=__attribute__((ext_vector_type(8)))int;
constexpr int D=64,PKV=768,PO=1536;
constexpr int PKVB=PKV*2;
#define MF8(a,b,c) __builtin_amdgcn_mfma_scale_f32_32x32x64_f8f6f4((a),(b),(c),0,0,0,0,0,0)
#define MF8A(D,A,B,C) asm volatile("v_mfma_f32_32x32x64_f8f6f4 %0, %1, %2, %3":"=&v"(D):"v"(A),"v"(B),"v"(C))
constexpr int NW=8,QBLK=32,QB=QBLK*NW,KVBLK=64;
constexpr int ATTN_UNIT_ROWS=QB;
__device__ __forceinline__ int crow(int r,int hi){return (r&3)+8*(r>>2)+4*hi;}
#define SBAR() __builtin_amdgcn_sched_barrier(0)
constexpr int NSLOT=3, SLOTB=4096;
constexpr int LDS_K=0, LDS_V=NSLOT*SLOTB, LDS_WS=2*NSLOT*SLOTB, LDS_OST=LDS_WS+NW*64*4, LDS_BYTES=LDS_OST+NW*4096;
constexpr float C2=8.0f*0.125f*1.4426950408889634f;
__device__ __forceinline__ void glds16s(const void*sbase,unsigned voff,unsigned lds_dst){unsigned keep;
  asm volatile("s_mov_b32 %0, m0\n\ts_mov_b32 m0, %3\n\ts_nop 0\n\tglobal_load_lds_dwordx4 %1, %2\n\ts_mov_b32 m0, %0":"=&s"(keep):"v"(voff),"s"(sbase),"s"(lds_dst):"memory");}
__device__ __forceinline__ void glds16m(const void*sbase,unsigned voff,unsigned lds_dst){
  asm volatile("s_mov_b32 m0, %2\n\ts_nop 0\n\tglobal_load_lds_dwordx4 %0, %1"::"v"(voff),"s"(sbase),"s"(lds_dst):"memory","m0");}
__device__ __forceinline__ const char* uptr(const void*p){ const unsigned long long u=(unsigned long long)p; return (const char*)(((unsigned long long)(unsigned)__builtin_amdgcn_readfirstlane((int)(unsigned)(u>>32))<<32)|(unsigned long long)(unsigned)__builtin_amdgcn_readfirstlane((int)(unsigned)u)); }
#define WAIT_BAR(N) asm volatile("s_waitcnt vmcnt(" #N ") lgkmcnt(0)\n\ts_barrier":::"memory")
typedef __attribute__((address_space(3))) const char* lds_cptr;
typedef __attribute__((address_space(3))) const v4i* lds_v4p;
__device__ __forceinline__ void kload2(v8i*kf,lds_cptr kp,int j){ const v4i x=*(lds_v4p)(kp+j*512), y=*(lds_v4p)(kp+j*512+1024); kf[j]=__builtin_shufflevector(x,y,0,1,2,3,4,5,6,7); }
typedef __attribute__((address_space(3))) v2i* lds_v2p;
__device__ __forceinline__ v8i vload(lds_cptr vp){
  const v2i a=__builtin_amdgcn_ds_read_tr8_b64_v2i32((lds_v2p)(vp)),b=__builtin_amdgcn_ds_read_tr8_b64_v2i32((lds_v2p)(vp+1024)),c=__builtin_amdgcn_ds_read_tr8_b64_v2i32((lds_v2p)(vp+2048)),d=__builtin_amdgcn_ds_read_tr8_b64_v2i32((lds_v2p)(vp+3072));
  return (v8i){a[0],a[1],b[0],b[1],c[0],c[1],d[0],d[1]}; }
__device__ __forceinline__ int pk8(int old,float a,float b,float c,float d){ unsigned p=__builtin_amdgcn_cvt_pk_u8_f32(a,0u,(unsigned)old); p=__builtin_amdgcn_cvt_pk_u8_f32(b,1u,p); p=__builtin_amdgcn_cvt_pk_u8_f32(c,2u,p); return (int)__builtin_amdgcn_cvt_pk_u8_f32(d,3u,p); }

#ifndef ATTN_STORE16
#define ATTN_STORE16(p,v) (*(u32x4*)(p)=(v))
#endif
__device__ __forceinline__ void attn_unit(const unsigned char*Qw0,const unsigned char*__restrict__ Kh,const unsigned char*__restrict__ Vh,bf16*Ow0,const int NT,char*shm){
  int tid_=threadIdx.x; asm volatile("":"+v"(tid_)); const int tid=tid_,lane=tid&63,r32=lane&31,hi=lane>>5; const int wid=__builtin_amdgcn_readfirstlane(tid>>6);
  const unsigned char*Qw=Qw0+(long)(wid*QBLK)*PKVB; const bool kw=wid<4;
  const unsigned lds0=(unsigned)(uintptr_t)shm;
  float*wsf=(float*)(shm+LDS_WS)+wid*64;
  const char*kvbase=kw?uptr(Kh+wid*16):uptr(Vh+(long)(16*(wid&3))*PKVB);
  const unsigned kvoff=kw?(unsigned)(lane*PKVB):(unsigned)((lane>>2)*PKVB+(((lane&3)^(2*((lane>>5)&1)))*16));
  const unsigned kvdst=lds0+(kw?LDS_K:LDS_V)+(wid&3)*1024;
  #define DMA_KV(t,slot) glds16s(kvbase+(long)(t)*(KVBLK*PKVB),kvoff,(unsigned)__builtin_amdgcn_readfirstlane(kvdst+(slot)))
  v8i kf[2];
  const lds_cptr shm3=(lds_cptr)shm; const lds_cptr kp0=shm3+LDS_K+hi*2048+r32*16;
  const int vr_=(lane&15)>>1; const lds_cptr vp0=shm3+LDS_V+((vr_&3)+8*(vr_>>2)+4*hi)*64+((2*((vr_>>2)&1)+((lane>>4)&1))*16)+8*(lane&1);
  const lds_cptr vp1=shm3+LDS_V+((vr_&3)+8*(vr_>>2)+4*hi)*64+(((2*((vr_>>2)&1)+((lane>>4)&1))*16)^32)+8*(lane&1);
  if(kw){DMA_KV(0,0);DMA_KV(1,SLOTB);}else{DMA_KV(0,0);}
  v8i qr; { const v4i q0=*reinterpret_cast<const v4i*>(Qw+(long)r32*PKVB+hi*32), q1=*reinterpret_cast<const v4i*>(Qw+(long)r32*PKVB+hi*32+16); qr=__builtin_shufflevector(q0,q1,0,1,2,3,4,5,6,7); }
  constexpr float REF=3.0f; f32x16 o[2];o[0]=f32x16{};o[1]=f32x16{};
  f32x4_t osum4={0.f,0.f,0.f,0.f}; v8i msk8; { const int mv=((((lane>>4)&1)==0)==((lane&15)<8))?0x38383838:0; msk8=(v8i){mv,mv,mv,mv,mv,mv,mv,mv}; } asm volatile("":"+v"(msk8));
  f32x16 negm; _Pragma("unroll") for(int r=0;r<16;++r)negm[r]=56.0f-8.0f*REF; asm volatile("":"+v"(negm));
  f32x16 pA0,pA1,pB0,pB1;
  int sl_prev=0,sl_cur=0,sl_next=SLOTB;
  #define ROT() do{sl_prev=sl_cur;sl_cur=sl_next;sl_next=(sl_next==(NSLOT-1)*SLOTB)?0:sl_next+SLOTB;}while(0)
  if(kw){DMA_KV(2,2*SLOTB);}
  WAIT_BAR(3);
  { kload2(kf,kp0,0); kload2(kf,kp0,1); pA0=MF8(kf[0],qr,negm); pA1=MF8(kf[1],qr,negm); }
  WAIT_BAR(0);
  if(kw){DMA_KV(3,0);}else{DMA_KV(1,SLOTB);}
  ROT();
  kload2(kf,kp0+sl_cur,0); kload2(kf,kp0+sl_cur,1);
  WAIT_BAR(1);
  v8i vb8[2], p8={0,0,0,0,0,0,0,0};
  #define PIN(x) asm volatile("":"+v"(x))
  #define EX(v) __builtin_amdgcn_exp2f(v)
  #define EX8(X,B) do{ X[B]=EX(X[B]); X[B+1]=EX(X[B+1]); X[B+2]=EX(X[B+2]); X[B+3]=EX(X[B+3]); X[B+4]=EX(X[B+4]); X[B+5]=EX(X[B+5]); X[B+6]=EX(X[B+6]); X[B+7]=EX(X[B+7]); }while(0)
  #define KRD(G,SLN,j) do{ if(G){ kload2(kf,kp0+(SLN),j); SBAR(); } }while(0)
  const int dt_=kw?3:1; const char*dptr=kvbase+(long)(1+dt_)*(KVBLK*PKVB); unsigned dslot=(unsigned)(((1+dt_)%3)*SLOTB);
  const unsigned dq0=(unsigned)__builtin_amdgcn_readfirstlane(kvdst+((1+dt_)%3)*SLOTB),dq1=(unsigned)__builtin_amdgcn_readfirstlane(kvdst+((2+dt_)%3)*SLOTB),dq2=(unsigned)__builtin_amdgcn_readfirstlane(kvdst+((3+dt_)%3)*SLOTB);
  #define DMA_NEXT(dst) do{ glds16m(dptr,kvoff,(dst)); dptr+=KVBLK*PKVB; }while(0)
  #define DMA_RT(cond) do{ if(cond){ glds16m(dptr,kvoff,(unsigned)__builtin_amdgcn_readfirstlane(kvdst+dslot)); } dptr+=KVBLK*PKVB; dslot=(dslot==(NSLOT-1)*SLOTB)?0u:dslot+SLOTB; }while(0)
  #define STEP(C0,C1,P0,P1,SLP,SLN,DMASTMT,GL) do{ SBAR(); \
    vb8[0]=vload(vp0+(SLP)); vb8[1]=vload(vp1+(SLP)); SBAR(); \
    MF8A(C0,kf[0],qr,negm); PIN(P0); \
    p8[0]=pk8(p8[0],P0[0],P0[1],P0[2],P0[3]); p8[1]=pk8(p8[1],P0[4],P0[5],P0[6],P0[7]); p8[2]=pk8(p8[2],P0[8],P0[9],P0[10],P0[11]); p8[3]=pk8(p8[3],P0[12],P0[13],P0[14],P0[15]); SBAR(); \
    MF8A(C1,kf[1],qr,negm); PIN(P1); \
    p8[4]=pk8(p8[4],P1[0],P1[1],P1[2],P1[3]); p8[5]=pk8(p8[5],P1[4],P1[5],P1[6],P1[7]); p8[6]=pk8(p8[6],P1[8],P1[9],P1[10],P1[11]); p8[7]=pk8(p8[7],P1[12],P1[13],P1[14],P1[15]); PIN(p8); SBAR(); \
    DMASTMT; \
    SBAR(); \
    o[0]=MF8(p8,vb8[0],o[0]); SBAR(); \
    KRD(GL,SLN,0); o[1]=MF8(p8,vb8[1],o[1]); SBAR(); \
    KRD(GL,SLN,1); osum4=__builtin_amdgcn_mfma_scale_f32_16x16x128_f8f6f4(p8,msk8,osum4,0,0,0,0,0,0); SBAR(); \
    }while(0)
  int t=1;
  for(;t+9<NT;t+=6){
    STEP(pB0,pB1,pA0,pA1,0,2*SLOTB,DMA_NEXT(dq0),true);       WAIT_BAR(1);
    STEP(pA0,pA1,pB0,pB1,SLOTB,0,DMA_NEXT(dq1),true);         WAIT_BAR(1);
    STEP(pB0,pB1,pA0,pA1,2*SLOTB,SLOTB,DMA_NEXT(dq2),true);   WAIT_BAR(1);
    STEP(pA0,pA1,pB0,pB1,0,2*SLOTB,DMA_NEXT(dq0),true);       WAIT_BAR(1);
    STEP(pB0,pB1,pA0,pA1,SLOTB,0,DMA_NEXT(dq1),true);         WAIT_BAR(1);
    STEP(pA0,pA1,pB0,pB1,2*SLOTB,SLOTB,DMA_NEXT(dq2),true);   WAIT_BAR(1);
  }
  for(;t+5<NT;t+=2){
    STEP(pB0,pB1,pA0,pA1,sl_prev,sl_next,DMA_RT(true),true);   WAIT_BAR(1); ROT();
    STEP(pA0,pA1,pB0,pB1,sl_prev,sl_next,DMA_RT(true),true);   WAIT_BAR(1); ROT();
  }
  #define ENDW(tt) do{ if((tt)+3<NT){WAIT_BAR(1);} else {WAIT_BAR(0);} }while(0)
  for(;t+1<NT;t+=2){
    STEP(pB0,pB1,pA0,pA1,sl_prev,sl_next,DMA_RT(t+dt_<NT),(t+1<NT));       ENDW(t);   ROT();
    STEP(pA0,pA1,pB0,pB1,sl_prev,sl_next,DMA_RT(t+1+dt_<NT),(t+2<NT));     ENDW(t+1); ROT();
  }
  STEP(pB0,pB1,pA0,pA1,sl_prev,sl_next,(void)0,false);
  { p8[0]=pk8(p8[0],pB0[0],pB0[1],pB0[2],pB0[3]); p8[1]=pk8(p8[1],pB0[4],pB0[5],pB0[6],pB0[7]); p8[2]=pk8(p8[2],pB0[8],pB0[9],pB0[10],pB0[11]); p8[3]=pk8(p8[3],pB0[12],pB0[13],pB0[14],pB0[15]);
    p8[4]=pk8(p8[4],pB1[0],pB1[1],pB1[2],pB1[3]); p8[5]=pk8(p8[5],pB1[4],pB1[5],pB1[6],pB1[7]); p8[6]=pk8(p8[6],pB1[8],pB1[9],pB1[10],pB1[11]); p8[7]=pk8(p8[7],pB1[12],pB1[13],pB1[14],pB1[15]);
    vb8[0]=vload(vp0+sl_cur); vb8[1]=vload(vp1+sl_cur);
    o[0]=MF8(p8,vb8[0],o[0]); o[1]=MF8(p8,vb8[1],o[1]); osum4=__builtin_amdgcn_mfma_scale_f32_16x16x128_f8f6f4(p8,msk8,osum4,0,0,0,0,0,0); }
  #undef PIN
  #undef EX
  #undef EX8
  #undef KRD
  #undef STEP
  #undef ENDW
  if((lane&7)==0){ float*wq=wsf+32+16*((lane>>3)&1)+4*(lane>>4); wq[0]=osum4[0];wq[1]=osum4[1];wq[2]=osum4[2];wq[3]=osum4[3]; } asm volatile("s_waitcnt lgkmcnt(0)":::"memory");
  float rli[16];
  #pragma unroll
  for(int r=0;r<16;++r)rli[r]=__builtin_amdgcn_rcpf(wsf[32+crow(r,hi)]);
  bf16*Ow=Ow0+(long)(wid*QBLK)*PO;
  { bf16*stg=(bf16*)(shm+LDS_OST)+wid*2048;
    #pragma unroll
    for(int r=0;r<16;++r){const int orow=crow(r,hi);
      #pragma unroll
      for(int d0=0;d0<2;++d0)stg[orow*64+d0*32+r32]=__float2bfloat16(o[d0][r]*rli[r]);}
    asm volatile("s_waitcnt lgkmcnt(0)":::"memory");
    #pragma unroll
    for(int i=0;i<4;++i){const int row=i*8+(lane>>3),ch=lane&7; const u32x4 v=*(const u32x4*)(stg+row*64+ch*8); ATTN_STORE16(Ow+(long)row*PO+ch*8,v);} }
  asm volatile("s_waitcnt lgkmcnt(0)\n\ts_barrier":::"memory");
  #undef DMA_KV
  #undef DMA_NEXT
  #undef DMA_RT
  #undef ROT
}
constexpr int ATTN_LDS_BYTES=LDS_BYTES;
#undef SBAR
#undef WAIT_BAR
}
#define GAS __attribute__((address_space(1)))
#define LAS __attribute__((address_space(3)))
typedef unsigned short bf16;
typedef unsigned v4u __attribute__((ext_vector_type(4)));
typedef float f32x4 __attribute__((ext_vector_type(4)));
typedef short bf16x8 __attribute__((ext_vector_type(8)));
typedef GAS unsigned gu32;
typedef GAS unsigned long long gu64;
#define RLX_AGENT __ATOMIC_RELAXED, __HIP_MEMORY_SCOPE_AGENT
#define LDS_WAIT() asm volatile("s_waitcnt lgkmcnt(0)" ::: "memory")
#define VM_WAIT() asm volatile("s_waitcnt vmcnt(0)" ::: "memory")
__device__ __forceinline__ unsigned long long rt() { return __builtin_amdgcn_s_memrealtime(); }
__device__ __forceinline__ unsigned f2bf(float f) { unsigned u = __builtin_bit_cast(unsigned, f); return (u + 0x7fffu + ((u >> 16) & 1u)) >> 16; }
__device__ __forceinline__ unsigned pk2(float lo, float hi) { return f2bf(lo) | (f2bf(hi) << 16); }
#define XB_TMO      128
#define XB_XCNT(j)  (256  + 64 * (j))
#define XB_XSUB(j)  (1280 + 64 * (j))
#define XB_XGEN(j)  (2304 + 64 * (j))
#define XB_TOP      3328
#define XB_TOPGEN   3392
#define XCD_BAR_WORDS 3456
#define XB_SPIN_CAP (1u << 18)

__device__ __forceinline__ unsigned xb_ld(unsigned* p)              { return __hip_atomic_load(p, __ATOMIC_RELAXED, __HIP_MEMORY_SCOPE_AGENT); }
__device__ __forceinline__ unsigned xb_add(unsigned* p, unsigned v) { return __hip_atomic_fetch_add(p, v, __ATOMIC_RELAXED, __HIP_MEMORY_SCOPE_AGENT); }
__device__ __forceinline__ unsigned xb_xcc_id() { return (unsigned)__builtin_amdgcn_s_getreg((3 << 11) | 20) & 0xFu; }
#define XB_SPIN(cond, bar) do { unsigned _sp = 0; while (cond) { __builtin_amdgcn_s_sleep(1); \
    if ((++_sp & 255u) == 0u) { if (xb_ld(&(bar)[XB_TMO])) break; if (_sp > XB_SPIN_CAP) { atomicAdd(&(bar)[XB_TMO], 1u); break; } } } } while (0)

struct XcdBarrier {
    unsigned* bar; unsigned x;
    volatile LAS unsigned* st;
};

__device__ __forceinline__ XcdBarrier xcd_barrier_post(unsigned* bar, volatile LAS unsigned* st) {
    XcdBarrier b; b.bar = bar; b.x = xb_xcc_id(); b.st = st;
    if (threadIdx.x == 0) (void)xb_add(&bar[XB_XCNT(b.x)], 1u);
    return b;
}
__device__ __forceinline__ void xcd_barrier_complete(unsigned* bar, unsigned x, unsigned& nloc, unsigned& nx) {
    const unsigned G = gridDim.x * gridDim.y * gridDim.z;
    unsigned sum, cnt, mine, sp = 0u;
    for (;;) {
        sum = 0u; cnt = 0u; mine = 0u;
#pragma unroll
        for (unsigned j = 0; j < 16; ++j) { const unsigned c = xb_ld(&bar[XB_XCNT(j)]); sum += c; cnt += (c > 0u) ? 1u : 0u; mine = (j == x) ? c : mine; }
        if (sum == G) break;
        __builtin_amdgcn_s_sleep(1);
        if ((++sp & 255u) == 0u) { if (xb_ld(&bar[XB_TMO])) break; if (sp > XB_SPIN_CAP) { atomicAdd(&bar[XB_TMO], 1u); break; } }
    }
    nloc = mine > 0u ? mine : 1u; nx = cnt > 0u ? cnt : 1u;
}

__device__ __forceinline__ void xcd_barrier(const XcdBarrier& b) {
    asm volatile("s_waitcnt vmcnt(0)" ::: "memory");
    __syncthreads();
    if (threadIdx.x == 0) {
        unsigned* bar = b.bar;
        __builtin_amdgcn_s_waitcnt(0);
        unsigned nloc = b.st[0], nx = b.st[1];
        if (nloc == 0u) { xcd_barrier_complete(bar, b.x, nloc, nx); b.st[0] = nloc; b.st[1] = nx; }
        const unsigned old = xb_add(&bar[XB_XSUB(b.x)], 1u);
        const unsigned gen = old / nloc;
        if (old + 1u == (gen + 1u) * nloc) {
            __builtin_amdgcn_fence(__ATOMIC_RELEASE, "agent");
            asm volatile("s_waitcnt vmcnt(0)" ::: "memory");
            const unsigned og = xb_add(&bar[XB_TOP], 1u);
            const unsigned tg = og / nx;
            if (og + 1u == (tg + 1u) * nx) xb_add(&bar[XB_TOPGEN], 1u);
            else XB_SPIN(xb_ld(&bar[XB_TOPGEN]) == tg, bar);
            __builtin_amdgcn_fence(__ATOMIC_ACQUIRE, "agent");
            xb_add(&bar[XB_XGEN(b.x)], 1u);
            asm volatile("s_waitcnt vmcnt(0)" ::: "memory");
        } else {
            XB_SPIN(xb_ld(&bar[XB_XGEN(b.x)]) == gen, bar);
            __builtin_amdgcn_fence(__ATOMIC_ACQUIRE, "agent");
            asm volatile("s_waitcnt vmcnt(0)" ::: "memory");
        }
    }
    __syncthreads();
}
constexpr int NWAVES = 8;
constexpr int D = 1024, NB = 2, SEQ = 16384, CTX = 256, SPB = SEQ + CTX  , MT = NB * SPB  , DEPTH = 2;
constexpr int NWIN = 7936, N1 = 4864, NGATE = 3072, NE = 16, DFF = 1024;
constexpr int PMAX_TILES = 276, PMAX = PMAX_TILES * 256;
constexpr float EPS = 1e-6f;
constexpr float C2 = 0.125f * 1.4426950408889634f;
constexpr size_t MiB = 1u << 20;
constexpr size_t WS_CTL = 0, CTL_ZERO_BYTES = 32 * 1024;
constexpr size_t WS_MOD = 1 * MiB;
constexpr size_t WS_SMALL = 2 * MiB;
constexpr size_t WS_HCTX = 8 * MiB;
constexpr size_t WS_HGU = 10 * MiB, WS_HGS = 26 * MiB;
constexpr size_t WS_WIN = 42 * MiB;
constexpr size_t WS_WABC = 73 * MiB;
constexpr size_t WS_WO = 79 * MiB;
constexpr size_t WS_WEXP = 83 * MiB;
constexpr size_t WS_WG8 = WS_WEXP + 48 * MiB;
constexpr size_t WS_U8 = WS_WEXP + 56 * MiB;
constexpr size_t WS_U = 179 * MiB;
constexpr size_t WS_PA = 244 * MiB;
constexpr size_t WS_PB = 309 * MiB;
constexpr size_t WS_PC = WS_PB + (size_t)MT * 2560 * 2;
constexpr size_t WS_YCAT = WS_PC + (size_t)MT * 768 * 2;
constexpr size_t WS_END = WS_YCAT + (size_t)MT * 1536 * 2;
constexpr size_t WS_DELTA = WS_YCAT;
constexpr size_t WS_GATES = WS_PA;
constexpr size_t WS_XS = WS_PA;
constexpr size_t WS_HID = WS_XS + (size_t)PMAX * 1024;
constexpr size_t WS_YS = WS_HID + (size_t)PMAX * 1024;
constexpr size_t WS_OBUF = WS_PA;
static_assert(WS_GATES + (size_t)MT * 3072 * 2 <= WS_PC, "gates overlay");
static_assert(WS_WG8 + (size_t)DEPTH * 3072 * 1024 <= WS_U8 && WS_U8 + (size_t)MT * 1024 <= WS_U, "fp8 gate weights / activations in the freed expert space");
static_assert(WS_YS + (size_t)PMAX * 1024 * 2 <= WS_YCAT, "expert buffers overlay PA..PC");
constexpr size_t SM_RE = 0, SM_RW = 512 * 1024, SM_RP = 1024 * 1024, SM_BCNT = 1536 * 1024, SM_TAB = 1600 * 1024, SM_ROPE = 1664 * 1024, SM_HLD = 1792 * 1024;
constexpr int CW_BAR = 4096;
static_assert((CW_BAR + 3456) * 4 <= (int)CTL_ZERO_BYTES, "barrier words inside the per-call memset");
constexpr int RING_BYTES = 131072, LDS_BYTES = 147456, LDSCTL_OFF = LDS_BYTES - 1024, MISC_OFF = LDSCTL_OFF + 320;

typedef unsigned u32x2v __attribute__((ext_vector_type(2)));
template <int CTRL> __device__ __forceinline__ float dppf(float v) { return __int_as_float(__builtin_amdgcn_mov_dpp(__float_as_int(v), CTRL, 0xf, 0xf, true)); }
__device__ __forceinline__ float quad_sum(float v) { v += dppf<0xB1>(v); v += dppf<0x4E>(v); return v; }
__device__ __forceinline__ float row_sum16(float v) { v = quad_sum(v); v += dppf<0x124>(v); v += dppf<0x128>(v); return v; }
__device__ __forceinline__ float wave_sum(float v) {
    v = row_sum16(v);
    return (__int_as_float(__builtin_amdgcn_readlane(__float_as_int(v), 0)) + __int_as_float(__builtin_amdgcn_readlane(__float_as_int(v), 16)))
         + (__int_as_float(__builtin_amdgcn_readlane(__float_as_int(v), 32)) + __int_as_float(__builtin_amdgcn_readlane(__float_as_int(v), 48)));
}
__device__ __forceinline__ float bf2f(bf16 h) { return __uint_as_float((unsigned)h << 16); }
__device__ __forceinline__ float sigm_acc(float x) { return 1.0f / (1.0f + __expf(-x)); }
__device__ __forceinline__ const float* hrow(const float* lat, const float* ctx, int r) { const int b = r >= SPB ? 1 : 0, s = r - b * SPB; return s < CTX ? ctx + (size_t)(b * CTX + s) * D : lat + (size_t)(b * SEQ + s - CTX) * D; }
__device__ __forceinline__ int mod_idx(int r) { const int b = r >= SPB ? 1 : 0, s = r - b * SPB; return s < CTX ? 2 : b; }
__device__ __forceinline__ void load_row(const float* p, int lane, f32x4 (&v)[4]) {
#pragma unroll
    for (int j = 0; j < 4; ++j) v[j] = *(const f32x4*)(p + 4 * lane + 256 * j);
}
__device__ __forceinline__ void add_row_bf16(const bf16* p, int lane, f32x4 (&v)[4]) {
#pragma unroll
    for (int j = 0; j < 4; ++j) { const u32x2v w = *(const u32x2v*)(p + 4 * lane + 256 * j); v[j] += (f32x4){__uint_as_float(w.x << 16), __uint_as_float(w.x & 0xffff0000u), __uint_as_float(w.y << 16), __uint_as_float(w.y & 0xffff0000u)}; }
}
__device__ __forceinline__ void load_h1(const float* outp, const float* hctx, int r, int lane, f32x4 (&v)[4]) {
    const int b = r >= SPB ? 1 : 0, s = r - b * SPB;
    if (s < CTX) { load_row(hctx + (size_t)(b * CTX + s) * D, lane, v); return; }
    const bf16* p = (const bf16*)(outp + (size_t)(b * SEQ + s - CTX) * D) + D;
#pragma unroll
    for (int j = 0; j < 4; ++j) { const u32x2v w = *(const u32x2v*)(p + 4 * lane + 256 * j); v[j] = (f32x4){__uint_as_float(w.x << 16), __uint_as_float(w.x & 0xffff0000u), __uint_as_float(w.y << 16), __uint_as_float(w.y & 0xffff0000u)}; }
}
__device__ __forceinline__ float row_rstd(const f32x4 (&v)[4]) {
    float s = 0.f;
#pragma unroll
    for (int j = 0; j < 4; ++j) s += (v[j][0] * v[j][0] + v[j][1] * v[j][1]) + (v[j][2] * v[j][2] + v[j][3] * v[j][3]);
    return 1.0f / sqrtf(wave_sum(s) * (1.0f / D) + EPS);
}
__device__ __forceinline__ void norm_mod(const f32x4 (&v)[4], const float* gain, const float* sc, const float* sh, int lane, f32x4 (&y)[4]) {
    const float rstd = row_rstd(v);
#pragma unroll
    for (int j = 0; j < 4; ++j) { const int i = 4 * lane + 256 * j; const f32x4 g = *(const f32x4*)(gain + i), c = *(const f32x4*)(sc + i), h = *(const f32x4*)(sh + i);
        y[j] = v[j] * rstd * g * (1.0f + c) + h; }
}
__device__ __forceinline__ void store_row_bf16(bf16* p, int lane, const f32x4 (&y)[4]) {
#pragma unroll
    for (int j = 0; j < 4; ++j) { u32x2v w; w.x = pk2(y[j][0], y[j][1]); w.y = pk2(y[j][2], y[j][3]); *(u32x2v*)(p + 4 * lane + 256 * j) = w; }
}

__device__ __forceinline__ void store_row_fp8(unsigned char* p, int lane, const f32x4 (&y)[4]) {
#pragma unroll
    for (int j = 0; j < 4; ++j) *(unsigned*)(p + 4 * lane + 256 * j) = pg8::pk_fp8x4(y[j][0], y[j][1], y[j][2], y[j][3]);
}
__device__ __forceinline__ void qk_norm_rope(f32x4& a, f32x4& b2, const f32x4 ga, const f32x4 gb, const float* rp, const bool second, const float scale) {
    float ss = (a[0] * a[0] + a[1] * a[1]) + (a[2] * a[2] + a[3] * a[3]) + (b2[0] * b2[0] + b2[1] * b2[1]) + (b2[2] * b2[2] + b2[3] * b2[3]);
    ss = quad_sum(ss); { const float up = dppf<0x124>(ss), dn = dppf<0x12C>(ss); ss += (threadIdx.x & 4) ? up : dn; }
    const float rs = 1.0f / sqrtf(ss * (1.0f / 64.0f) + EPS);
    a = a * rs * ga; b2 = b2 * rs * gb;
    f32x4 pa, pb;
#pragma unroll
    for (int e = 0; e < 4; ++e) { pa[e] = dppf<0x4E>(a[e]); pb[e] = dppf<0x4E>(b2[e]); }
    if (rp) { const f32x4 t0 = *(const f32x4*)rp, t1 = *(const f32x4*)(rp + 4), t2 = *(const f32x4*)(rp + 8), t3 = *(const f32x4*)(rp + 12); const float sg = second ? 1.0f : -1.0f;
        a = (f32x4){a[0] * t0[0] + sg * pa[0] * t0[1], a[1] * t0[2] + sg * pa[1] * t0[3], a[2] * t1[0] + sg * pa[2] * t1[1], a[3] * t1[2] + sg * pa[3] * t1[3]};
        b2 = (f32x4){b2[0] * t2[0] + sg * pb[0] * t2[1], b2[1] * t2[2] + sg * pb[1] * t2[3], b2[2] * t3[0] + sg * pb[2] * t3[1], b2[3] * t3[2] + sg * pb[3] * t3[3]}; }
    a = a * scale; b2 = b2 * scale;
}

template <bool FP8OUT = false> __device__ __forceinline__ void transpose_item(const float* W, int pitch, bf16* WT, int K, int drow0, int k0, int n0, LAS float* scr, int lane) {
    const int rr = lane >> 3, c4 = (lane & 7) * 4;
    f32x4 t[8];
#pragma unroll
    for (int i = 0; i < 8; ++i) t[i] = *(const f32x4*)(W + (size_t)(k0 + 8 * i + rr) * pitch + n0 + c4);
#pragma unroll
    for (int i = 0; i < 8; ++i) { LAS float* d = scr + (8 * i + rr) * 33 + c4; d[0] = t[i][0]; d[1] = t[i][1]; d[2] = t[i][2]; d[3] = t[i][3]; }
    LDS_WAIT(); asm volatile("" ::: "memory");
    const int c = lane & 7;
#pragma unroll
    for (int j = 0; j < 4; ++j) { const int n = (lane >> 3) + 8 * j; const LAS float* s = scr + (8 * c) * 33 + n;
        if constexpr (FP8OUT) { u32x2v o; o.x = pg8::pk_fp8x4(s[0 * 33] * pg8::WSCALE8, s[1 * 33] * pg8::WSCALE8, s[2 * 33] * pg8::WSCALE8, s[3 * 33] * pg8::WSCALE8); o.y = pg8::pk_fp8x4(s[4 * 33] * pg8::WSCALE8, s[5 * 33] * pg8::WSCALE8, s[6 * 33] * pg8::WSCALE8, s[7 * 33] * pg8::WSCALE8);
            *(u32x2v*)((unsigned char*)WT + (size_t)(drow0 + n) * K + k0 + 8 * c) = o; }
        else { v4u o; o.x = pk2(s[0 * 33], s[1 * 33]); o.y = pk2(s[2 * 33], s[3 * 33]); o.z = pk2(s[4 * 33], s[5 * 33]); o.w = pk2(s[6 * 33], s[7 * 33]);
        *(v4u*)(WT + (size_t)(drow0 + n) * K + k0 + 8 * c) = o; } }
    LDS_WAIT(); asm volatile("" ::: "memory");
}
__device__ __forceinline__ int win_drow(int n0) {
    if (n0 < 512) return (n0 >> 7) * 256 + (n0 & 127);
    if (n0 < 1024) return 1024 + (n0 - 512);
    if (n0 < 1536) return ((n0 - 1024) >> 7) * 256 + 128 + (n0 & 127);
    return n0;
}
__device__ __forceinline__ void convert_experts(const float* wg, const float* wu, const float* wd, int layer, bf16* WE, LAS float* scr, int gw, int NGW, int lane) {
    const size_t lo = (size_t)layer * NE * D * DFF;
    unsigned char* GU = (unsigned char*)WE; unsigned char* DN = GU + (size_t)NE * 2048 * 1024;
    constexpr int IPM = 16 * 32;
    for (int it = gw; it < 3 * NE * IPM; it += NGW) {
        const int mat = it / IPM, r = it % IPM, kb = r / 32, nb = r % 32, e = mat % NE, kind = mat / NE, n0 = 32 * nb;
        if (kind == 0) transpose_item<true>(wg + lo + (size_t)e * D * DFF, DFF, (bf16*)(GU + (size_t)e * 2048 * 1024), 1024, (n0 >> 7) * 256 + (n0 & 127), 64 * kb, n0, scr, lane);
        else if (kind == 1) transpose_item<true>(wu + lo + (size_t)e * D * DFF, DFF, (bf16*)(GU + (size_t)e * 2048 * 1024), 1024, (n0 >> 7) * 256 + 128 + (n0 & 127), 64 * kb, n0, scr, lane);
        else transpose_item<true>(wd + lo + (size_t)e * DFF * D, D, (bf16*)(DN + (size_t)e * 1024 * 1024), 1024, n0, 64 * kb, n0, scr, lane);
    }
}

__device__ __forceinline__ void attn_naive(unsigned char* lds, const bf16* PC, bf16* YC, int vcu, int G, int tid) {
    float* Ks = (float*)lds; float* Vs = Ks + 64 * 64;
    for (int unit = vcu; unit < 528; unit += G) {
        int b, h, q0, nq, nkeys;
        if (unit < 512) { b = unit >> 8; h = (unit >> 5) & 7; q0 = CTX + (unit & 31) * 512; nq = 512; nkeys = SPB; }
        else { const int x = unit - 512; b = x >> 3; h = x & 7; q0 = 0; nq = 256; nkeys = CTX; }
        const int kvh = h >> 2;
        const int qi = tid < nq ? tid : nq - 1;
        const size_t row = (size_t)b * SPB + q0 + qi;
        float q[64], o[64];
#pragma unroll
        for (int d = 0; d < 64; d += 8) { f32x4 a, c; pg8::ld8(PC + row * 768 + h * 64 + d, a, c); q[d] = a[0]; q[d + 1] = a[1]; q[d + 2] = a[2]; q[d + 3] = a[3]; q[d + 4] = c[0]; q[d + 5] = c[1]; q[d + 6] = c[2]; q[d + 7] = c[3]; }
#pragma unroll
        for (int d = 0; d < 64; ++d) o[d] = 0.f;
        float mrun = -INFINITY, lrun = 0.f;
        for (int kt = 0; kt < nkeys; kt += 64) {
            __syncthreads();
            { const int key = tid >> 3, d0 = (tid & 7) * 8; const size_t kr = ((size_t)b * SPB + kt + key) * 768;
              f32x4 a, c; pg8::ld8(PC + kr + 512 + kvh * 64 + d0, a, c); *(f32x4*)(Ks + key * 64 + d0) = a; *(f32x4*)(Ks + key * 64 + d0 + 4) = c;
              pg8::ld8(PC + kr + 640 + kvh * 64 + d0, a, c); *(f32x4*)(Vs + key * 64 + d0) = a; *(f32x4*)(Vs + key * 64 + d0 + 4) = c; }
            __syncthreads();
#pragma unroll 1
            for (int j = 0; j < 64; ++j) { const float* kp = Ks + j * 64; const float* vp = Vs + j * 64; float a = 0.f;
#pragma unroll
                for (int d = 0; d < 64; d += 4) { const f32x4 kv = *(const f32x4*)(kp + d); a += q[d] * kv[0]; a += q[d + 1] * kv[1]; a += q[d + 2] * kv[2]; a += q[d + 3] * kv[3]; }
                if (a > mrun) { const float alpha = __builtin_amdgcn_exp2f(mrun - a); lrun *= alpha; mrun = a;
#pragma unroll
                    for (int d = 0; d < 64; ++d) o[d] *= alpha; }
                const float pj = __builtin_amdgcn_exp2f(a - mrun); lrun += pj;
#pragma unroll
                for (int d = 0; d < 64; d += 4) { const f32x4 vv = *(const f32x4*)(vp + d); o[d] += pj * vv[0]; o[d + 1] += pj * vv[1]; o[d + 2] += pj * vv[2]; o[d + 3] += pj * vv[3]; }
            }
        }
        if (tid < nq) { const float il = 1.0f / lrun; bf16* op = YC + row * 1536 + 1024 + h * 64;
#pragma unroll
            for (int d = 0; d < 64; d += 8) pg8::st8(op + d, (f32x4){o[d] * il, o[d + 1] * il, o[d + 2] * il, o[d + 3] * il}, (f32x4){o[d + 4] * il, o[d + 5] * il, o[d + 6] * il, o[d + 7] * il}); }
    }
    __syncthreads();
}

__device__ __forceinline__ void hgrn_naive(const bf16* PB, bf16* OB, const float* lbp, int layer, int gw, int NGW, int lane) {
    for (int wu = gw; wu < 2048; wu += NGW) {
        const int chain = wu >> 7, v = wu & 127, b = chain >> 3, hd = (chain >> 1) & 3, dir = chain & 1;
        float lb0 = 0.f, lb1 = 0.f;
        if (layer > 0) { const int c0 = dir * 512 + hd * 128 + lane; lb0 = sigm_acc(lbp[1024 + c0] - lbp[c0]); lb1 = sigm_acc(lbp[1024 + c0 + 64] - lbp[c0 + 64]); }
        float S0 = 0.f, S1 = 0.f;
        for (int tb = 0; tb < SPB; tb += 8) {
            float q0[8], q1[8], z0[8], z1[8], vv[8]; int rr[8];
#pragma unroll
            for (int i = 0; i < 8; ++i) { const int tau = tb + i; const int s = dir == 0 ? tau : (tau < CTX ? CTX - 1 - tau : SPB + CTX - 1 - tau); const int r = b * SPB + s; rr[i] = r;
                const bf16* p = PB + (size_t)r * 2560 + hd * 128;
                q0[i] = bf2f(p[lane]); q1[i] = bf2f(p[lane + 64]); z0[i] = bf2f(p[512 + dir * 512 + lane]); z1[i] = bf2f(p[512 + dir * 512 + lane + 64]); vv[i] = bf2f(p[1536 + v]); }
            float part[8];
#pragma unroll
            for (int i = 0; i < 8; ++i) {
                const float e0 = __expf(z0[i]), e1 = __expf(z1[i]);
                const float n0 = 1.0f / (1.0f + e0), n1 = 1.0f / (1.0f + e1);
                const float k0 = (1.0f - lb0) * n0, k1 = (1.0f - lb1) * n1, f0 = 1.0f - k0, f1 = 1.0f - k1;
                S0 = f0 * S0 + k0 * vv[i]; S1 = f1 * S1 + k1 * vv[i];
                part[i] = S0 * q0[i] + S1 * q1[i]; }
#pragma unroll
            for (int i = 0; i < 8; ++i) part[i] = wave_sum(part[i]);
            float mine = part[0]; int myr = rr[0];
#pragma unroll
            for (int i = 1; i < 8; ++i) if (lane == i) { mine = part[i]; myr = rr[i]; }
            if (lane < 8) OB[((size_t)dir * MT + myr) * 512 + hd * 128 + v] = (bf16)f2bf(mine);
        }
    }
}
namespace hg {
typedef short bf16x8 __attribute__((ext_vector_type(8)));
typedef float f32x4 __attribute__((ext_vector_type(4)));
constexpr int QS = 136, TS = 72;
constexpr int NSEG = 16, NCHUNK = SPB / 64;
constexpr int OFF_QT = 0, OFF_KT = OFF_QT + 64 * QS * 2, OFF_KTT = OFF_KT + 64 * QS * 2, OFF_VT = OFF_KTT + 128 * TS * 2, OFF_S0T = OFF_VT + 128 * TS * 2,
              OFF_AS = OFF_S0T + 128 * QS * 2, OFF_ER = OFF_AS + 64 * TS * 2, OFF_D2 = OFF_ER + 128 * 4, HG_LDS = OFF_D2 + 128 * 4;
static_assert(OFF_KT % 16 == 0 && OFF_KTT % 16 == 0 && OFF_VT % 16 == 0 && OFF_S0T % 16 == 0 && OFF_AS % 16 == 0 && OFF_ER % 16 == 0 && HG_LDS <= LDSCTL_OFF, "hgrn LDS map");
#define HG_MFMA(a, b, c) __builtin_amdgcn_mfma_f32_16x16x32_bf16((a), (b), (c), 0, 0, 0)
__device__ __forceinline__ int rowmap(int dir, int ci, int t) { return dir == 0 ? 64 * ci + t : (ci < 4 ? 255 - 64 * ci - t : 16895 - 64 * ci - t); }

__device__ __forceinline__ float scan32_mul(float v) {
    const int one = __float_as_int(1.0f);
    v *= __int_as_float(__builtin_amdgcn_update_dpp(one, __float_as_int(v), 0x111, 0xf, 0xf, false));
    v *= __int_as_float(__builtin_amdgcn_update_dpp(one, __float_as_int(v), 0x112, 0xf, 0xf, false));
    v *= __int_as_float(__builtin_amdgcn_update_dpp(one, __float_as_int(v), 0x114, 0xf, 0xf, false));
    v *= __int_as_float(__builtin_amdgcn_update_dpp(one, __float_as_int(v), 0x118, 0xf, 0xf, false));
    v *= __int_as_float(__builtin_amdgcn_update_dpp(one, __float_as_int(v), 0x142, 0xa, 0xf, false));
    return v;
}
__device__ __forceinline__ float bfx(const v4u& a, const v4u& b, int c) {
    const unsigned w = c < 8 ? (c < 4 ? (c < 2 ? a.x : a.y) : (c < 6 ? a.z : a.w)) : (c < 12 ? (c < 10 ? b.x : b.y) : (c < 14 ? b.z : b.w));
    return (c & 1) ? __uint_as_float(w & 0xffff0000u) : __uint_as_float(w << 16);
}
template <bool FULL> __device__ __forceinline__ void hgrn_seg(unsigned char* lds, const bf16* PB, bf16* OB, const float* lbp, float* HU, const float* HS, float* HLD,
                                                              const int layer, const int chain, const int seg, const int tid) {
    if (!FULL && seg == NSEG - 1) return;
    const int lane = tid & 63, wave = __builtin_amdgcn_readfirstlane(tid >> 6), fr = lane & 15, fq = lane >> 4;
    const int b = chain >> 3, hd = (chain >> 1) & 3, dir = chain & 1;
    const int c0 = (seg * NCHUNK) / NSEG, c1 = ((seg + 1) * NCHUNK) / NSEG;
    float oml[16];
#pragma unroll
    for (int c = 0; c < 16; ++c) { float lb = 0.f; if (layer > 0) { const int ch = dir * 512 + hd * 128 + 16 * wave + c; lb = sigm_acc(lbp[1024 + ch] - lbp[ch]); } oml[c] = 1.0f - lb; }
    bf16* QT = (bf16*)(lds + OFF_QT); bf16* KT = (bf16*)(lds + OFF_KT); bf16* KTT = (bf16*)(lds + OFF_KTT); bf16* VT = (bf16*)(lds + OFF_VT); bf16* S0T = (bf16*)(lds + OFF_S0T); bf16* AS = (bf16*)(lds + OFF_AS);
    float* ER = (float*)(lds + OFF_ER); float* D2 = (float*)(lds + OFF_D2);
    if (FULL) for (int i = tid; i < 64 * TS / 2; i += 512) ((unsigned*)AS)[i] = 0u;
    const bf16* pz = PB + (size_t)b * SPB * 2560 + hd * 128 + 16 * wave;
    const int vt_t = tid >> 3, vt_seg = tid & 7;
    const bf16* pv = PB + (size_t)b * SPB * 2560 + 1536 + hd * 128 + vt_seg * 16;
    f32x4 S[8];
#pragma unroll
    for (int vt = 0; vt < 8; ++vt) S[vt] = (f32x4){0.f, 0.f, 0.f, 0.f};
    if (FULL && seg > 0) { const float* sp = HS + ((size_t)(chain * NSEG + seg) * 128 + 16 * wave + 4 * fq) * 128 + fr;
#pragma unroll
        for (int vt = 0; vt < 8; ++vt)
#pragma unroll
            for (int i = 0; i < 4; ++i) S[vt][i] = sp[i * 128 + 16 * vt]; }
    float ldacc[16];
#pragma unroll
    for (int c = 0; c < 16; ++c) ldacc[c] = 0.f;
    v4u z0, z1, q0 = {0u, 0u, 0u, 0u}, q1 = q0, vraw0, vraw1;
    { const bf16* p = pz + (size_t)rowmap(dir, c0, lane) * 2560; z0 = *(const v4u*)(p + 512 + dir * 512); z1 = *(const v4u*)(p + 512 + dir * 512 + 8); if (FULL) { q0 = *(const v4u*)p; q1 = *(const v4u*)(p + 8); }
      const bf16* p2 = pv + (size_t)rowmap(dir, c0, vt_t) * 2560; vraw0 = *(const v4u*)p2; vraw1 = *(const v4u*)(p2 + 8); }
    for (int ci = c0; ci < c1; ++ci) {
        float kk[16], P[16];
#pragma unroll
        for (int c = 0; c < 16; ++c) { const float e = __expf(bfx(z0, z1, c)); const float kj = oml[c] * __builtin_amdgcn_rcpf(1.0f + e); kk[c] = kj; P[c] = 1.0f - kj; }
#pragma unroll
        for (int c = 0; c < 16; ++c) P[c] = scan32_mul(P[c]);
        unsigned qp[8], kp[8]; float Tv[16], Gv[16];
#pragma unroll
        for (int c = 0; c < 16; c += 2) { float qe[2], ke[2];
#pragma unroll
            for (int h = 0; h < 2; ++h) { const float Pc = P[c + h];
                const float T = fmaxf(__int_as_float(__builtin_amdgcn_readlane(__float_as_int(Pc), 31)), 1e-37f), Gl = __int_as_float(__builtin_amdgcn_readlane(__float_as_int(Pc), 63));
                Tv[c + h] = T; Gv[c + h] = Gl;
                const float inv = __builtin_amdgcn_rcpf(fmaxf(Pc, 1e-37f));
                const float eq = lane < 32 ? Pc * __builtin_amdgcn_rcpf(T) : Pc, ek = lane < 32 ? T * inv : inv;
                ke[h] = kk[c + h] * ek; qe[h] = FULL ? bfx(q0, q1, c + h) * eq : 0.f; }
            kp[c >> 1] = pg8::cvt_pk_bf16(ke[0], ke[1]); if (FULL) qp[c >> 1] = pg8::cvt_pk_bf16(qe[0], qe[1]); }
        if (!FULL) {
#pragma unroll
            for (int c = 0; c < 16; ++c) ldacc[c] += __logf(Tv[c]) + __logf(fmaxf(Gv[c], 1e-37f)); }
        const v4u vr0 = vraw0, vr1 = vraw1;
        { const int cn = ci + 1 < c1 ? ci + 1 : ci;
          const bf16* p = pz + (size_t)rowmap(dir, cn, lane) * 2560; z0 = *(const v4u*)(p + 512 + dir * 512); z1 = *(const v4u*)(p + 512 + dir * 512 + 8); if (FULL) { q0 = *(const v4u*)p; q1 = *(const v4u*)(p + 8); }
          const bf16* p2 = pv + (size_t)rowmap(dir, cn, vt_t) * 2560; vraw0 = *(const v4u*)p2; vraw1 = *(const v4u*)(p2 + 8); }
        __syncthreads();
        if (FULL) { *(v4u*)(QT + lane * QS + 16 * wave) = (v4u){qp[0], qp[1], qp[2], qp[3]}; *(v4u*)(QT + lane * QS + 16 * wave + 8) = (v4u){qp[4], qp[5], qp[6], qp[7]};
                    *(v4u*)(KT + lane * QS + 16 * wave) = (v4u){kp[0], kp[1], kp[2], kp[3]}; *(v4u*)(KT + lane * QS + 16 * wave + 8) = (v4u){kp[4], kp[5], kp[6], kp[7]}; }
#pragma unroll
        for (int c = 0; c < 16; c += 2) { KTT[(16 * wave + c) * TS + lane] = (bf16)(kp[c >> 1] & 0xffffu); KTT[(16 * wave + c + 1) * TS + lane] = (bf16)(kp[c >> 1] >> 16); }
        if (lane == 31) {
#pragma unroll
            for (int c = 0; c < 16; ++c) ER[16 * wave + c] = Tv[c]; }
        if (lane == 63) {
#pragma unroll
            for (int c = 0; c < 16; ++c) D2[16 * wave + c] = Gv[c]; }
        { bf16* vp = VT + (16 * vt_seg) * TS + 8 * ((vt_t >> 3) ^ vt_seg) + (vt_t & 7);
          vp[0 * TS] = (bf16)(vr0.x & 0xffffu); vp[1 * TS] = (bf16)(vr0.x >> 16); vp[2 * TS] = (bf16)(vr0.y & 0xffffu); vp[3 * TS] = (bf16)(vr0.y >> 16);
          vp[4 * TS] = (bf16)(vr0.z & 0xffffu); vp[5 * TS] = (bf16)(vr0.z >> 16); vp[6 * TS] = (bf16)(vr0.w & 0xffffu); vp[7 * TS] = (bf16)(vr0.w >> 16);
          vp[8 * TS] = (bf16)(vr1.x & 0xffffu); vp[9 * TS] = (bf16)(vr1.x >> 16); vp[10 * TS] = (bf16)(vr1.y & 0xffffu); vp[11 * TS] = (bf16)(vr1.y >> 16);
          vp[12 * TS] = (bf16)(vr1.z & 0xffffu); vp[13 * TS] = (bf16)(vr1.z >> 16); vp[14 * TS] = (bf16)(vr1.w & 0xffffu); vp[15 * TS] = (bf16)(vr1.w >> 16); }
        __syncthreads();
        float erv[4], d2v[4];
#pragma unroll
        for (int i = 0; i < 4; ++i) { erv[i] = ER[16 * wave + 4 * fq + i]; d2v[i] = D2[16 * wave + 4 * fq + i]; }
#pragma unroll
        for (int vt = 0; vt < 8; ++vt) { S[vt] = (f32x4){S[vt][0] * erv[0], S[vt][1] * erv[1], S[vt][2] * erv[2], S[vt][3] * erv[3]};
            if (FULL) { u32x2v w; w.x = pg8::cvt_pk_bf16(S[vt][0], S[vt][1]); w.y = pg8::cvt_pk_bf16(S[vt][2], S[vt][3]); *(u32x2v*)(S0T + (16 * vt + fr) * QS + 16 * wave + 4 * fq) = w; } }
        if (FULL) for (int ti = wave; ti < 10; ti += 8) { const int tb = ti >= 6 ? 3 : ti >= 3 ? 2 : ti >= 1 ? 1 : 0, sb = ti - (tb * (tb + 1)) / 2;
            f32x4 acc = {0.f, 0.f, 0.f, 0.f};
#pragma unroll
            for (int k4 = 0; k4 < 4; ++k4) { const bf16x8 a = *(const bf16x8*)(QT + (16 * tb + fr) * QS + 32 * k4 + 8 * fq), bb = *(const bf16x8*)(KT + (16 * sb + fr) * QS + 32 * k4 + 8 * fq); acc = HG_MFMA(a, bb, acc); }
#pragma unroll
            for (int i = 0; i < 4; ++i) { const int t = 16 * tb + 4 * fq + i, s = 16 * sb + fr; AS[t * TS + s] = (bf16)f2bf(s <= t ? acc[i] : 0.f); } }
        { const bf16x8 a0 = *(const bf16x8*)(KTT + (16 * wave + fr) * TS + 8 * fq), a1 = *(const bf16x8*)(KTT + (16 * wave + fr) * TS + 32 + 8 * fq);
#pragma unroll
          for (int vt = 0; vt < 8; ++vt) { const bf16* vrow = VT + (16 * vt + fr) * TS;
              f32x4 acc = HG_MFMA(a0, *(const bf16x8*)(vrow + 8 * (fq ^ vt)), S[vt]); acc = HG_MFMA(a1, *(const bf16x8*)(vrow + 8 * ((4 + fq) ^ vt)), acc);
              S[vt] = (f32x4){acc[0] * d2v[0], acc[1] * d2v[1], acc[2] * d2v[2], acc[3] * d2v[3]}; } }
        if (FULL) {
            __syncthreads();
            const int tb = wave & 3, v0t = (wave >> 2) * 4;
            bf16x8 aq[4], aa[2];
#pragma unroll
            for (int k4 = 0; k4 < 4; ++k4) aq[k4] = *(const bf16x8*)(QT + (16 * tb + fr) * QS + 32 * k4 + 8 * fq);
#pragma unroll
            for (int ks = 0; ks < 2; ++ks) aa[ks] = *(const bf16x8*)(AS + (16 * tb + fr) * TS + 32 * ks + 8 * fq);
            int orow[4];
#pragma unroll
            for (int i = 0; i < 4; ++i) orow[i] = b * SPB + rowmap(dir, ci, 16 * tb + 4 * fq + i);
#pragma unroll
            for (int vi = 0; vi < 4; ++vi) { const int vt = v0t + vi; f32x4 acc = {0.f, 0.f, 0.f, 0.f}; const bf16* srow = S0T + (16 * vt + fr) * QS + 8 * fq; const bf16* vrow = VT + (16 * vt + fr) * TS;
#pragma unroll
                for (int k4 = 0; k4 < 4; ++k4) acc = HG_MFMA(aq[k4], *(const bf16x8*)(srow + 32 * k4), acc);
                acc = HG_MFMA(aa[0], *(const bf16x8*)(vrow + 8 * (fq ^ vt)), acc); acc = HG_MFMA(aa[1], *(const bf16x8*)(vrow + 8 * ((4 + fq) ^ vt)), acc);
#pragma unroll
                for (int i = 0; i < 4; ++i) OB[((size_t)dir * MT + orow[i]) * 512 + hd * 128 + 16 * vt + fr] = (bf16)f2bf(acc[i]); }
        }
    }
    if (!FULL) { float* up = HU + ((size_t)(chain * NSEG + seg) * 128 + 16 * wave + 4 * fq) * 128 + fr;
#pragma unroll
        for (int vt = 0; vt < 8; ++vt)
#pragma unroll
            for (int i = 0; i < 4; ++i) up[i * 128 + 16 * vt] = S[vt][i];
        if (lane == 63) {
#pragma unroll
            for (int c = 0; c < 16; ++c) HLD[(chain * NSEG + seg) * 128 + 16 * wave + c] = ldacc[c]; } }
    __syncthreads();
}
__device__ __forceinline__ void hgrn_carry(const float* HU, float* HS, const float* HLD, const int vcu, const int G, const int tid) {
    for (int e = vcu * 512 + tid; e < 16 * 16384; e += G * 512) { const int chain = e >> 14, kv = e & 16383, k = kv >> 7; float s = 0.f;
        for (int g = 0; g + 1 < NSEG; ++g) { const size_t o = (size_t)(chain * NSEG + g) * 16384 + kv; s = __expf(HLD[(chain * NSEG + g) * 128 + k]) * s + HU[o]; HS[o + 16384] = s; } }
}
#undef HG_MFMA
}
constexpr int NPL = 13;
constexpr int NPHASE = 2 + DEPTH * NPL;
struct Args { const float* in[24]; float* out; unsigned char* ws; int ph_lo, ph_hi, li, pad; };
enum { I_X = 0, I_C, I_CTX, I_CCTX, I_WMOD, I_BMOD, I_N1G, I_N2G, I_WIN, I_CONVW, I_LBP, I_HNG, I_QNG, I_KNG, I_WA, I_WB, I_WC, I_WOUT, I_RW, I_RB, I_WG, I_WU, I_WD, I_FG };

typedef __attribute__((address_space(4))) const Args CArgs;
__device__ __forceinline__ const CArgs* kap() { const CArgs* p = (const CArgs*)__builtin_amdgcn_kernarg_segment_ptr(); asm volatile("" : "+s"(p)); return p; }
#define IN(k) (lo <= (k) && (k) < hi)
#define PHASE_VARS int tid_ = threadIdx.x; asm volatile("" : "+v"(tid_)); const int tid = tid_, lane = tid_ & 63; (void)tid; (void)lane; PHASE_PTRS
#define PHASE_PTRS const CArgs* A = kap(); unsigned char* ws = A->ws; (void)ws;
#define WSP(T, off) ((T*)(ws + (off)))
#define SEAM(k) do { if (IN(k) && IN((k) + 1)) xcd_barrier(bar); } while (0)
template <int LAYER> __device__ __forceinline__ void layer_phases(const int lo, const int hi, const XcdBarrier& bar, unsigned char* lds) {
    constexpr int layer = LAYER;
    LAS unsigned char* ldsl = (LAS unsigned char*)lds;
    const int wave = __builtin_amdgcn_readfirstlane((int)threadIdx.x >> 6);
    const int G = gridDim.x; const int bx = blockIdx.x; const int vcu = (G % 8 == 0) ? (bx % 8) * (G / 8) + bx / 8 : bx;
    const int gw = vcu * NWAVES + wave, NGW = G * NWAVES;
    LAS float* scr = (LAS float*)(ldsl + wave * 16384); (void)scr;
        const int pb = 2 + layer * NPL;
        if (IN(pb + 0)) { PHASE_PTRS
            pg8::Gemm g{WSP(bf16, WS_U), WSP(bf16, WS_WIN) + (size_t)layer * NWIN * D, MT, N1, D, D}; pg8::StaticOrder S; S.init(MT, N1, G, bx);
            pg8::EpiW1 E{WSP(bf16, WS_PA), WSP(bf16, WS_PB), WSP(bf16, WS_PC)};
            pg8::gemm_phase<pg8::EpiW1, pg8::StaticOrder, true, true>(ldsl, g, S, E);
        }
        SEAM(pb + 0);
        if (IN(pb + 1)) { PHASE_VARS
            const float* cw = A->in[I_CONVW] + layer * 3 * 512; const float* qg = A->in[I_QNG] + layer * 64; const float* kg = A->in[I_KNG] + layer * 64;
            const bf16* PAp = WSP(bf16, WS_PA); bf16* YCp = WSP(bf16, WS_YCAT); bf16* PCp = WSP(bf16, WS_PC); const float* ropet = WSP(float, WS_SMALL + SM_ROPE);
            const f32x4 w0a = *(const f32x4*)(cw + 8 * lane), w0b = *(const f32x4*)(cw + 8 * lane + 4), w1a = *(const f32x4*)(cw + 512 + 8 * lane), w1b = *(const f32x4*)(cw + 512 + 8 * lane + 4),
                        w2a = *(const f32x4*)(cw + 1024 + 8 * lane), w2b = *(const f32x4*)(cw + 1024 + 8 * lane + 4);
            const int c8 = lane & 7;
            const f32x4 qga = *(const f32x4*)(qg + 8 * c8), qgb = *(const f32x4*)(qg + 8 * c8 + 4), kga = *(const f32x4*)(kg + 8 * c8), kgb = *(const f32x4*)(kg + 8 * c8 + 4);
            for (int r0 = gw * 2; r0 < MT; r0 += NGW * 2) {
                f32x4 x0a[2], x0b[2], xma[2], xmb[2], xpa[2], xpb[2], aba[2], abb[2], qa[2], qb[2], ka[2], kb[2];
#pragma unroll
                for (int i = 0; i < 2; ++i) { const int r = r0 + i, b = r >= SPB ? 1 : 0, s = r - b * SPB; const bool first = (s == 0 || s == CTX), last = (s == CTX - 1 || s == SPB - 1);
                    const bf16* pa = PAp + (size_t)r * 1024 + 8 * lane; xma[i] = (f32x4){0.f, 0.f, 0.f, 0.f}; xmb[i] = xma[i]; xpa[i] = xma[i]; xpb[i] = xma[i];
                    pg8::ld8(pa, x0a[i], x0b[i]); if (!first) pg8::ld8(pa - 1024, xma[i], xmb[i]); if (!last) pg8::ld8(pa + 1024, xpa[i], xpb[i]); pg8::ld8(pa + 512, aba[i], abb[i]);
                    const bf16* pc = PCp + (size_t)r * 768; pg8::ld8(pc + 8 * lane, qa[i], qb[i]); pg8::ld8(pc + 512 + 8 * (lane & 15), ka[i], kb[i]); }
#pragma unroll
                for (int i = 0; i < 2; ++i) { const int r = r0 + i, b = r >= SPB ? 1 : 0, s = r - b * SPB, t = s - CTX;
                    pg8::st8(YCp + (size_t)r * 1536 + 8 * lane, aba[i] * (w0a * xma[i] + w1a * x0a[i] + w2a * xpa[i]), abb[i] * (w0b * xmb[i] + w1b * x0b[i] + w2b * xpb[i]));
                    const float* rp = s >= CTX ? ropet + 2 * (((c8 < 4) ? (t >> 6) : 256 + (t & 63)) * 16 + 8 * (c8 & 1)) : nullptr;
                    bf16* pc = PCp + (size_t)r * 768;
                    qk_norm_rope(qa[i], qb[i], qga, qgb, rp, (c8 & 2) != 0, attn_body::C2); { pg8::u32x2 w; w.x = pg8::pk_fp8x4(qa[i][0], qa[i][1], qa[i][2], qa[i][3]); w.y = pg8::pk_fp8x4(qb[i][0], qb[i][1], qb[i][2], qb[i][3]); *(pg8::u32x2*)((unsigned char*)pc + 8 * lane) = w; }
                    qk_norm_rope(ka[i], kb[i], kga, kgb, rp, (c8 & 2) != 0, 1.0f); if (lane < 16) { pg8::u32x2 w; w.x = pg8::pk_fp8x4(ka[i][0], ka[i][1], ka[i][2], ka[i][3]); w.y = pg8::pk_fp8x4(kb[i][0], kb[i][1], kb[i][2], kb[i][3]); *(pg8::u32x2*)((unsigned char*)pc + 1024 + 8 * lane) = w; } }
            }
            if (layer > 0) convert_experts(A->in[I_WG], A->in[I_WU], A->in[I_WD], layer, WSP(bf16, WS_WEXP), scr, gw, NGW, lane);
        }
        __syncthreads();
        if (IN(pb + 1)) { PHASE_VARS for (int u = vcu; u < 256; u += G) hg::hgrn_seg<false>(lds, WSP(bf16, WS_PB), WSP(bf16, WS_OBUF), A->in[I_LBP], WSP(float, WS_HGU), WSP(float, WS_HGS), WSP(float, WS_SMALL + SM_HLD), layer, u >> 4, u & 15, tid); }
        SEAM(pb + 1);
        if (IN(pb + 2)) { PHASE_VARS hg::hgrn_carry(WSP(float, WS_HGU), WSP(float, WS_HGS), WSP(float, WS_SMALL + SM_HLD), vcu, G, tid); }
        __syncthreads();
        if (IN(pb + 2)) { PHASE_PTRS
            const attn_body::bf16* PCb = (const attn_body::bf16*)WSP(bf16, WS_PC); attn_body::bf16* YCb = (attn_body::bf16*)WSP(bf16, WS_YCAT);
            const int per = (1024 + G - 1) / G;
            for (int i = 0; i < per; ++i) { const int id = vcu * per + i; if (id >= 1024) break;
                const int b = id >> 9, h = (id >> 6) & 7, q0 = CTX + (id & 63) * 256; const size_t rb = (size_t)b * SPB;
                attn_body::attn_unit((const unsigned char*)PCb + (rb + q0) * 1536 + h * 64, (const unsigned char*)PCb + rb * 1536 + 1024 + (h >> 2) * 64, (const unsigned char*)PCb + rb * 1536 + 1280 + (h >> 2) * 64, YCb + (rb + q0) * 1536 + 1024 + h * 64, SPB / 64, (char*)lds); }
            if (layer < DEPTH - 1) for (int x = vcu; x < 16; x += G) {
                const int b = x >> 3, h = x & 7; const size_t rb = (size_t)b * SPB;
                attn_body::attn_unit((const unsigned char*)PCb + rb * 1536 + h * 64, (const unsigned char*)PCb + rb * 1536 + 1024 + (h >> 2) * 64, (const unsigned char*)PCb + rb * 1536 + 1280 + (h >> 2) * 64, YCb + rb * 1536 + 1024 + h * 64, CTX / 64, (char*)lds); }
        }
        SEAM(pb + 2);
        if (IN(pb + 3)) { PHASE_VARS for (int u = vcu; u < 256; u += G) hg::hgrn_seg<true>(lds, WSP(bf16, WS_PB), WSP(bf16, WS_OBUF), A->in[I_LBP], WSP(float, WS_HGU), WSP(float, WS_HGS), WSP(float, WS_SMALL + SM_HLD), layer, u >> 4, u & 15, tid); }
        SEAM(pb + 3);
        if (IN(pb + 4)) { PHASE_VARS
            const float* hg = A->in[I_HNG] + layer * 512; const bf16* OBp = WSP(bf16, WS_OBUF); const bf16* PBp = WSP(bf16, WS_PB); bf16* YCp = WSP(bf16, WS_YCAT);
            const f32x4 n0 = *(const f32x4*)(hg + 8 * lane), n1 = *(const f32x4*)(hg + 8 * lane + 4);
            for (int r0 = gw * 4; r0 < MT; r0 += NGW * 4) { f32x4 a0[4], a1[4], b0[4], b1[4], g0[4], g1[4];
#pragma unroll
                for (int i = 0; i < 4; ++i) { const size_t r = r0 + i; pg8::ld8(OBp + r * 512 + 8 * lane, a0[i], a1[i]); pg8::ld8(OBp + ((size_t)MT + r) * 512 + 8 * lane, b0[i], b1[i]); pg8::ld8(PBp + r * 2560 + 2048 + 8 * lane, g0[i], g1[i]); }
#pragma unroll
                for (int i = 0; i < 4; ++i) { const size_t r = r0 + i; a0[i] += b0[i]; a1[i] += b1[i];
                    float ss = (a0[i][0] * a0[i][0] + a0[i][1] * a0[i][1]) + (a0[i][2] * a0[i][2] + a0[i][3] * a0[i][3]) + (a1[i][0] * a1[i][0] + a1[i][1] * a1[i][1]) + (a1[i][2] * a1[i][2] + a1[i][3] * a1[i][3]);
                    ss = row_sum16(ss);
                    const float rs = 1.0f / sqrtf(ss * (1.0f / 128.0f) + EPS);
                    pg8::st8(YCp + r * 1536 + 512 + 8 * lane, a0[i] * rs * n0 * g0[i], a1[i] * rs * n1 * g1[i]); } }
        }
        SEAM(pb + 4);
        if (IN(pb + 5)) { PHASE_PTRS
            pg8::Gemm g{WSP(bf16, WS_U8), (const bf16*)(WSP(unsigned char, WS_WG8) + (size_t)layer * NGATE * D), MT, NGATE, D / 2, D / 2};   pg8::RowOrder S; S.init(layer == DEPTH - 1, NGATE, 1, G, bx);
            pg8::EpiGate E{WSP(bf16, WS_GATES)};
            pg8::gemm_phase<pg8::EpiGate, pg8::RowOrder, true, true, true>(ldsl, g, S, E);
        }
        SEAM(pb + 5);
        if (IN(pb + 6)) { PHASE_PTRS pg8::Gemm g{WSP(bf16, WS_YCAT), WSP(bf16, WS_WABC) + (size_t)(layer * 3) * D * 512, MT, D, 512, 1536, (size_t)512 * 2, (size_t)D * 512 * 2};
            pg8::RowOrder S; S.init(layer == DEPTH - 1, D, 3, G, bx); pg8::EpiMerge3 E{WSP(bf16, WS_GATES), WSP(bf16, WS_U)};
            pg8::gemm_phase<pg8::EpiMerge3, pg8::RowOrder, true, true>(ldsl, g, S, E); }
        SEAM(pb + 6);
        if (IN(pb + 7)) { PHASE_PTRS pg8::Gemm g{WSP(bf16, WS_U), WSP(bf16, WS_WO) + (size_t)layer * D * D, MT, D, D, D}; pg8::RowOrder S; S.init(layer == DEPTH - 1, D, 1, G, bx); pg8::EpiWo E{WSP(bf16, WS_DELTA), (WSP(float, WS_MOD) + (size_t)layer * 3 * 6144)};
            pg8::gemm_phase<pg8::EpiWo, pg8::RowOrder, true, true>(ldsl, g, S, E); }
        SEAM(pb + 7);
        if (IN(pb + 8)) { PHASE_VARS
            int* lcnt = (int*)lds; float* rwT = (float*)(lds + 1024);
            if (tid < 16) lcnt[tid] = 0;
            { const float* rwg = A->in[I_RW]; for (int i = tid; i < D * NE; i += NWAVES * 64) rwT[(i & 15) * D + (i >> 4)] = rwg[i]; }
            __syncthreads();
            const float* rw = A->in[I_RW]; (void)rw; const float* rb = A->in[I_RB]; const float* hl = layer == 0 ? A->in[I_X] : (const float*)A->out; const float* hc = layer == 0 ? A->in[I_CTX] : (const float*)WSP(float, WS_HCTX); const bf16* DLp = WSP(bf16, WS_DELTA); const float* modl_ = WSP(float, WS_MOD) + (size_t)layer * 3 * 6144;
            const float* n2g = A->in[I_N2G] + layer * D; bf16* U = WSP(bf16, WS_U); int* re_ = WSP(int, WS_SMALL + SM_RE); float* rwt_ = WSP(float, WS_SMALL + SM_RW); int* rp_ = WSP(int, WS_SMALL + SM_RP);
            for (int r0 = gw * 2; r0 < MT; r0 += NGW * 2) { if (layer == DEPTH - 1 && mod_idx(r0) == 2) continue;
                f32x4 v[2][4], y[2][4];
#pragma unroll
                for (int i = 0; i < 2; ++i) { if (layer == 0) load_row(hrow(hl, hc, r0 + i), lane, v[i]); else load_h1(A->out, WSP(float, WS_HCTX), r0 + i, lane, v[i]); add_row_bf16(DLp + (size_t)(r0 + i) * D, lane, v[i]); }
#pragma unroll
                for (int i = 0; i < 2; ++i) { const float* m = modl_ + (size_t)mod_idx(r0 + i) * 6144; norm_mod(v[i], n2g, m + 4 * 1024, m + 3 * 1024, lane, y[i]); store_row_fp8((unsigned char*)U + (size_t)(r0 + i) * D, lane, y[i]); }
                float lg[2][16];
#pragma unroll
                for (int e = 0; e < 16; ++e) { lg[0][e] = 0.f; lg[1][e] = 0.f; }
#pragma unroll
                for (int j = 0; j < 4; ++j)
#pragma unroll
                    for (int e = 0; e < 16; ++e) { const f32x4 w = *(const f32x4*)(rwT + e * D + 4 * lane + 256 * j);
                        lg[0][e] = fmaf(y[0][j][0], w[0], fmaf(y[0][j][1], w[1], fmaf(y[0][j][2], w[2], fmaf(y[0][j][3], w[3], lg[0][e]))));
                        lg[1][e] = fmaf(y[1][j][0], w[0], fmaf(y[1][j][1], w[1], fmaf(y[1][j][2], w[2], fmaf(y[1][j][3], w[3], lg[1][e])))); }
#define RT_DPP(x, ctrl) __int_as_float(__builtin_amdgcn_update_dpp(__float_as_int(x), __float_as_int(x), (ctrl), 0xf, 0xf, false))
#define RT_XOR4(dst, x) do { int t_ = __builtin_amdgcn_update_dpp(__float_as_int(x), __float_as_int(x), 0x104, 0xf, 0x5, false); t_ = __builtin_amdgcn_update_dpp(t_, __float_as_int(x), 0x114, 0xf, 0xa, false); dst = __int_as_float(t_); } while (0)
                float z[16], w8[8], c4[4], d2[2];
#pragma unroll
                for (int e = 0; e < 16; ++e) { const auto rr = __builtin_amdgcn_permlane32_swap(__float_as_uint(lg[0][e]), __float_as_uint(lg[1][e]), false, false); z[e] = __uint_as_float(rr[0]) + __uint_as_float(rr[1]); }
#pragma unroll
                for (int e = 0; e < 8; ++e) { const auto rr = __builtin_amdgcn_permlane16_swap(__float_as_uint(z[e]), __float_as_uint(z[e + 8]), false, false); w8[e] = __uint_as_float(rr[0]) + __uint_as_float(rr[1]); }
                const bool b4 = (lane & 16) != 0, b3 = (lane & 8) != 0, b2 = (lane & 4) != 0, b1 = (lane & 2) != 0;
#pragma unroll
                for (int p = 0; p < 4; ++p) { const float s1 = b3 ? w8[p + 4] : w8[p], s2 = b3 ? w8[p] : w8[p + 4]; c4[p] = s1 + RT_DPP(s2, 0x128); }
#pragma unroll
                for (int p = 0; p < 2; ++p) { const float s1 = b2 ? c4[p + 2] : c4[p], s2 = b2 ? c4[p] : c4[p + 2]; float x_; RT_XOR4(x_, s2); d2[p] = s1 + x_; }
                float lgt; { const float s1 = b1 ? d2[1] : d2[0], s2 = b1 ? d2[0] : d2[1]; lgt = s1 + RT_DPP(s2, 0x4e); }
                lgt += RT_DPP(lgt, 0xb1);
                const int ex = (lane >> 1) & 15; const float scv = __builtin_amdgcn_rcpf(1.0f + __expf(-lgt)); const float sel = scv + rb[ex];
                float o2_; RT_XOR4(o2_, sel); const float o1_ = RT_DPP(sel, 0x4e), o3_ = RT_DPP(o2_, 0x4e);
                const int rank = (int)(o1_ > sel || (o1_ == sel && b1)) + (int)(o2_ > sel || (o2_ == sel && b2)) + (int)(o3_ > sel || (o3_ == sel && b2));
                float gs = rank < 2 ? sel : 0.f; gs += RT_DPP(gs, 0x4e); { float x_; RT_XOR4(x_, gs); gs += x_; }
                float g2_; { const auto rr = __builtin_amdgcn_permlane16_swap(__float_as_uint(gs), __float_as_uint(gs), false, false); g2_ = b4 ? __uint_as_float(rr[0]) : __uint_as_float(rr[1]); }
                const float g1_ = RT_DPP(gs, 0x128), g3_ = RT_DPP(g2_, 0x128);
                const bool gbest = !(g1_ > gs || (g1_ == gs && b3)) && !(g2_ > gs || (g2_ == gs && b4)) && !(g3_ > gs || (g3_ == gs && b4));
                const unsigned long long m0 = __ballot(gbest && rank == 0), m1 = __ballot(gbest && rank == 1);
#undef RT_DPP
#undef RT_XOR4
#pragma unroll
                for (int i = 0; i < 2; ++i) { const int r = r0 + i;
                    const int l0 = 32 * i + __builtin_ctz((unsigned)(m0 >> (32 * i))), l1 = 32 * i + __builtin_ctz((unsigned)(m1 >> (32 * i)));
                    const int i0 = (l0 >> 1) & 15, i1 = (l1 >> 1) & 15; const float w0 = __int_as_float(__builtin_amdgcn_readlane(__float_as_int(scv), l0)), w1 = __int_as_float(__builtin_amdgcn_readlane(__float_as_int(scv), l1));
                    if (lane == 0) { const float inv = 1.0f / (w0 + w1); const int k0 = atomicAdd(&lcnt[i0], 1), k1 = atomicAdd(&lcnt[i1], 1);
                        re_[2 * r] = i0; re_[2 * r + 1] = i1; rwt_[2 * r] = w0 * inv; rwt_[2 * r + 1] = w1 * inv; rp_[2 * r] = k0; rp_[2 * r + 1] = k1; } }
            }
            __syncthreads();
            if (tid < 16) WSP(int, WS_SMALL + SM_BCNT)[vcu * 16 + tid] = lcnt[tid];
            __syncthreads();
        }
        SEAM(pb + 8);
        if (IN(pb + 9)) { PHASE_VARS
            int* ltot = (int*)lds; int* lbef = ltot + 16; int* lbase = ltot + 32;
            const int* bc = WSP(int, WS_SMALL + SM_BCNT); int* tab = WSP(int, WS_SMALL + SM_TAB); int* re_ = WSP(int, WS_SMALL + SM_RE); int* rp_ = WSP(int, WS_SMALL + SM_RP);
            const unsigned char* U = WSP(unsigned char, WS_U); unsigned char* XSp = WSP(unsigned char, WS_XS);
            if (tid < 32) ltot[tid] = 0;
            __syncthreads();
            { const int e = tid & 15; int tot = 0, bef = 0;
              for (int b2 = (tid >> 4); b2 < G; b2 += 32) { const int c = bc[b2 * 16 + e]; tot += c; if (b2 < vcu) bef += c; }
              atomicAdd(&ltot[e], tot); atomicAdd(&lbef[e], bef); }
            __syncthreads();
            if (tid == 0) { int run = 0;
                for (int e = 0; e < 16; ++e) { const int pad = (ltot[e] + 255) / 256 * 256; lbase[e] = run + lbef[e];
                    if (vcu == 0) for (int t2 = run / 256; t2 < (run + pad) / 256; ++t2) tab[1 + t2] = e;
                    run += pad; }
                if (vcu == 0) tab[0] = run / 256; }
            __syncthreads();
            for (int r0 = gw * 2; r0 < MT; r0 += NGW * 4) {
                int p0[4], p1[4]; v4u a[4]; bool ok[4];
#pragma unroll
                for (int i = 0; i < 4; ++i) { const int r = r0 + (i >> 1) * NGW * 2 + (i & 1); ok[i] = r < MT && !(layer == DEPTH - 1 && mod_idx(r) == 2); const int rc = ok[i] ? r : 0;
                    p0[i] = lbase[re_[2 * rc]] + rp_[2 * rc]; p1[i] = lbase[re_[2 * rc + 1]] + rp_[2 * rc + 1];
                    a[i] = *(const v4u*)(U + (size_t)rc * D + 16 * lane); }
                asm volatile("" ::: "memory");
#pragma unroll
                for (int i = 0; i < 4; ++i) { const int r = r0 + (i >> 1) * NGW * 2 + (i & 1); if (!ok[i]) continue; if (lane == 0) { rp_[2 * r] = p0[i]; rp_[2 * r + 1] = p1[i]; }
                    const v4u q8 = a[i];
                    *(v4u*)(XSp + (size_t)p0[i] * D + 16 * lane) = q8; *(v4u*)(XSp + (size_t)p1[i] * D + 16 * lane) = q8; } }
            __syncthreads();
        }
        SEAM(pb + 9);
        if (IN(pb + 10)) { PHASE_PTRS pg8::Gemm g{WSP(bf16, WS_XS), WSP(bf16, WS_WEXP), PMAX, 2048, D / 2, D / 2}; pg8::MoeOrder S; S.init(WSP(int, WS_SMALL + SM_TAB), 8, G, vcu); pg8::EpiMoe1 E{WSP(unsigned char, WS_HID)};
            pg8::gemm_phase<pg8::EpiMoe1, pg8::MoeOrder, true, true, true>(ldsl, g, S, E); }
        SEAM(pb + 10);
        if (IN(pb + 11)) { PHASE_PTRS pg8::Gemm g{WSP(bf16, WS_HID), (const bf16*)(WSP(unsigned char, WS_WEXP) + (size_t)NE * 2048 * 1024), PMAX, 1024, DFF / 2, DFF / 2}; pg8::MoeOrder S; S.init(WSP(int, WS_SMALL + SM_TAB), 4, G, vcu); pg8::EpiMoe2 E{WSP(bf16, WS_YS)};
            pg8::gemm_phase<pg8::EpiMoe2, pg8::MoeOrder, true, true, true>(ldsl, g, S, E); }
        SEAM(pb + 11);
        if (IN(pb + 12)) { PHASE_VARS
            float* hl = A->out; float* hc = WSP(float, WS_HCTX); const float* modl_ = WSP(float, WS_MOD) + (size_t)layer * 3 * 6144; const int* rp_ = WSP(int, WS_SMALL + SM_RP); const float* rwt_ = WSP(float, WS_SMALL + SM_RW);
            const float* sl = layer == 0 ? A->in[I_X] : (const float*)A->out; const float* sc_ = layer == 0 ? A->in[I_CTX] : (const float*)WSP(float, WS_HCTX); const bf16* DLp = WSP(bf16, WS_DELTA);
            const bf16* YS = WSP(bf16, WS_YS); bf16* U = WSP(bf16, WS_U); const float* n1g = A->in[I_N1G] + (layer + 1 < DEPTH ? layer + 1 : layer) * D; const float* fg = A->in[I_FG];
            for (int r0 = gw * 4; r0 < MT; r0 += NGW * 4) {
                if (layer == DEPTH - 1 && mod_idx(r0) == 2) continue;
                f32x4 v[4][4]; u32x2v ya[4][4], yb[4][4]; float w0[4], w1[4]; float* hp[4]; int p0[4], p1[4];
#pragma unroll
                for (int i = 0; i < 4; ++i) { const int r = r0 + i; p0[i] = rp_[2 * r]; p1[i] = rp_[2 * r + 1]; w0[i] = rwt_[2 * r]; w1[i] = rwt_[2 * r + 1]; hp[i] = (float*)hrow(hl, hc, r); if (layer == 0) load_row(hrow(sl, sc_, r), lane, v[i]); else load_h1(A->out, WSP(float, WS_HCTX), r, lane, v[i]); add_row_bf16(DLp + (size_t)r * D, lane, v[i]); }
#pragma unroll
                for (int i = 0; i < 4; ++i)
#pragma unroll
                    for (int j = 0; j < 4; ++j) { const int c = 4 * lane + 256 * j; ya[i][j] = *(const u32x2v*)(YS + (size_t)p0[i] * D + c); yb[i][j] = *(const u32x2v*)(YS + (size_t)p1[i] * D + c); }
#pragma unroll
                for (int i = 0; i < 4; ++i) { const int r = r0 + i, mi = mod_idx(r); const float* g2 = modl_ + (size_t)mi * 6144 + 5 * 1024;
#pragma unroll
                    for (int j = 0; j < 4; ++j) { const int c = 4 * lane + 256 * j; const f32x4 gg = *(const f32x4*)(g2 + c);
                        const f32x4 fa = {pg8::bflo(ya[i][j].x), pg8::bfhi(ya[i][j].x), pg8::bflo(ya[i][j].y), pg8::bfhi(ya[i][j].y)}, fb = {pg8::bflo(yb[i][j].x), pg8::bfhi(yb[i][j].x), pg8::bflo(yb[i][j].y), pg8::bfhi(yb[i][j].y)};
                        v[i][j] += gg * (fa * w0[i] + fb * w1[i]); }
                    if (layer < DEPTH - 1) {
#pragma unroll
                        for (int j = 0; j < 4; ++j) { if (mi == 2) *(f32x4*)(hp[i] + 4 * lane + 256 * j) = v[i][j]; }
                        if (mi != 2) store_row_bf16((bf16*)hp[i] + D, lane, v[i]);
                        f32x4 y[4]; const float* m = WSP(float, WS_MOD) + (size_t)((layer + 1) * 3 + mi) * 6144; norm_mod(v[i], n1g, m + 1024, m, lane, y); store_row_bf16(U + (size_t)r * D, lane, y); store_row_fp8(WSP(unsigned char, WS_U8) + (size_t)r * D, lane, y);
                    } else {
                        const float rstd = row_rstd(v[i]);
#pragma unroll
                        for (int j = 0; j < 4; ++j) *(f32x4*)(hp[i] + 4 * lane + 256 * j) = v[i][j] * rstd * *(const f32x4*)(fg + 4 * lane + 256 * j);
                    } }
            }
        }
        SEAM(pb + 12);
    }
__global__ void __launch_bounds__(NWAVES * 64, 2) fwd(Args args) {
    extern __shared__ __attribute__((aligned(16))) unsigned char lds[];
    LAS unsigned char* ldsl = (LAS unsigned char*)lds;
    volatile LAS unsigned* MISC = (volatile LAS unsigned*)(ldsl + MISC_OFF);
    const int tid = threadIdx.x, lane = tid & 63, wave = __builtin_amdgcn_readfirstlane(tid >> 6);
    const int G = gridDim.x; const int bx = blockIdx.x; const int vcu = (G % 8 == 0) ? (bx % 8) * (G / 8) + bx / 8 : bx;
    const int gw = vcu * NWAVES + wave, NGW = G * NWAVES;
    gu32* ctl = (gu32*)(args.ws + WS_CTL);
    for (int u = tid; u < (LDS_BYTES - LDSCTL_OFF) / 4; u += NWAVES * 64) ((LAS unsigned*)(ldsl + LDSCTL_OFF))[u] = 0u;
    __syncthreads();
    const int lo = args.ph_lo, hi = args.ph_hi;
    const bool multi = (hi - lo) > 1;
    XcdBarrier bar; bar.bar = (unsigned*)(ctl + CW_BAR) + args.li * XCD_BAR_WORDS; bar.x = 0; bar.st = nullptr;
    if (multi) bar = xcd_barrier_post((unsigned*)(ctl + CW_BAR) + args.li * XCD_BAR_WORDS, MISC + 8);

    LAS float* scr = (LAS float*)(ldsl + wave * 16384);

    if (IN(0)) { PHASE_VARS
        for (int it = gw; it < DEPTH * 16 * 248; it += NGW) { const int l = it / (16 * 248), r = it % (16 * 248), kb = r / 248, nb = r % 248;
            if (32 * nb < N1) transpose_item(A->in[I_WIN] + (size_t)l * D * NWIN, NWIN, WSP(bf16, WS_WIN) + (size_t)l * NWIN * D, D, win_drow(32 * nb), 64 * kb, 32 * nb, scr, lane);
            else transpose_item<true>(A->in[I_WIN] + (size_t)l * D * NWIN, NWIN, (bf16*)(WSP(unsigned char, WS_WG8) + (size_t)l * NGATE * D), D, 32 * nb - N1, 64 * kb, 32 * nb, scr, lane); }
        for (int it = gw; it < DEPTH * 3 * 256; it += NGW) { const int mat = it / 256, r = it % 256, kb = r / 32, nb = r % 32, l = mat / 3, br = mat % 3;
            const float* W = (br == 0 ? A->in[I_WA] : br == 1 ? A->in[I_WB] : A->in[I_WC]) + (size_t)l * 512 * D;
            transpose_item(W, D, WSP(bf16, WS_WABC) + (size_t)(l * 3 + br) * D * 512, 512, 32 * nb, 64 * kb, 32 * nb, scr, lane); }
        for (int it = gw; it < DEPTH * 512; it += NGW) { const int l = it / 512, r = it % 512, kb = r / 32, nb = r % 32;
            transpose_item(A->in[I_WOUT] + (size_t)l * D * D, D, WSP(bf16, WS_WO) + (size_t)l * D * D, D, 32 * nb, 64 * kb, 32 * nb, scr, lane); }
        convert_experts(A->in[I_WG], A->in[I_WU], A->in[I_WD], 0, WSP(bf16, WS_WEXP), scr, gw, NGW, lane);
        __syncthreads();
        { float* sc = (float*)lds;
          float* red = sc + 3 * 1024;
          for (int i = tid; i < 3 * 1024; i += NWAVES * 64) { const int j = i >> 10, k = i & 1023; const float c = j < 2 ? A->in[I_C][j * 1024 + k] : A->in[I_CCTX][k]; sc[i] = c * sigm_acc(c); }
          __syncthreads();
          for (int unit = vcu; unit < DEPTH * 96; unit += G) { const int l = unit / 96, cg = unit % 96, col = cg * 64 + lane;
              const float* W = A->in[I_WMOD] + (size_t)l * D * 6144 + col; float a0 = 0.f, a1 = 0.f, a2 = 0.f;
#pragma unroll 8
              for (int k = wave * 128; k < wave * 128 + 128; ++k) { const float w = W[(size_t)k * 6144]; a0 += sc[k] * w; a1 += sc[1024 + k] * w; a2 += sc[2048 + k] * w; }
              red[(wave * 3 + 0) * 64 + lane] = a0; red[(wave * 3 + 1) * 64 + lane] = a1; red[(wave * 3 + 2) * 64 + lane] = a2;
              __syncthreads();
              if (tid < 192) { const int j = tid >> 6, ln = tid & 63; float s = 0.f;
#pragma unroll
                  for (int w = 0; w < 8; ++w) s += red[(w * 3 + j) * 64 + ln];
                  const int c = cg * 64 + ln; WSP(float, WS_MOD)[(size_t)(l * 3 + j) * 6144 + c] = s + A->in[I_BMOD][l * 6144 + c]; }
              __syncthreads(); }
        }
        for (int i = gw * 64 + lane; i < 320 * 16; i += NGW * 64) { const int pos = (i >> 4) < 256 ? (i >> 4) : (i >> 4) - 256, fi = i & 15;
            const float inv = __builtin_amdgcn_exp2f(-(float)(2 * fi) * (13.287712379549449f / 32.0f)); const float a = (float)pos * inv;
            const double ad = (double)a; const double rev = ad * 0.15915494309189535; const double fr = rev - __builtin_rint(rev); const float red = (float)(fr * 6.283185307179586);
            WSP(float, WS_SMALL + SM_ROPE)[2 * i] = __cosf(red); WSP(float, WS_SMALL + SM_ROPE)[2 * i + 1] = __sinf(red); }
    }
    SEAM(0);
    if (IN(1)) { PHASE_VARS
        const float* mod0 = WSP(float, WS_MOD); bf16* U = WSP(bf16, WS_U); unsigned char* U8 = WSP(unsigned char, WS_U8); const float* xin = A->in[I_X]; const float* cin = A->in[I_CTX]; const float* n1g = A->in[I_N1G];
        for (int r0 = gw * 4; r0 < MT; r0 += NGW * 4) { f32x4 v[4][4];
#pragma unroll
            for (int i = 0; i < 4; ++i) load_row(hrow(xin, cin, r0 + i), lane, v[i]);
#pragma unroll
            for (int i = 0; i < 4; ++i) { f32x4 y[4]; const float* m = mod0 + (size_t)mod_idx(r0 + i) * 6144; norm_mod(v[i], n1g, m + 1024, m, lane, y); store_row_bf16(U + (size_t)(r0 + i) * D, lane, y); store_row_fp8(U8 + (size_t)(r0 + i) * D, lane, y); } }
    }
    SEAM(1);

    layer_phases<0>(lo, hi, bar, lds);
    layer_phases<1>(lo, hi, bar, lds);
#undef PHASE_VARS
#undef PHASE_PTRS
#undef WSP
#undef IN
#undef SEAM
}

extern "C" void kernel_launch(void* const* d_in, const int* in_sizes, int n_in, void* d_out, int out_size, void* d_ws, size_t ws_size, hipStream_t stream) {
    static int grid = 0;
    if (grid == 0) {
        if (n_in != 24 || out_size != NB * SEQ * D || ws_size < WS_END) { fprintf(stderr, "kernel_launch: unexpected shapes (n_in %d, out %d, ws %zu < %zu); nothing launched\n", n_in, out_size, ws_size, (size_t)WS_END); grid = -1; return; }
        int dev = 0, cus = 0, per_cu = 0;
        if (hipGetDevice(&dev) != hipSuccess || hipDeviceGetAttribute(&cus, hipDeviceAttributeMultiprocessorCount, dev) != hipSuccess) { grid = -1; return; }
        if (hipFuncSetAttribute((const void*)fwd, hipFuncAttributeMaxDynamicSharedMemorySize, LDS_BYTES) != hipSuccess) { fprintf(stderr, "kernel_launch: hipFuncSetAttribute failed\n"); grid = -1; return; }
        if (hipOccupancyMaxActiveBlocksPerMultiprocessor(&per_cu, (const void*)fwd, NWAVES * 64, LDS_BYTES) != hipSuccess || per_cu < 1) { fprintf(stderr, "kernel_launch: occupancy query says %d\n", per_cu); }
        (void)hipGetLastError();
        grid = cus;
    }
    if (grid < 0) return;
    if (hipMemsetAsync((char*)d_ws + WS_CTL, 0, CTL_ZERO_BYTES, stream) != hipSuccess) return;
    Args a{};
    for (int i = 0; i < 24; ++i) a.in[i] = (const float*)d_in[i];
    a.out = (float*)d_out; a.ws = (unsigned char*)d_ws;
#ifndef MK_ONE_LAUNCH
#define MK_ONE_LAUNCH 1
#endif
    if (MK_ONE_LAUNCH) { a.ph_lo = 0; a.ph_hi = NPHASE; a.li = 0; hipLaunchKernelGGL(fwd, dim3(grid), dim3(NWAVES * 64), LDS_BYTES, stream, a); }
    else for (int ph = 0; ph < NPHASE; ++ph) { a.ph_lo = ph; a.ph_hi = ph + 1; a.li = 0; hipLaunchKernelGGL(fwd, dim3(grid), dim3(NWAVES * 64), LDS_BYTES, stream, a); }
}
```
